# Optimizing an MI355X kernel written in HIP

```python
import jax, jax.numpy as jnp
from jax import lax
import numpy as np

D_MODEL = 1024
BATCH = 2
SEQ = 8192
DEPTH = 2
DEC_BATCH = 8
DEC_SEQ = 2048
PAST_LEN = 128

N_META = 16
MIX_WIDTH = D_MODEL
ATT_HEADS = 8
QK_NOPE = 64
QK_ROPE = 32
V_HEAD = 64
Q_LORA = 256
KV_LORA = 128
ATT_WIDTH = ATT_HEADS * V_HEAD
RWKV_HEAD = 64
RWKV_WIDTH = MIX_WIDTH - ATT_WIDTH
RWKV_HEADS = RWKV_WIDTH // RWKV_HEAD
DECAY_LORA = 64
ICLR_LORA = 64
GATE_LORA = 160
N_DIR = 2
D_FF = 2816
Q_BLOCK = 128
ROPE_THETA = 10000.0
RMS_EPS = 1e-6
LNX_EPS = 64e-5
MLA_COLS = Q_LORA + KV_LORA + QK_ROPE
RWKV_COLS = 3 * RWKV_WIDTH + N_DIR * DECAY_LORA + N_DIR * ICLR_LORA + GATE_LORA
IN_COLS = MLA_COLS + RWKV_COLS

kernel_name = 'hymba_mla_rwkv7_macaron_encoder'


def rmsnorm(x, g):
    xf = x.astype(jnp.float32)
    y = xf * lax.rsqrt(jnp.mean(xf * xf, axis=-1, keepdims=True) + RMS_EPS)
    return (y * g.astype(jnp.float32)).astype(x.dtype)


def swiglu(x, w_gate, w_up, w_down):
    return (jax.nn.silu(x @ w_gate) * (x @ w_up)) @ w_down


def rope_tables(length, dim):
    inv = 1.0 / (ROPE_THETA ** (jnp.arange(0, dim, 2, dtype=jnp.float32) / dim))
    ang = jnp.arange(length, dtype=jnp.float32)[:, None] * inv[None, :]
    return jnp.cos(ang), jnp.sin(ang)


def apply_rope(x, cos, sin):
    half = x.shape[-1] // 2
    x1 = x[..., :half].astype(jnp.float32)
    x2 = x[..., half:].astype(jnp.float32)
    return jnp.concatenate([x1 * cos - x2 * sin, x2 * cos + x1 * sin], axis=-1).astype(x.dtype)


def mla_attention(p_mla, q_norm, w_uq, kv_norm, w_ukv):
    b, l, _ = p_mla.shape
    c_q = rmsnorm(p_mla[..., :Q_LORA], q_norm)
    c_kv = rmsnorm(p_mla[..., Q_LORA:Q_LORA + KV_LORA], kv_norm)
    q = (c_q @ w_uq).reshape(b, l, ATT_HEADS, QK_NOPE + QK_ROPE)
    kv = (c_kv @ w_ukv).reshape(b, l, ATT_HEADS, QK_NOPE + V_HEAD)
    cos, sin = rope_tables(l, QK_ROPE)
    q_nope = q[..., :QK_NOPE]
    q_rope = apply_rope(q[..., QK_NOPE:], cos[:, None, :], sin[:, None, :])
    k_rope = apply_rope(p_mla[..., Q_LORA + KV_LORA:], cos, sin)
    k_nope = kv[..., :QK_NOPE]
    v = kv[..., QK_NOPE:]
    scale = (QK_NOPE + QK_ROPE) ** -0.5
    n_blk = -(-l // Q_BLOCK)
    pad = n_blk * Q_BLOCK - l

    def blocks(t):
        t = jnp.pad(t, ((0, 0), (0, pad), (0, 0), (0, 0)))
        return jnp.moveaxis(t.reshape(b, n_blk, Q_BLOCK, ATT_HEADS, t.shape[-1]), 1, 0)

    def attend(qb):
        qn, qr = qb
        s = jnp.einsum('bqhd,bkhd->bhqk', qn, k_nope) + jnp.einsum('bqhr,bkr->bhqk', qr, k_rope)
        pr = jax.nn.softmax(s.astype(jnp.float32) * scale, axis=-1)
        return jnp.einsum('bhqk,bkhd->bqhd', pr.astype(v.dtype), v)

    o = lax.map(attend, (blocks(q_nope), blocks(q_rope)))
    return jnp.moveaxis(o, 0, 1).reshape(b, n_blk * Q_BLOCK, ATT_WIDTH)[:, :l]


def token_shift_centred(p, mu):
    prev = jnp.pad(p, ((0, 0), (1, 0), (0, 0)))[:, :-1]
    nxt = jnp.pad(p, ((0, 0), (0, 1), (0, 0)))[:, 1:]
    return p + mu[0] * (prev - p) + mu[1] * (nxt - p)


def to_scan(t):
    t = jnp.moveaxis(t.astype(jnp.float32), 1, 0)
    t = jnp.stack([t[:, :, 0], t[::-1, :, 1]], axis=1)
    return t.reshape(t.shape[0], N_DIR, t.shape[2], RWKV_HEADS, RWKV_HEAD)


def rwkv7_scan(r, w, k, v, aa, bb):
    b = r.shape[2]
    s0 = jnp.zeros((N_DIR, b, RWKV_HEADS, RWKV_HEAD, RWKV_HEAD), jnp.float32)

    def step(S, inp):
        rt, wt, kt, vt, at, bt = inp
        sa = jnp.einsum('dbhvk,dbhk->dbhv', S, at)
        S = S * wt[..., None, :] + sa[..., :, None] * bt[..., None, :] + vt[..., :, None] * kt[..., None, :]
        return S, jnp.einsum('dbhvk,dbhk->dbhv', S, rt)

    _, ys = lax.scan(step, s0, (r, w, k, v, aa, bb))
    return ys


def rwkv7_bidir(p_rwkv, shift_mu, decay_w0, decay_w2, iclr_a0, iclr_a2, gate_g2,
                key_k_k, key_k_a, bonus_r_k, lnx_w, lnx_b):
    b, l, _ = p_rwkv.shape
    C = RWKV_WIDTH
    p = token_shift_centred(p_rwkv, shift_mu)
    o1 = 3 * C
    o2 = o1 + N_DIR * DECAY_LORA
    o3 = o2 + N_DIR * ICLR_LORA
    r = p[..., :C]
    k = p[..., C:2 * C]
    v = p[..., 2 * C:o1]
    dw = p[..., o1:o2].reshape(b, l, N_DIR, DECAY_LORA)
    da = p[..., o2:o3].reshape(b, l, N_DIR, ICLR_LORA)
    dg = p[..., o3:]
    wl = (decay_w0 + jnp.einsum('bldr,drc->bldc', jnp.tanh(dw), decay_w2)).astype(jnp.float32)
    wl = -jax.nn.softplus(-wl) - 0.5
    decay = jnp.exp(-jnp.exp(wl))
    a = jax.nn.sigmoid((iclr_a0 + jnp.einsum('bldr,drc->bldc', da, iclr_a2)).astype(jnp.float32))
    g = jax.nn.sigmoid(dg) @ gate_g2
    kk = (k * key_k_k).astype(jnp.float32).reshape(b, l, RWKV_HEADS, RWKV_HEAD)
    kk = (kk / jnp.maximum(jnp.linalg.norm(kk, axis=-1, keepdims=True), 1e-12)).reshape(b, l, C)
    k_dir = k.astype(jnp.float32)[:, :, None, :] * (1.0 + (a - 1.0) * key_k_a.astype(jnp.float32))
    both = lambda t: jnp.broadcast_to(t[:, :, None, :], (b, l, N_DIR, C))
    ys = rwkv7_scan(to_scan(both(r)), to_scan(decay), to_scan(k_dir), to_scan(both(v)),
                    to_scan(both(-kk)), to_scan(kk[:, :, None, :] * a))
    y = jnp.moveaxis(ys[:, 0] + ys[::-1, 1], 0, 1)
    mu = jnp.mean(y, axis=-1, keepdims=True)
    var = jnp.mean(jnp.square(y - mu), axis=-1, keepdims=True)
    yn = ((y - mu) * lax.rsqrt(var + LNX_EPS)).reshape(b, l, C) * lnx_w + lnx_b
    rh = r.astype(jnp.float32).reshape(b, l, RWKV_HEADS, RWKV_HEAD)
    kh = jnp.sum(k_dir, axis=2).reshape(b, l, RWKV_HEADS, RWKV_HEAD)
    vh = v.astype(jnp.float32).reshape(b, l, RWKV_HEADS, RWKV_HEAD)
    bonus = (jnp.sum(rh * kh * bonus_r_k, axis=-1, keepdims=True) * vh).reshape(b, l, C)
    return ((yn + bonus) * g.astype(jnp.float32)).astype(p_rwkv.dtype)


def encode(x, meta_tokens, ffn1_norm, ffn1_w_gate, ffn1_w_up, ffn1_w_down, mix_norm, w_in, shift_mu,
           q_norm, w_uq, kv_norm, w_ukv, decay_w0, decay_w2, iclr_a0, iclr_a2, gate_g2, key_k_k,
           key_k_a, bonus_r_k, lnx_w, lnx_b, w_out, ffn2_norm, ffn2_w_gate, ffn2_w_up, ffn2_w_down,
           final_norm):
    b = x.shape[0]
    meta = jnp.broadcast_to(meta_tokens.astype(x.dtype)[None], (b, N_META, D_MODEL))
    h = jnp.concatenate([meta, x], axis=1)
    for i in range(DEPTH):
        h = h + 0.5 * swiglu(rmsnorm(h, ffn1_norm[i]), ffn1_w_gate[i], ffn1_w_up[i], ffn1_w_down[i])
        proj = rmsnorm(h, mix_norm[i]) @ w_in[i]
        att = mla_attention(proj[..., :MLA_COLS], q_norm[i], w_uq[i], kv_norm[i], w_ukv[i])
        rw = rwkv7_bidir(proj[..., MLA_COLS:], shift_mu[i], decay_w0[i], decay_w2[i], iclr_a0[i],
                         iclr_a2[i], gate_g2[i], key_k_k[i], key_k_a[i], bonus_r_k[i], lnx_w[i], lnx_b[i])
        h = h + jnp.concatenate([att, rw], axis=-1) @ w_out[i]
        h = h + 0.5 * swiglu(rmsnorm(h, ffn2_norm[i]), ffn2_w_gate[i], ffn2_w_up[i], ffn2_w_down[i])
    return rmsnorm(h, final_norm)[:, N_META:]


def setup_inputs(seed: int = 0) -> dict:
    key = jax.random.key(seed)
    ks = jax.random.split(key, 40)
    f32 = jnp.float32
    nrm = lambda k, shape, fan_in: jax.random.normal(k, shape, f32) * fan_in ** -0.5
    gain = lambda k, shape: 1.0 + 0.02 * jax.random.normal(k, shape, f32)
    L = DEPTH
    C = RWKV_WIDTH
    return {
        'x_prompt': jax.random.normal(ks[0], (BATCH, SEQ, D_MODEL), f32),
        'x_sample': jax.random.normal(ks[1], (DEC_BATCH, DEC_SEQ, D_MODEL), f32),
        'meta_tokens': jax.random.normal(ks[2], (N_META, D_MODEL), f32),
        'ffn1_norm': gain(ks[3], (L, D_MODEL)),
        'ffn1_w_gate': nrm(ks[4], (L, D_MODEL, D_FF), D_MODEL),
        'ffn1_w_up': nrm(ks[5], (L, D_MODEL, D_FF), D_MODEL),
        'ffn1_w_down': nrm(ks[6], (L, D_FF, D_MODEL), D_FF),
        'mix_norm': gain(ks[7], (L, D_MODEL)),
        'w_in': nrm(ks[8], (L, D_MODEL, IN_COLS), D_MODEL),
        'shift_mu': jax.random.uniform(ks[9], (L, 2, RWKV_COLS), f32, 0.0, 0.5),
        'q_norm': gain(ks[10], (L, Q_LORA)),
        'w_uq': nrm(ks[11], (L, Q_LORA, ATT_HEADS * (QK_NOPE + QK_ROPE)), Q_LORA),
        'kv_norm': gain(ks[12], (L, KV_LORA)),
        'w_ukv': nrm(ks[13], (L, KV_LORA, ATT_HEADS * (QK_NOPE + V_HEAD)), KV_LORA),
        'decay_w0': jax.random.uniform(ks[14], (L, N_DIR, C), f32, -6.0, 1.0),
        'decay_w2': nrm(ks[15], (L, N_DIR, DECAY_LORA, C), DECAY_LORA),
        'iclr_a0': 0.1 * jax.random.normal(ks[16], (L, N_DIR, C), f32),
        'iclr_a2': nrm(ks[17], (L, N_DIR, ICLR_LORA, C), ICLR_LORA),
        'gate_g2': nrm(ks[18], (L, GATE_LORA, C), GATE_LORA),
        'key_k_k': 0.85 + 0.02 * jax.random.normal(ks[19], (L, C), f32),
        'key_k_a': gain(ks[20], (L, C)),
        'bonus_r_k': 0.1 * jax.random.normal(ks[21], (L, RWKV_HEADS, RWKV_HEAD), f32),
        'lnx_w': gain(ks[22], (L, C)),
        'lnx_b': 0.02 * jax.random.normal(ks[23], (L, C), f32),
        'w_out': nrm(ks[24], (L, MIX_WIDTH, D_MODEL), MIX_WIDTH),
        'ffn2_norm': gain(ks[25], (L, D_MODEL)),
        'ffn2_w_gate': nrm(ks[26], (L, D_MODEL, D_FF), D_MODEL),
        'ffn2_w_up': nrm(ks[27], (L, D_MODEL, D_FF), D_MODEL),
        'ffn2_w_down': nrm(ks[28], (L, D_FF, D_MODEL), D_FF),
        'final_norm': gain(ks[29], (D_MODEL,)),
    }


def reference(x_prompt, x_sample, meta_tokens, ffn1_norm, ffn1_w_gate, ffn1_w_up, ffn1_w_down, mix_norm,
              w_in, shift_mu, q_norm, w_uq, kv_norm, w_ukv, decay_w0, decay_w2, iclr_a0, iclr_a2, gate_g2,
              key_k_k, key_k_a, bonus_r_k, lnx_w, lnx_b, w_out, ffn2_norm, ffn2_w_gate, ffn2_w_up,
              ffn2_w_down, final_norm):
    weights = (meta_tokens, ffn1_norm, ffn1_w_gate, ffn1_w_up, ffn1_w_down, mix_norm, w_in, shift_mu,
               q_norm, w_uq, kv_norm, w_ukv, decay_w0, decay_w2, iclr_a0, iclr_a2, gate_g2, key_k_k,
               key_k_a, bonus_r_k, lnx_w, lnx_b, w_out, ffn2_norm, ffn2_w_gate, ffn2_w_up, ffn2_w_down,
               final_norm)
    y_prompt = encode(x_prompt, *weights)
    y_sample = encode(x_sample, *weights)
    return (y_prompt, y_sample)
```

```cpp
#include <hip/hip_runtime.h>
#include <hip/hip_cooperative_groups.h>
#include <cstdio>
namespace cg = cooperative_groups;

typedef unsigned short u16;
typedef __attribute__((ext_vector_type(8))) short bf16x8;
typedef __attribute__((ext_vector_type(16))) float f32x16;
#define DI __device__ __forceinline__
#define MFMA(a, b, c) __builtin_amdgcn_mfma_f32_32x32x16_bf16((a), (b), (c), 0, 0, 0)

constexpr int T = 32928, TP = 33024, LPR = 8208, LSM = 2064, NMT = 129;
constexpr int NTHR = 512;
constexpr float RMS_EPS = 1e-6f, LNX_EPS = 64e-5f;
constexpr float QSCALE = 0.10206207261596575f * 1.4426950408889634f;
constexpr int OFF_IN = 0, OFF_UQ = 2621440, OFF_UKV = 2818048, OFF_DEC = 2949120, OFF_A = 3014656, OFF_G = 3080192, OFF_OUT = 3178496, WM_ELEMS = 4227072;
constexpr int OFF_WD = 5767168, WF_ELEMS = 8650752;
constexpr int SMEM_BYTES = 149504;

__constant__ double ROPE_INV[16] = {1.0, 0.5623413251903491, 0.31622776601683794, 0.1778279410038923, 0.1, 0.05623413251903491,
  0.031622776601683794, 0.01778279410038923, 0.01, 0.005623413251903491, 0.0031622776601683794, 0.001778279410038923,
  0.001, 0.0005623413251903491, 0.00031622776601683794, 0.0001778279410038923};

struct Params {
  const float *x_prompt, *x_sample, *meta, *ffn1_norm, *ffn1_wg, *ffn1_wu, *ffn1_wd, *mix_norm, *w_in, *shift_mu, *q_norm, *w_uq,
      *kv_norm, *w_ukv, *decay_w0, *decay_w2, *iclr_a0, *iclr_a2, *gate_g2, *key_k_k, *key_k_a, *bonus_r_k, *lnx_w, *lnx_b, *w_out,
      *ffn2_norm, *ffn2_wg, *ffn2_wu, *ffn2_wd, *final_norm;
  float* out;
  u16 *hb, *regB, *kn, *vt, *wF, *wM;
  float *ssq, *ssqq, *bsc, *ropec, *ropes;
  unsigned* ctr;
  unsigned* bar;
};

typedef const __attribute__((address_space(4))) Params& CP;
DI int tidx() { int t = __builtin_amdgcn_workitem_id_x(); asm volatile("" : "+v"(t)); return t; }
DI u16 f2bf(float x) { unsigned u = __float_as_uint(x); u += 0x7fffu + ((u >> 16) & 1u); return (u16)(u >> 16); }
DI float bf2f(u16 b) { return __uint_as_float(((unsigned)b) << 16); }
typedef __bf16 bf16x2_t __attribute__((ext_vector_type(2)));
typedef float fl2_t __attribute__((ext_vector_type(2)));
DI unsigned pack2(float a, float b) { fl2_t f; f.x = a; f.y = b; bf16x2_t r = __builtin_convertvector(f, bf16x2_t); return __builtin_bit_cast(unsigned, r); }
DI float bflo(unsigned u) { return __uint_as_float(u << 16); }
DI float bfhi(unsigned u) { return __uint_as_float(u & 0xffff0000u); }
DI float sigmoidf_(float x) { return __builtin_amdgcn_rcpf(1.f + __expf(-x)); }
DI int crow(int reg, int h) { return (reg & 3) + 8 * (reg >> 2) + 4 * h; }
DI void row2seq(int r, int& s, int& pos, int& L) {
  if (r < 2 * LPR) { s = r >= LPR ? 1 : 0; pos = r - s * LPR; L = LPR; }
  else { int q = (r - 2 * LPR) / LSM; s = 2 + q; pos = r - 2 * LPR - q * LSM; L = LSM; }
}
DI int seq_start(int s) { return s < 2 ? s * LPR : 2 * LPR + (s - 2) * LSM; }
DI int seq_len(int s) { return s < 2 ? LPR : LSM; }
DI float dpp_sum8(float x) {
  x += __int_as_float(__builtin_amdgcn_update_dpp(0, __float_as_int(x), 0xB1, 0xf, 0xf, false));
  x += __int_as_float(__builtin_amdgcn_update_dpp(0, __float_as_int(x), 0x4E, 0xf, 0xf, false));
  x += __int_as_float(__builtin_amdgcn_update_dpp(0, __float_as_int(x), 0x141, 0xf, 0xf, false));
  return x;
}
DI float sum16(float x) {
  x += __int_as_float(__builtin_amdgcn_update_dpp(0, __float_as_int(x), 0x128, 0xf, 0xf, false));
  x += __int_as_float(__builtin_amdgcn_update_dpp(0, __float_as_int(x), 0x124, 0xf, 0xf, false));
  x += __int_as_float(__builtin_amdgcn_update_dpp(0, __float_as_int(x), 0x122, 0xf, 0xf, false));
  x += __int_as_float(__builtin_amdgcn_update_dpp(0, __float_as_int(x), 0x121, 0xf, 0xf, false));
  return x;
}
DI float rstd16(const float* ssq, int m) {
  float s = 0.f;
#pragma unroll
  for (int c = 0; c < 16; ++c) s += ssq[(size_t)c * TP + m];
  return rsqrtf(s * (1.f / 1024.f) + RMS_EPS);
}

struct CJob { const float* src; const float* gain; u16* dst; int K, N, ld, map, nkt; };
DI int rowmap(int map, int n) {
  if (map == 1) return (n >> 5) * 64 + (n & 31);
  if (map == 2) return (n >> 5) * 64 + 32 + (n & 31);
  if (map == 3) return n < 416 ? n : n + 96;
  return n;
}
DI void conv_tile(const CJob& jb, int t, char* smem) {
  float* tile = (float*)smem;
  const int tid = tidx();
  const int kt = t % jb.nkt, ntile = t / jb.nkt;
  const int k0 = kt * 64, n0 = ntile * 64;
  const int tx = tid & 63, ty = tid >> 6;
#pragma unroll
  for (int i = 0; i < 8; ++i) {
    int k = k0 + ty + 8 * i;
    float v = 0.f;
    if (k < jb.K) { v = jb.src[(size_t)k * jb.N + n0 + tx]; if (jb.gain) v *= jb.gain[k]; }
    tile[(ty + 8 * i) * 65 + tx] = v;
  }
  __syncthreads();
  const int ny = tid >> 3, kx = tid & 7;
  uint4 o;
  o.x = pack2(tile[(kx * 8 + 0) * 65 + ny], tile[(kx * 8 + 1) * 65 + ny]);
  o.y = pack2(tile[(kx * 8 + 2) * 65 + ny], tile[(kx * 8 + 3) * 65 + ny]);
  o.z = pack2(tile[(kx * 8 + 4) * 65 + ny], tile[(kx * 8 + 5) * 65 + ny]);
  o.w = pack2(tile[(kx * 8 + 6) * 65 + ny], tile[(kx * 8 + 7) * 65 + ny]);
  *(uint4*)(jb.dst + (size_t)rowmap(jb.map, n0 + ny) * jb.ld + k0 + kx * 8) = o;
  __syncthreads();
}
constexpr int NCONV_FFN = 2112, NCONV_MIX = 1032;
DI void conv_ffn(CP p, int l, int f, int t, char* smem) {
  CJob jb;
  u16* slot = (l == 1 && f == 0) ? p.kn : p.wF;
  const float* wg = f ? p.ffn2_wg : p.ffn1_wg; const float* wu = f ? p.ffn2_wu : p.ffn1_wu; const float* wd = f ? p.ffn2_wd : p.ffn1_wd;
  const float* nr = f ? p.ffn2_norm : p.ffn1_norm;
  if (t < 704) { jb = CJob{wg + (size_t)l * 1024 * 2816, nr + l * 1024, slot, 1024, 2816, 1024, 1, 16}; }
  else if (t < 1408) { t -= 704; jb = CJob{wu + (size_t)l * 1024 * 2816, nr + l * 1024, slot, 1024, 2816, 1024, 2, 16}; }
  else { t -= 1408; jb = CJob{wd + (size_t)l * 2816 * 1024, nullptr, slot + OFF_WD, 2816, 1024, 2816, 0, 44}; }
  conv_tile(jb, t, smem);
}
DI void conv_mix(CP p, int l, int t, char* smem) {
  CJob jb;
  if (t < 592) jb = CJob{p.w_in + (size_t)l * 1024 * 2368, p.mix_norm + l * 1024, p.wM + OFF_IN, 1024, 2368, 1024, 3, 16};
  else if (t < 640) { t -= 592; jb = CJob{p.w_uq + (size_t)l * 256 * 768, p.q_norm + l * 256, p.wM + OFF_UQ, 256, 768, 256, 0, 4}; }
  else if (t < 672) { t -= 640; jb = CJob{p.w_ukv + (size_t)l * 128 * 1024, p.kv_norm + l * 128, p.wM + OFF_UKV, 128, 1024, 128, 0, 2}; }
  else if (t < 688) { t -= 672; int d = t >> 3; t &= 7; jb = CJob{p.decay_w2 + (size_t)(l * 2 + d) * 64 * 512, nullptr, p.wM + OFF_DEC + d * 32768, 64, 512, 64, 0, 1}; }
  else if (t < 704) { t -= 688; int d = t >> 3; t &= 7; jb = CJob{p.iclr_a2 + (size_t)(l * 2 + d) * 64 * 512, nullptr, p.wM + OFF_A + d * 32768, 64, 512, 64, 0, 1}; }
  else if (t < 728) { t -= 704; jb = CJob{p.gate_g2 + (size_t)l * 160 * 512, nullptr, p.wM + OFF_G, 160, 512, 192, 0, 3}; }
  else if (t < 984) { t -= 728; jb = CJob{p.w_out + (size_t)l * 1024 * 1024, nullptr, p.wM + OFF_OUT, 1024, 1024, 1024, 0, 16}; }
  else {
    t -= 984;
    size_t base = (t < 24) ? (size_t)416 * 1024 + (size_t)t * 4096 : (size_t)2464 * 1024 + (size_t)(t - 24) * 4096;
    *(uint4*)(p.wM + OFF_IN + base + tidx() * 8) = make_uint4(0, 0, 0, 0);
    return;
  }
  conv_tile(jb, t, smem);
}

struct GArgs { const u16 *a0, *a1; int ld0, ld1, split, ks0; const u16* W; int K; int layer; float scale; };
enum { EPI_UP = 0, EPI_RES = 1, EPI_INPROJ = 2, EPI_Q = 3, EPI_KV = 4, EPI_POST = 5 };

DI uint4 load_gate(CP p, int layer, int m, int k) {
  uint4 z = make_uint4(0, 0, 0, 0);
  if (m >= T || k >= 160) return z;
  int s, pos, L; row2seq(m, s, pos, L);
  const u16* pb = p.regB + (size_t)m * 1952 + 1792 + k;
  uint4 c = *(const uint4*)pb;
  uint4 pm = pos > 0 ? *(const uint4*)(pb - 1952) : z;
  uint4 pp = pos + 1 < L ? *(const uint4*)(pb + 1952) : z;
  const float* mu0 = p.shift_mu + (size_t)(layer * 2 + 0) * 1952 + 1792 + k;
  const float* mu1 = p.shift_mu + (size_t)(layer * 2 + 1) * 1952 + 1792 + k;
  unsigned cc[4] = {c.x, c.y, c.z, c.w}, mm[4] = {pm.x, pm.y, pm.z, pm.w}, nn[4] = {pp.x, pp.y, pp.z, pp.w};
  unsigned o[4];
#pragma unroll
  for (int e = 0; e < 4; ++e) {
    float c0 = bflo(cc[e]), c1 = bfhi(cc[e]);
    float x0 = c0 + mu0[2 * e] * (bflo(mm[e]) - c0) + mu1[2 * e] * (bflo(nn[e]) - c0);
    float x1 = c1 + mu0[2 * e + 1] * (bfhi(mm[e]) - c1) + mu1[2 * e + 1] * (bfhi(nn[e]) - c1);
    o[e] = pack2(sigmoidf_(x0), sigmoidf_(x1));
  }
  return make_uint4(o[0], o[1], o[2], o[3]);
}

template <int MODE>
DI uint4 load_a(CP p, const GArgs& g, int row, int kt, int kc) {
  if (MODE == 1) return load_gate(p, g.layer, row, kt * 64 + kc * 8);
  const u16* ap = (kt < g.split) ? g.a0 + (size_t)row * g.ld0 + kt * g.ks0 : g.a1 + (size_t)row * g.ld1 + (kt - g.split) * 64;
  return *(const uint4*)(ap + kc * 8);
}

DI u16* halo_ptr(CP p) { return (u16*)p.out + (size_t)TP * 1024 + (size_t)TP * 768 + (size_t)TP * 32; }
DI uint4 ldg16(const u16* p) { uint4 v = *(const uint4*)p; return v; }
DI void sts16(u16* p, uint4 v) { *(uint4*)p = v; }
DI void store4(u16* dst, float a, float b, float c, float d) { *(uint2*)dst = make_uint2(pack2(a, b), pack2(c, d)); }

template <int MODE, int EPI, int BN>
DI void gemm_tile(CP p, const GArgs& g, int mt, int nt, char* smem) {
  constexpr int WN = BN / 64, WM = 8 / WN, MI = 256 / WM / 32, NWC = BN / 64;
  u16* As = (u16*)smem;
  u16* Ws = As + 2 * 256 * 72;
  const int tid = tidx(), lane = tid & 63, wv = tid >> 6, wm = wv / WN, wn = wv % WN, l32 = lane & 31, hh = lane >> 5;
  const int m0 = mt * 256, n0 = nt * BN;
  const int nk = g.K >> 6;
  f32x16 acc[MI][2];
#pragma unroll
  for (int i = 0; i < MI; ++i)
#pragma unroll
    for (int j = 0; j < 2; ++j)
#pragma unroll
      for (int r = 0; r < 16; ++r) acc[i][j][r] = 0.f;
  uint4 ra0[4], ra1[4], rw0[4], rw1[4];
#define GLA(KT, DA, I) { const int c_ = tid + (I) * 512; DA[I] = load_a<MODE>(p, g, m0 + (c_ >> 3), (KT), c_ & 7); }
#define GLW(KT, DW, I) if ((I) < NWC) { const int c_ = tid + (I) * 512; DW[I] = ldg16(g.W + (size_t)(n0 + (c_ >> 3)) * g.K + (KT) * 64 + (c_ & 7) * 8); }
#define GLOAD(KT, DA, DW) do { GLA(KT, DA, 0) GLA(KT, DA, 1) GLA(KT, DA, 2) GLA(KT, DA, 3) GLW(KT, DW, 0) GLW(KT, DW, 1) GLW(KT, DW, 2) GLW(KT, DW, 3) } while (0)
#define LSA(BUF, DA, I) { const int c_ = tid + (I) * 512; sts16(As + ((BUF) * 256 + (c_ >> 3)) * 72 + (c_ & 7) * 8, DA[I]); }
#define LSW(BUF, DW, I) if ((I) < NWC) { const int c_ = tid + (I) * 512; sts16(Ws + ((BUF) * BN + (c_ >> 3)) * 72 + (c_ & 7) * 8, DW[I]); }
#define LSTORE(BUF, DA, DW) do { LSA(BUF, DA, 0) LSA(BUF, DA, 1) LSA(BUF, DA, 2) LSA(BUF, DA, 3) LSW(BUF, DW, 0) LSW(BUF, DW, 1) LSW(BUF, DW, 2) LSW(BUF, DW, 3) } while (0)
  auto compute = [&](int buf) {
    const u16* Ab = As + buf * 256 * 72 + (wm * (MI * 32) + l32) * 72 + hh * 8;
    const u16* Wb = Ws + buf * BN * 72 + (wn * 64 + l32) * 72 + hh * 8;
#pragma unroll
    for (int ks = 0; ks < 4; ++ks) {
      bf16x8 wf0 = *(const bf16x8*)(Wb + ks * 16);
      bf16x8 wf1 = *(const bf16x8*)(Wb + 32 * 72 + ks * 16);
#pragma unroll
      for (int i = 0; i < MI; ++i) {
        bf16x8 xf = *(const bf16x8*)(Ab + i * 32 * 72 + ks * 16);
        acc[i][0] = MFMA(wf0, xf, acc[i][0]);
        acc[i][1] = MFMA(wf1, xf, acc[i][1]);
      }
    }
  };
  if (true) {
    char* L0 = smem;
    constexpr int BUFB = (256 + BN) * 128;
    constexpr int NBUF = BN == 128 ? 3 : 2;
    constexpr int NGL = 4 + BN / 64;
    const int gl_row = lane >> 3;
    auto issue = [&](int kt, int buf) {
      char* lb = L0 + buf * BUFB;
#pragma unroll
      for (int i = 0; i < 4; ++i) {
        const int seg = wv * 4 + i, row = seg * 8 + gl_row;
        const int c = (lane & 7) ^ ((row >> 1) & 7);
        const u16* ap = (kt < g.split) ? g.a0 + (size_t)(m0 + row) * g.ld0 + kt * g.ks0 : g.a1 + (size_t)(m0 + row) * g.ld1 + (kt - g.split) * 64;
        __builtin_amdgcn_global_load_lds((const unsigned*)(ap + c * 8), (__attribute__((address_space(3))) unsigned*)(lb + seg * 1024 + lane * 16), 16, 0, 0);
      }
#pragma unroll
      for (int i = 0; i < BN / 64; ++i) {
        const int seg = wv * (BN / 64) + i, row = seg * 8 + gl_row;
        const int c = (lane & 7) ^ ((row >> 1) & 7);
        __builtin_amdgcn_global_load_lds((const unsigned*)(g.W + (size_t)(n0 + row) * g.K + kt * 64 + c * 8),
                                         (__attribute__((address_space(3))) unsigned*)(lb + 256 * 128 + seg * 1024 + lane * 16), 16, 0, 0);
      }
    };
    auto compute2 = [&](int buf) {
      const char* lb = L0 + buf * BUFB;
#pragma unroll
      for (int ks = 0; ks < 4; ++ks) {
        const int c = ks * 2 + hh;
        bf16x8 wf[2], xf[MI];
#pragma unroll
        for (int j = 0; j < 2; ++j) { const int r = wn * 64 + j * 32 + l32; wf[j] = *(const bf16x8*)(lb + 256 * 128 + r * 128 + ((c ^ ((r >> 1) & 7)) << 4)); }
#pragma unroll
        for (int i = 0; i < MI; ++i) { const int r = wm * (MI * 32) + i * 32 + l32; xf[i] = *(const bf16x8*)(lb + r * 128 + ((c ^ ((r >> 1) & 7)) << 4)); }
#pragma unroll
        for (int i = 0; i < MI; ++i) {
          acc[i][0] = MFMA(wf[0], xf[i], acc[i][0]);
          acc[i][1] = MFMA(wf[1], xf[i], acc[i][1]);
        }
      }
    };
    if (NBUF == 3) {
      issue(0, 0);
      if (nk > 1) { issue(1, 1); asm volatile("s_waitcnt vmcnt(6)" ::: "memory"); }
      else asm volatile("s_waitcnt vmcnt(0)" ::: "memory");
      asm volatile("s_waitcnt lgkmcnt(0)" ::: "memory");
      __builtin_amdgcn_s_barrier();
      int buf = 0;
      for (int kt = 0; kt < nk; ++kt) {
        const int b2 = buf == 0 ? 2 : buf - 1;
        if (kt + 2 < nk) issue(kt + 2, b2);
        compute2(buf);
        if (kt + 2 < nk) asm volatile("s_waitcnt vmcnt(6)" ::: "memory");
        else asm volatile("s_waitcnt vmcnt(0)" ::: "memory");
        asm volatile("s_waitcnt lgkmcnt(0)" ::: "memory");
        __builtin_amdgcn_s_barrier();
        buf = buf == 2 ? 0 : buf + 1;
      }
    } else {
      issue(0, 0);
      asm volatile("s_waitcnt vmcnt(0)" ::: "memory");
      __syncthreads();
      for (int kt = 0; kt < nk; ++kt) {
        const int buf = kt & 1;
        if (kt + 1 < nk) issue(kt + 1, buf ^ 1);
        compute2(buf);
        asm volatile("s_waitcnt vmcnt(0)" ::: "memory");
        __syncthreads();
      }
    }
    __syncthreads();
  } else {
    GLOAD(0, ra0, rw0);
    LSTORE(0, ra0, rw0);
    __syncthreads();
    for (int kt = 0; kt < nk; ++kt) {
      const int buf = kt & 1;
      if (kt + 1 < nk) GLOAD(kt + 1, ra0, rw0);
      compute(buf);
      if (kt + 1 < nk) LSTORE(buf ^ 1, ra0, rw0);
      __syncthreads();
    }
  }
#undef GLOAD
#undef LSTORE
  const int nw = n0 + wn * 64;
#pragma unroll
  for (int i = 0; i < MI; ++i) {
    const int m = m0 + wm * (MI * 32) + i * 32 + l32;
    if (EPI == EPI_UP) {
      const float rs = rstd16(p.ssq, m);
      const int hb0 = nw >> 1;
#pragma unroll
      for (int gq = 0; gq < 4; ++gq) {
        float v[4];
#pragma unroll
        for (int r = 0; r < 4; ++r) {
          float gt = acc[i][0][4 * gq + r] * rs, up = acc[i][1][4 * gq + r] * rs;
          v[r] = gt * sigmoidf_(gt) * up;
        }
        int hid = hb0 + 8 * gq + 4 * hh;
        u16* dst = hid < 1408 ? p.regB + (size_t)m * 1408 + hid : (u16*)p.out + (size_t)m * 1408 + (hid - 1408);
        store4(dst, v[0], v[1], v[2], v[3]);
      }
    } else if (EPI == EPI_RES) {
      float ss = 0.f;
#pragma unroll
      for (int j = 0; j < 2; ++j)
#pragma unroll
        for (int gq = 0; gq < 4; ++gq) {
          u16* hp = p.hb + (size_t)m * 1024 + nw + j * 32 + 8 * gq + 4 * hh;
          uint2 old = *(const uint2*)hp;
          float h0 = bflo(old.x) + g.scale * acc[i][j][4 * gq + 0];
          float h1 = bfhi(old.x) + g.scale * acc[i][j][4 * gq + 1];
          float h2 = bflo(old.y) + g.scale * acc[i][j][4 * gq + 2];
          float h3 = bfhi(old.y) + g.scale * acc[i][j][4 * gq + 3];
          unsigned p0 = pack2(h0, h1), p1 = pack2(h2, h3);
          *(uint2*)hp = make_uint2(p0, p1);
          float r0 = bflo(p0), r1 = bfhi(p0), r2 = bflo(p1), r3 = bfhi(p1);
          ss += r0 * r0 + r1 * r1 + r2 * r2 + r3 * r3;
        }
      ss += __shfl_xor(ss, 32);
      if (hh == 0) p.ssq[(size_t)(nw >> 6) * TP + m] = ss;
    } else if (EPI == EPI_INPROJ) {
      const float rs = rstd16(p.ssq, m);
      int s, pos, L; row2seq(m < T ? m : 0, s, pos, L);
      float ss = 0.f;
#pragma unroll
      for (int j = 0; j < 2; ++j) {
        const int nb = nw + j * 32;
        if (nb == 384) {
          u16* kr = (u16*)p.out + (size_t)TP * 1024 + (size_t)TP * 768 + (size_t)m * 32;
#pragma unroll
          for (int gq = 0; gq < 2; ++gq) {
            float o1[4], o2[4];
#pragma unroll
            for (int r = 0; r < 4; ++r) {
              int ii = 8 * gq + 4 * hh + r;
              float c = p.ropec[pos * 16 + ii], sn = p.ropes[pos * 16 + ii];
              float x1 = acc[i][j][4 * gq + r] * rs, x2 = acc[i][j][4 * (gq + 2) + r] * rs;
              o1[r] = x1 * c - x2 * sn; o2[r] = x2 * c + x1 * sn;
            }
            store4(kr + 8 * gq + 4 * hh, o1[0], o1[1], o1[2], o1[3]);
            store4(kr + 16 + 8 * gq + 4 * hh, o2[0], o2[1], o2[2], o2[3]);
          }
        } else {
#pragma unroll
          for (int gq = 0; gq < 4; ++gq) {
            int n = nb + 8 * gq + 4 * hh;
            unsigned p0 = pack2(acc[i][j][4 * gq] * rs, acc[i][j][4 * gq + 1] * rs);
            unsigned p1 = pack2(acc[i][j][4 * gq + 2] * rs, acc[i][j][4 * gq + 3] * rs);
            if (n < 512) {
              *(uint2*)((u16*)p.out + (size_t)m * 512 + n) = make_uint2(p0, p1);
              float r0 = bflo(p0), r1 = bfhi(p0), r2 = bflo(p1), r3 = bfhi(p1);
              ss += r0 * r0 + r1 * r1 + r2 * r2 + r3 * r3;
            } else if (n - 512 < 1952) {
              *(uint2*)(p.regB + (size_t)m * 1952 + (n - 512)) = make_uint2(p0, p1);
              if (m < T && ((pos & 63) == 0 || (pos & 63) == 63)) {
                const int ch = (s < 2 ? s * 129 : 258 + (s - 2) * 33) + (pos >> 6);
                *(uint2*)(halo_ptr(p) + ((size_t)ch * 2 + ((pos & 63) ? 1 : 0)) * 1952 + (n - 512)) = make_uint2(p0, p1);
              }
            }
          }
        }
      }
      if (nw < 384) {
        ss += __shfl_xor(ss, 32);
        if (hh == 0) p.ssqq[(size_t)(nw >> 6) * TP + m] = ss;
      }
    } else if (EPI == EPI_Q) {
      float sq = p.ssqq[m] + p.ssqq[(size_t)TP + m] + p.ssqq[(size_t)2 * TP + m] + p.ssqq[(size_t)3 * TP + m];
      const float rs = rsqrtf(sq * (1.f / 256.f) + RMS_EPS) * QSCALE;
      int s, pos, L; row2seq(m < T ? m : 0, s, pos, L);
      u16* qrow = (u16*)p.out + (size_t)TP * 1024 + (size_t)m * 768;
#pragma unroll
      for (int j = 0; j < 2; ++j) {
        const int nb = nw + j * 32;
        if (((nb >> 5) % 3) == 2) {
#pragma unroll
          for (int gq = 0; gq < 2; ++gq) {
            float o1[4], o2[4];
#pragma unroll
            for (int r = 0; r < 4; ++r) {
              int ii = 8 * gq + 4 * hh + r;
              float c = p.ropec[pos * 16 + ii], sn = p.ropes[pos * 16 + ii];
              float x1 = acc[i][j][4 * gq + r] * rs, x2 = acc[i][j][4 * (gq + 2) + r] * rs;
              o1[r] = x1 * c - x2 * sn; o2[r] = x2 * c + x1 * sn;
            }
            store4(qrow + nb + 8 * gq + 4 * hh, o1[0], o1[1], o1[2], o1[3]);
            store4(qrow + nb + 16 + 8 * gq + 4 * hh, o2[0], o2[1], o2[2], o2[3]);
          }
        } else {
#pragma unroll
          for (int gq = 0; gq < 4; ++gq)
            store4(qrow + nb + 8 * gq + 4 * hh, acc[i][j][4 * gq] * rs, acc[i][j][4 * gq + 1] * rs, acc[i][j][4 * gq + 2] * rs, acc[i][j][4 * gq + 3] * rs);
        }
      }
    } else if (EPI == EPI_KV) {
      if (m < T) {
        float sq = p.ssqq[(size_t)4 * TP + m] + p.ssqq[(size_t)5 * TP + m];
        const float rs = rsqrtf(sq * (1.f / 128.f) + RMS_EPS);
        int s, pos, L; row2seq(m, s, pos, L);
        const int head = nw >> 7;
        const int ppos = (pos & ~15) | (pos & 3) | (((pos >> 3) & 1) << 2) | (((pos >> 2) & 1) << 3);
#pragma unroll
        for (int j = 0; j < 2; ++j) {
          const int jj = (nw & 127) + j * 32;
#pragma unroll
          for (int gq = 0; gq < 4; ++gq) {
            int c = jj + 8 * gq + 4 * hh;
            if (jj < 64) {
              store4(p.kn + (size_t)m * 512 + head * 64 + c, acc[i][j][4 * gq] * rs, acc[i][j][4 * gq + 1] * rs, acc[i][j][4 * gq + 2] * rs, acc[i][j][4 * gq + 3] * rs);
            } else {
#pragma unroll
              for (int r = 0; r < 4; ++r) {
                int dv = c - 64 + r;
                p.vt[(size_t)seq_start(s) * 512 + (size_t)(head * 64 + dv) * L + ppos] = f2bf(acc[i][j][4 * gq + r] * rs);
              }
            }
          }
        }
      }
    } else if (EPI == EPI_POST) {
      if (m < T) {
        int s, pos, L; row2seq(m, s, pos, L);
        const int hd = nw >> 6;
        u16* yb = (u16*)p.out + (size_t)m * 1024;
        float y[2][16];
        float sum = 0.f;
#pragma unroll
        for (int j = 0; j < 2; ++j)
#pragma unroll
          for (int gq = 0; gq < 4; ++gq) {
            int n = nw + j * 32 + 8 * gq + 4 * hh;
            uint2 a = *(const uint2*)(yb + n), b = *(const uint2*)(yb + 512 + n);
            y[j][4 * gq + 0] = bflo(a.x) + bflo(b.x); y[j][4 * gq + 1] = bfhi(a.x) + bfhi(b.x);
            y[j][4 * gq + 2] = bflo(a.y) + bflo(b.y); y[j][4 * gq + 3] = bfhi(a.y) + bfhi(b.y);
            sum += y[j][4 * gq] + y[j][4 * gq + 1] + y[j][4 * gq + 2] + y[j][4 * gq + 3];
          }
        sum += __shfl_xor(sum, 32);
        const float mu = sum * (1.f / 64.f);
        float vs = 0.f;
#pragma unroll
        for (int j = 0; j < 2; ++j)
#pragma unroll
          for (int r = 0; r < 16; ++r) { float dlt = y[j][r] - mu; vs += dlt * dlt; }
        vs += __shfl_xor(vs, 32);
        const float rstd = rsqrtf(vs * (1.f / 64.f) + LNX_EPS);
        const float bsum = p.bsc[(size_t)m * 8 + hd] + p.bsc[((size_t)TP + m) * 8 + hd];
        const u16* vb = p.regB + (size_t)m * 1952 + 1024;
#pragma unroll
        for (int j = 0; j < 2; ++j)
#pragma unroll
          for (int gq = 0; gq < 4; ++gq) {
            int n = nw + j * 32 + 8 * gq + 4 * hh;
            uint2 c = *(const uint2*)(vb + n);
            float cv[4] = {bflo(c.x), bfhi(c.x), bflo(c.y), bfhi(c.y)};
            float o[4];
#pragma unroll
            for (int r = 0; r < 4; ++r) {
              float vsh = cv[r];
              float yn = (y[j][4 * gq + r] - mu) * rstd * p.lnx_w[g.layer * 512 + n + r] + p.lnx_b[g.layer * 512 + n + r];
              o[r] = (yn + bsum * vsh) * acc[i][j][4 * gq + r];
            }
            store4(yb + n, o[0], o[1], o[2], o[3]);
          }
      }
    }
  }
}

template <int MODE, int EPI, int BN = 128>
DI void gemm_phase_item(CP p, const GArgs& g, int item, int NT, char* smem) {
  const int grp = item / (8 * NT);
  const int gsz = min(8, NMT - grp * 8);
  const int idx = item - grp * 8 * NT;
  gemm_tile<MODE, EPI, BN>(p, g, grp * 8 + idx % gsz, idx / gsz, smem);
}

template <int MODE, int EPI, int BN>
DI void gemm_phase(CP p, const GArgs& g, int NT, char* smem) {
  const int x = blockIdx.x & 7, j = blockIdx.x >> 3, nj = gridDim.x >> 3;
  const int owned = (NMT - x + 7) >> 3;
  const int total = owned * NT;
  for (int e = j; e < total; e += nj) {
    const int grp = e / (8 * NT);
    const int gsz = min(8, owned - grp * 8);
    const int rem = e - grp * 8 * NT;
    const int mi = rem % gsz, nt = rem / gsz;
    gemm_tile<MODE, EPI, BN>(p, g, x + 8 * (grp * 8 + mi), nt, smem);
  }
}

DI void attn_item(CP p, int s, int hd, int qb, char* smem, bool dostore = true) {
  u16* Ks = (u16*)smem;
  u16* Vs = Ks + 3 * 64 * 104;
  const int tid = tidx(), lane = tid & 63, wv = tid >> 6, l32 = lane & 31, hh = lane >> 5;
  const int L = seq_len(s), r0 = seq_start(s);
  const u16* Qb = (const u16*)p.out + (size_t)TP * 1024;
  const u16* KR = Qb + (size_t)TP * 768;
  const int qpos = qb * 256 + wv * 32 + l32;
  const bool wvalid = (qb * 256 + wv * 32) < L;
  const int qrow = r0 + min(qpos, L - 1);
  bf16x8 qf[6];
#pragma unroll
  for (int ks = 0; ks < 6; ++ks) qf[ks] = *(const bf16x8*)(Qb + (size_t)qrow * 768 + hd * 96 + ks * 16 + hh * 8);
  f32x16 o[2];
#pragma unroll
  for (int u = 0; u < 2; ++u)
#pragma unroll
    for (int r = 0; r < 16; ++r) o[u][r] = 0.f;
  float mrun = -1e30f, lrun = 0.f;
  const int nt = (L + 63) >> 6;
  const u16* vtb = p.vt + (size_t)r0 * 512 + (size_t)hd * 64 * L;
  uint4 rg[3];
  auto ldc = [&](int kt, int c) -> uint4 {
    const bool isk = c < 768;
    const int key = c / 12, cc = c - key * 12, kpos = min(kt * 64 + key, L - 1);
    const u16* srck = cc < 8 ? p.kn + (size_t)(r0 + kpos) * 512 + hd * 64 + cc * 8 : KR + (size_t)(r0 + kpos) * 32 + (cc - 8) * 8;
    const int c2 = c - 768, dv = (c2 >> 3) & 63, kc = c2 & 7, kp0 = min(kt * 64 + kc * 8, L - 8);
    const u16* srcv = vtb + (size_t)dv * L + kp0;
    return ldg16(isk ? srck : srcv);
  };
  auto stc = [&](int st3, int c, uint4 v, int kt) {
    const bool isk = c < 768;
    const int key = c / 12, cc = c - key * 12, c2 = c - 768, dv = (c2 >> 3) & 63, kc = c2 & 7;
    const bool masked = isk ? (kt * 64 + key >= L) : (kt * 64 + kc * 8 >= L);
    if (masked) v = make_uint4(0, 0, 0, 0);
    u16* dst = isk ? Ks + (st3 * 64 + key) * 104 + cc * 8 : Vs + (st3 * 64 + dv) * 72 + kc * 8;
    sts16(dst, v);
  };
  auto qk = [&](int st3, f32x16* st) {
#pragma unroll
    for (int t = 0; t < 2; ++t) {
#pragma unroll
      for (int r = 0; r < 16; ++r) st[t][r] = 0.f;
      const u16* kb = Ks + (st3 * 64 + t * 32 + l32) * 104 + hh * 8;
      bf16x8 kf[6];
#pragma unroll
      for (int ks = 0; ks < 6; ++ks) kf[ks] = *(const bf16x8*)(kb + ks * 16);
#pragma unroll
      for (int ks = 0; ks < 6; ++ks) st[t] = MFMA(kf[ks], qf[ks], st[t]);
    }
  };
  rg[0] = ldc(0, tid); rg[1] = ldc(0, tid + 512); if (tid < 256) rg[2] = ldc(0, tid + 1024);
  stc(0, tid, rg[0], 0); stc(0, tid + 512, rg[1], 0); if (tid < 256) stc(0, tid + 1024, rg[2], 0);
  if (nt > 1) {
    rg[0] = ldc(1, tid); rg[1] = ldc(1, tid + 512); if (tid < 256) rg[2] = ldc(1, tid + 1024);
    stc(1, tid, rg[0], 1); stc(1, tid + 512, rg[1], 1); if (tid < 256) stc(1, tid + 1024, rg[2], 1);
  }
  __syncthreads();
  f32x16 sc[2], sn[2];
  if (wvalid) qk(0, sc);
  int st_cur = 0;
  for (int kt = 0; kt < nt; ++kt) {
    const int st_nxt = st_cur == 2 ? 0 : st_cur + 1, st_ld = st_nxt == 2 ? 0 : st_nxt + 1;
    if (kt + 2 < nt) { rg[0] = ldc(kt + 2, tid); rg[1] = ldc(kt + 2, tid + 512); if (tid < 256) rg[2] = ldc(kt + 2, tid + 1024); }
    if (wvalid) {
      if (kt + 1 < nt) qk(st_nxt, sn);
      if (kt == nt - 1) {
#pragma unroll
        for (int t = 0; t < 2; ++t)
#pragma unroll
          for (int r = 0; r < 16; ++r) if (kt * 64 + t * 32 + crow(r, hh) >= L) sc[t][r] = -1e30f;
      }
      bf16x8 vfr[2][2][2];
#pragma unroll
      for (int t = 0; t < 2; ++t)
#pragma unroll
        for (int s2 = 0; s2 < 2; ++s2)
#pragma unroll
          for (int u = 0; u < 2; ++u) vfr[t][s2][u] = *(const bf16x8*)(Vs + (st_cur * 64 + u * 32 + l32) * 72 + t * 32 + s2 * 16 + hh * 8);
      float mx = -1e30f;
#pragma unroll
      for (int t = 0; t < 2; ++t)
#pragma unroll
        for (int r = 0; r < 16; ++r) mx = fmaxf(mx, sc[t][r]);
      mx = fmaxf(mx, __shfl_xor(mx, 32));
      const float mnew = fmaxf(mrun, mx);
      const float alpha = __builtin_amdgcn_exp2f(mrun - mnew);
      float ls = 0.f;
#pragma unroll
      for (int t = 0; t < 2; ++t)
#pragma unroll
        for (int r = 0; r < 16; ++r) { float pv = __builtin_amdgcn_exp2f(sc[t][r] - mnew); sc[t][r] = pv; ls += pv; }
      lrun = lrun * alpha + ls; mrun = mnew;
#pragma unroll
      for (int u = 0; u < 2; ++u)
#pragma unroll
        for (int r = 0; r < 16; ++r) o[u][r] *= alpha;
#pragma unroll
      for (int t = 0; t < 2; ++t)
#pragma unroll
        for (int s2 = 0; s2 < 2; ++s2) {
          uint4 pk;
          pk.x = pack2(sc[t][8 * s2 + 0], sc[t][8 * s2 + 1]); pk.y = pack2(sc[t][8 * s2 + 2], sc[t][8 * s2 + 3]);
          pk.z = pack2(sc[t][8 * s2 + 4], sc[t][8 * s2 + 5]); pk.w = pack2(sc[t][8 * s2 + 6], sc[t][8 * s2 + 7]);
          bf16x8 pf = __builtin_bit_cast(bf16x8, pk);
#pragma unroll
          for (int u = 0; u < 2; ++u) o[u] = MFMA(vfr[t][s2][u], pf, o[u]);
        }
      if (kt + 1 < nt) { sc[0] = sn[0]; sc[1] = sn[1]; }
    }
    if (kt + 2 < nt) { stc(st_ld, tid, rg[0], kt + 2); stc(st_ld, tid + 512, rg[1], kt + 2); if (tid < 256) stc(st_ld, tid + 1024, rg[2], kt + 2); }
    __syncthreads();
    st_cur = st_nxt;
  }
  if (wvalid) {
    float lt = lrun + __shfl_xor(lrun, 32);
    const float inv = 1.f / lt;
    if (qpos < L && dostore) {
      u16* dst = (u16*)p.out + (size_t)TP * 1024 + (size_t)(r0 + qpos) * 768 + hd * 96;
#pragma unroll
      for (int u = 0; u < 2; ++u)
#pragma unroll
        for (int gq = 0; gq < 4; ++gq)
          store4(dst + u * 32 + 8 * gq + 4 * hh, o[u][4 * gq] * inv, o[u][4 * gq + 1] * inv, o[u][4 * gq + 2] * inv, o[u][4 * gq + 3] * inv);
    }
  }
}

DI void scan_block(CP p, int layer, int s, int d, int hd, char* smem) {
  float* OP = (float*)smem;
  float* WA = OP + 32 * 392;
  float* YB = WA + 2 * 32 * 64;
  u16* XL = (u16*)(YB + 32 * 64);
  float* MU = (float*)(XL + 2 * 32 * 72);
  float* CS = MU + 5 * 2 * 64;
  const int tid = tidx(), lane = tid & 63, wv = tid >> 6, l32 = lane & 31, hh = lane >> 5;
  const int L = seq_len(s), r0 = seq_start(s);
  const int sj = tid >> 4, q = tid & 15;
  const int rloc = lane >> 3, cg8 = lane & 7, row = wv * 8 + rloc;
  const int aoff[5] = {hd * 64, 512 + hd * 64, 1024 + hd * 64, 1536 + d * 64, 1664 + d * 64};
  __syncthreads();
  for (int i = tid; i < 640; i += NTHR) {
    int a = i >> 7, w = (i >> 6) & 1, c = i & 63;
    int off = a == 0 ? aoff[0] : a == 1 ? aoff[1] : a == 2 ? aoff[2] : a == 3 ? aoff[3] : aoff[4];
    MU[i] = p.shift_mu[(size_t)(layer * 2 + w) * 1952 + off + c];
  }
  if (tid < 64) {
    CS[tid] = p.key_k_k[layer * 512 + hd * 64 + tid];
    CS[64 + tid] = p.key_k_a[layer * 512 + hd * 64 + tid];
    CS[128 + tid] = p.bonus_r_k[layer * 512 + hd * 64 + tid];
  }
  const int mat = (wv >> 1) & 1, ntile = wv & 1;
  bf16x8 wfr[4];
  {
    const u16* wb = p.wM + (mat ? OFF_A : OFF_DEC) + (size_t)(d * 512 + hd * 64 + ntile * 32 + l32) * 64 + hh * 8;
#pragma unroll
    for (int ks = 0; ks < 4; ++ks) wfr[ks] = *(const bf16x8*)(wb + ks * 16);
  }
  const float bias = mat ? p.iclr_a0[(size_t)(layer * 2 + d) * 512 + hd * 64 + ntile * 32 + l32]
                         : p.decay_w0[(size_t)(layer * 2 + d) * 512 + hd * 64 + ntile * 32 + l32];
  __syncthreads();
  float S[8];
#pragma unroll
  for (int i = 0; i < 8; ++i) S[i] = 0.f;
  const int nch = (L + 31) >> 5;
  uint2 raw[15];
  float r4[4], k4[4], kk4[4], v4[4];

  auto prefetch = [&](int c) {
    const int sidx = c * 32 + sj;
    const bool valid = sidx < L;
    const int tok = d == 0 ? sidx : L - 1 - sidx;
    const u16* base = p.regB + (size_t)(r0 + tok) * 1952 + 4 * q;
#pragma unroll
    for (int a = 0; a < 5; ++a) {
      const int off = a == 0 ? aoff[0] : a == 1 ? aoff[1] : a == 2 ? aoff[2] : a == 3 ? aoff[3] : aoff[4];
      raw[a * 3 + 0] = (valid && tok > 0) ? *(const uint2*)(base - 1952 + off) : make_uint2(0, 0);
      raw[a * 3 + 1] = valid ? *(const uint2*)(base + off) : make_uint2(0, 0);
      raw[a * 3 + 2] = (valid && tok + 1 < L) ? *(const uint2*)(base + 1952 + off) : make_uint2(0, 0);
    }
  };
  auto shift4 = [&](int a, float* x) {
    const float4 m0 = *(const float4*)(MU + (a * 2 + 0) * 64 + 4 * q);
    const float4 m1 = *(const float4*)(MU + (a * 2 + 1) * 64 + 4 * q);
    const uint2 pm = raw[a * 3], c = raw[a * 3 + 1], pp = raw[a * 3 + 2];
    float c0 = bflo(c.x), c1 = bfhi(c.x), c2 = bflo(c.y), c3 = bfhi(c.y);
    x[0] = c0 + m0.x * (bflo(pm.x) - c0) + m1.x * (bflo(pp.x) - c0);
    x[1] = c1 + m0.y * (bfhi(pm.x) - c1) + m1.y * (bfhi(pp.x) - c1);
    x[2] = c2 + m0.z * (bflo(pm.y) - c2) + m1.z * (bflo(pp.y) - c2);
    x[3] = c3 + m0.w * (bfhi(pm.y) - c3) + m1.w * (bfhi(pp.y) - c3);
  };
  auto stage = [&](int c) {
    shift4(0, r4); shift4(1, k4); shift4(2, v4);
    float xw[4], xa[4];
    shift4(3, xw); shift4(4, xa);
#pragma unroll
    for (int e = 0; e < 4; ++e) xw[e] = 1.f - 2.f / (__expf(2.f * xw[e]) + 1.f);
    store4(XL + sj * 72 + 4 * q, xw[0], xw[1], xw[2], xw[3]);
    store4(XL + 32 * 72 + sj * 72 + 4 * q, xa[0], xa[1], xa[2], xa[3]);
    {
      const float4 kkw = *(const float4*)(CS + 4 * q);
      float x0 = k4[0] * kkw.x, x1 = k4[1] * kkw.y, x2 = k4[2] * kkw.z, x3 = k4[3] * kkw.w;
      float ss = sum16(x0 * x0 + x1 * x1 + x2 * x2 + x3 * x3);
      float inv = 1.f / fmaxf(sqrtf(ss), 1e-12f);
      kk4[0] = x0 * inv; kk4[1] = x1 * inv; kk4[2] = x2 * inv; kk4[3] = x3 * inv;
    }
    __syncthreads();
    if (wv < 4) {
      f32x16 acc;
#pragma unroll
      for (int r = 0; r < 16; ++r) acc[r] = 0.f;
      const u16* xb = XL + mat * 32 * 72 + l32 * 72 + hh * 8;
#pragma unroll
      for (int ks = 0; ks < 4; ++ks) acc = MFMA(*(const bf16x8*)(xb + ks * 16), wfr[ks], acc);
#pragma unroll
      for (int r = 0; r < 16; ++r) {
        float x = acc[r] + bias;
        float sg = sigmoidf_(x);
        float val = mat ? sg : __expf(-0.6065306597126334f * sg);
        WA[(mat * 32 + crow(r, hh)) * 64 + ntile * 32 + l32] = val;
      }
    }
    __syncthreads();
    {
      const float4 w4 = *(const float4*)(WA + sj * 64 + 4 * q);
      const float4 a4 = *(const float4*)(WA + (32 + sj) * 64 + 4 * q);
      const float4 ka = *(const float4*)(CS + 64 + 4 * q);
      const float4 brk = *(const float4*)(CS + 128 + 4 * q);
      const float wv4[4] = {w4.x, w4.y, w4.z, w4.w}, av4[4] = {a4.x, a4.y, a4.z, a4.w};
      const float kav[4] = {ka.x, ka.y, ka.z, ka.w}, bkv[4] = {brk.x, brk.y, brk.z, brk.w};
      float aa[4], wr[4], bb[4], kd[4];
      float br = 0.f, kr = 0.f, bs = 0.f;
#pragma unroll
      for (int e = 0; e < 4; ++e) {
        aa[e] = -kk4[e]; wr[e] = wv4[e] * r4[e]; bb[e] = kk4[e] * av4[e];
        kd[e] = k4[e] * (1.f + (av4[e] - 1.f) * kav[e]);
        br += bb[e] * r4[e]; kr += kd[e] * r4[e]; bs += r4[e] * kd[e] * bkv[e];
      }
      br = sum16(br); kr = sum16(kr); bs = sum16(bs);
      float* o = OP + sj * 392 + 4 * q;
      *(float4*)(o) = make_float4(aa[0], aa[1], aa[2], aa[3]);
      *(float4*)(o + 64) = make_float4(wr[0], wr[1], wr[2], wr[3]);
      *(float4*)(o + 128) = w4;
      *(float4*)(o + 192) = make_float4(bb[0], bb[1], bb[2], bb[3]);
      *(float4*)(o + 256) = make_float4(kd[0], kd[1], kd[2], kd[3]);
      *(float4*)(o + 320) = make_float4(v4[0], v4[1], v4[2], v4[3]);
      if (q == 0) {
        OP[sj * 392 + 384] = br; OP[sj * 392 + 385] = kr;
        const int sidx = c * 32 + sj;
        if (sidx < L) { const int tok = d == 0 ? sidx : L - 1 - sidx; p.bsc[((size_t)d * TP + r0 + tok) * 8 + hd] = bs; }
      }
    }
    __syncthreads();
  };

  prefetch(0);
  stage(0);
  for (int c = 0; c < nch; ++c) {
    if (c + 1 < nch) prefetch(c + 1);
    const int nst = min(32, L - c * 32);
    for (int jj = 0; jj < nst; ++jj) {
      const float* o = OP + jj * 392;
      const float4 a0 = *(const float4*)(o + cg8 * 8), a1 = *(const float4*)(o + cg8 * 8 + 4);
      const float4 y0 = *(const float4*)(o + 64 + cg8 * 8), y1 = *(const float4*)(o + 64 + cg8 * 8 + 4);
      const float4 w0 = *(const float4*)(o + 128 + cg8 * 8), w1 = *(const float4*)(o + 128 + cg8 * 8 + 4);
      const float4 b0 = *(const float4*)(o + 192 + cg8 * 8), b1 = *(const float4*)(o + 192 + cg8 * 8 + 4);
      const float4 k0 = *(const float4*)(o + 256 + cg8 * 8), k1 = *(const float4*)(o + 256 + cg8 * 8 + 4);
      const float vv = o[320 + row];
      const float2 sc = *(const float2*)(o + 384);
      float da = S[0] * a0.x + S[1] * a0.y + S[2] * a0.z + S[3] * a0.w + S[4] * a1.x + S[5] * a1.y + S[6] * a1.z + S[7] * a1.w;
      float dy = S[0] * y0.x + S[1] * y0.y + S[2] * y0.z + S[3] * y0.w + S[4] * y1.x + S[5] * y1.y + S[6] * y1.z + S[7] * y1.w;
      da = dpp_sum8(da); dy = dpp_sum8(dy);
      const float yv = dy + da * sc.x + vv * sc.y;
      S[0] = S[0] * w0.x + da * b0.x + vv * k0.x; S[1] = S[1] * w0.y + da * b0.y + vv * k0.y;
      S[2] = S[2] * w0.z + da * b0.z + vv * k0.z; S[3] = S[3] * w0.w + da * b0.w + vv * k0.w;
      S[4] = S[4] * w1.x + da * b1.x + vv * k1.x; S[5] = S[5] * w1.y + da * b1.y + vv * k1.y;
      S[6] = S[6] * w1.z + da * b1.z + vv * k1.z; S[7] = S[7] * w1.w + da * b1.w + vv * k1.w;
      if (cg8 == 0) YB[jj * 64 + row] = yv;
    }
    __syncthreads();
    {
      const int sidx = c * 32 + sj;
      if (sidx < L) {
        const int tok = d == 0 ? sidx : L - 1 - sidx;
        const float4 yv = *(const float4*)(YB + sj * 64 + 4 * q);
        store4((u16*)p.out + (size_t)(r0 + tok) * 1024 + d * 512 + hd * 64 + 4 * q, yv.x, yv.y, yv.z, yv.w);
      }
    }
    if (c + 1 < nch) stage(c + 1);
  }
  __syncthreads();
}

typedef float f2 __attribute__((ext_vector_type(2)));
DI f2 mk2(float a, float b) { f2 r; r.x = a; r.y = b; return r; }
#define LDS_FENCE() asm volatile("s_waitcnt lgkmcnt(0)" ::: "memory")

template <int CPL>
DI void scan_block2(CP p, int layer, int s, int d, int hd, int rowhalf, char* smem) {
  float* OP = (float*)smem;
  float* YB = OP + 2 * 32 * 392;
  u16* XL = (u16*)(YB + 2 * 32 * 64);
  float* MU = (float*)(XL + 2 * 32 * 72);
  float* CS = MU + 640;
  u16* WL = (u16*)(CS + 192);
  const int tid = tidx(), lane = tid & 63, wv = tid >> 6, l32 = lane & 31, hh = lane >> 5;
  const int L = seq_len(s), r0 = seq_start(s);
  const int aoff0 = hd * 64, aoff1 = 512 + hd * 64, aoff2 = 1024 + hd * 64, aoff3 = 1536 + d * 64, aoff4 = 1664 + d * 64;
  __syncthreads();
  for (int i = tid; i < 640; i += NTHR) {
    int a = i >> 7, w = (i >> 6) & 1, c = i & 63;
    int off = a == 0 ? aoff0 : a == 1 ? aoff1 : a == 2 ? aoff2 : a == 3 ? aoff3 : aoff4;
    MU[i] = p.shift_mu[(size_t)(layer * 2 + w) * 1952 + off + c];
  }
#pragma unroll
  for (int i = 0; i < 2; ++i) {
    const int idx = tid + i * NTHR, mat = idx >> 9, col = (idx >> 3) & 63, kc = idx & 7;
    *(uint4*)(WL + (mat * 64 + col) * 72 + kc * 8) = *(const uint4*)(p.wM + (mat ? OFF_A : OFF_DEC) + (size_t)(d * 512 + hd * 64 + col) * 64 + kc * 8);
  }
  if (tid < 64) {
    CS[tid] = p.key_k_k[layer * 512 + hd * 64 + tid];
    CS[64 + tid] = p.key_k_a[layer * 512 + hd * 64 + tid];
    CS[128 + tid] = p.bonus_r_k[layer * 512 + hd * 64 + tid];
  }
  __syncthreads();
  const int nch = (L + 31) >> 5;

  if (wv >= 4) {
    const int sw = wv - 4;
    const int q = lane & 15;
    float bias[2][2];
#pragma unroll
    for (int mat = 0; mat < 2; ++mat)
#pragma unroll
      for (int nt2 = 0; nt2 < 2; ++nt2)
        bias[mat][nt2] = mat ? p.iclr_a0[(size_t)(layer * 2 + d) * 512 + hd * 64 + nt2 * 32 + l32]
                             : p.decay_w0[(size_t)(layer * 2 + d) * 512 + hd * 64 + nt2 * 32 + l32];
    uint2 raw[2][5];
    auto load_raw = [&](int c) {
#pragma unroll
      for (int u = 0; u < 2; ++u) {
        const int sj = 8 * sw + 4 * u + (lane >> 4);
        const int sidc = min(c * 32 + sj, L - 1);
        const int tok = d == 0 ? sidc : L - 1 - sidc;
        const u16* base = p.regB + (size_t)(r0 + tok) * 1952 + 4 * q;
        raw[u][0] = *(const uint2*)(base + aoff0); raw[u][1] = *(const uint2*)(base + aoff1); raw[u][2] = *(const uint2*)(base + aoff2);
        raw[u][3] = *(const uint2*)(base + aoff3); raw[u][4] = *(const uint2*)(base + aoff4);
      }
    };
    auto stage = [&](int c) {
      float r4[2][4], k4[2][4], kk4[2][4], v4[2][4];
#pragma unroll
      for (int u = 0; u < 2; ++u) {
        const int sj = 8 * sw + 4 * u + (lane >> 4);
        r4[u][0] = bflo(raw[u][0].x); r4[u][1] = bfhi(raw[u][0].x); r4[u][2] = bflo(raw[u][0].y); r4[u][3] = bfhi(raw[u][0].y);
        k4[u][0] = bflo(raw[u][1].x); k4[u][1] = bfhi(raw[u][1].x); k4[u][2] = bflo(raw[u][1].y); k4[u][3] = bfhi(raw[u][1].y);
        v4[u][0] = bflo(raw[u][2].x); v4[u][1] = bfhi(raw[u][2].x); v4[u][2] = bflo(raw[u][2].y); v4[u][3] = bfhi(raw[u][2].y);
        *(uint2*)(XL + sj * 72 + 4 * q) = raw[u][3];
        *(uint2*)(XL + 32 * 72 + sj * 72 + 4 * q) = raw[u][4];
        const float4 kkw = *(const float4*)(CS + 4 * q);
        float x0 = k4[u][0] * kkw.x, x1 = k4[u][1] * kkw.y, x2 = k4[u][2] * kkw.z, x3 = k4[u][3] * kkw.w;
        float ss = sum16(x0 * x0 + x1 * x1 + x2 * x2 + x3 * x3);
        float inv = __builtin_amdgcn_rsqf(fmaxf(ss, 1e-24f));
        kk4[u][0] = x0 * inv; kk4[u][1] = x1 * inv; kk4[u][2] = x2 * inv; kk4[u][3] = x3 * inv;
      }
      LDS_FENCE();
      float* OPn = OP + (c & 1) * 32 * 392;
#pragma unroll
      for (int mat = 0; mat < 2; ++mat)
#pragma unroll
        for (int nt2 = 0; nt2 < 2; ++nt2) {
          f32x16 acc;
#pragma unroll
          for (int r = 0; r < 16; ++r) acc[r] = 0.f;
          const u16* xb = XL + mat * 32 * 72 + (8 * sw + (l32 & 7)) * 72 + hh * 8;
#pragma unroll
          for (int ks = 0; ks < 4; ++ks) acc = MFMA(*(const bf16x8*)(xb + ks * 16), *(const bf16x8*)(WL + (mat * 64 + nt2 * 32 + l32) * 72 + ks * 16 + hh * 8), acc);
#pragma unroll
          for (int r = 0; r < 4; ++r) {
            float x = acc[r] + bias[mat][nt2];
            float sg = sigmoidf_(x);
            float val = mat ? sg : __expf(-0.6065306597126334f * sg);
            OPn[(8 * sw + 4 * hh + r) * 392 + (mat ? 0 : 128) + nt2 * 32 + l32] = val;
          }
        }
      LDS_FENCE();
#pragma unroll
      for (int u = 0; u < 2; ++u) {
        const int sj = 8 * sw + 4 * u + (lane >> 4);
        const float4 w4 = *(const float4*)(OPn + sj * 392 + 128 + 4 * q);
        const float4 a4 = *(const float4*)(OPn + sj * 392 + 4 * q);
        const float4 ka = *(const float4*)(CS + 64 + 4 * q);
        const float4 brk = *(const float4*)(CS + 128 + 4 * q);
        const float wv4[4] = {w4.x, w4.y, w4.z, w4.w}, av4[4] = {a4.x, a4.y, a4.z, a4.w};
        const float kav[4] = {ka.x, ka.y, ka.z, ka.w}, bkv[4] = {brk.x, brk.y, brk.z, brk.w};
        float aa[4], wr[4], bb[4], kd[4];
        float br = 0.f, kr = 0.f, bs = 0.f;
#pragma unroll
        for (int e = 0; e < 4; ++e) {
          aa[e] = -kk4[u][e]; wr[e] = wv4[e] * r4[u][e]; bb[e] = kk4[u][e] * av4[e];
          kd[e] = k4[u][e] * (1.f + (av4[e] - 1.f) * kav[e]);
          br += bb[e] * r4[u][e]; kr += kd[e] * r4[u][e]; bs += r4[u][e] * kd[e] * bkv[e];
        }
        br = sum16(br); kr = sum16(kr); bs = sum16(bs);
        float* o = OPn + sj * 392 + 4 * q;
        *(float4*)(o) = make_float4(aa[0], aa[1], aa[2], aa[3]);
        *(float4*)(o + 64) = make_float4(wr[0], wr[1], wr[2], wr[3]);
        *(float4*)(o + 128) = w4;
        *(float4*)(o + 192) = make_float4(bb[0], bb[1], bb[2], bb[3]);
        *(float4*)(o + 256) = make_float4(kd[0], kd[1], kd[2], kd[3]);
        *(float4*)(o + 320) = make_float4(v4[u][0], v4[u][1], v4[u][2], v4[u][3]);
        if (q == 0) {
          OPn[sj * 392 + 384] = br; OPn[sj * 392 + 385] = kr;
          const int sidx = c * 32 + sj;
          if (sidx < L && rowhalf == 0) { const int tok = d == 0 ? sidx : L - 1 - sidx; p.bsc[((size_t)d * TP + r0 + tok) * 8 + hd] = bs; }
        }
      }
    };
    auto writeout = [&](int c) {
      const float* yb = YB + (c & 1) * 2048;
#pragma unroll
      for (int u = 0; u < 2; ++u) {
        const int sj = 8 * sw + 4 * u + (lane >> 4);
        const int sidx = c * 32 + sj;
        const bool mine = CPL == 16 ? true : ((q >> 3) == rowhalf);
        if (sidx < L && mine) {
          const int tok = d == 0 ? sidx : L - 1 - sidx;
          const float4 yv = *(const float4*)(yb + sj * 64 + 4 * q);
          store4((u16*)p.out + (size_t)(r0 + tok) * 1024 + d * 512 + hd * 64 + 4 * q, yv.x, yv.y, yv.z, yv.w);
        }
      }
    };
    load_raw(0);
    stage(0);
    if (nch > 1) load_raw(1);
    __syncthreads();
    for (int c = 0; c < nch; ++c) {
      if (c + 1 < nch) { stage(c + 1); if (c + 2 < nch) load_raw(c + 2); }
      if (c >= 1) writeout(c - 1);
      __syncthreads();
    }
    writeout(nch - 1);
  } else {
    constexpr int LPRW = 64 / CPL;
    constexpr int NV = CPL / 2;
    const int cg = lane % LPRW;
    const int row = (CPL == 8 ? rowhalf * 32 + wv * 8 : wv * 16) + lane / LPRW;
    f2 S[NV];
#pragma unroll
    for (int i = 0; i < NV; ++i) S[i] = mk2(0.f, 0.f);
    __builtin_amdgcn_s_setprio(3);
    __syncthreads();
    for (int c = 0; c < nch; ++c) {
      const int nst = min(32, L - c * 32);
      const float* ob = OP + (c & 1) * 32 * 392;
      float* yb = YB + (c & 1) * 2048;
      float* ydst = cg == 0 ? yb + row : (float*)(smem + 147712) + lane;
      const int ystride = cg == 0 ? 64 : 0;
      float4 ca[CPL / 4], cy[CPL / 4], cw[CPL / 4], cb[CPL / 4], ck[CPL / 4];
      float cvv; float2 csc;
      {
        const float* o = ob + cg * CPL;
#pragma unroll
        for (int i = 0; i < CPL / 4; ++i) {
          ca[i] = *(const float4*)(o + 4 * i); cy[i] = *(const float4*)(o + 64 + 4 * i); cw[i] = *(const float4*)(o + 128 + 4 * i);
          cb[i] = *(const float4*)(o + 192 + 4 * i); ck[i] = *(const float4*)(o + 256 + 4 * i);
        }
        cvv = ob[320 + row]; csc = *(const float2*)(ob + 384);
      }
#pragma unroll 4
      for (int jj = 0; jj < nst; ++jj) {
        float4 na[CPL / 4], ny[CPL / 4], nw[CPL / 4], nb[CPL / 4], nk[CPL / 4];
        float nvv; float2 nsc;
        {
          const int jn = jj + 1;
          const float* o = ob + jn * 392 + cg * CPL;
#pragma unroll
          for (int i = 0; i < CPL / 4; ++i) {
            na[i] = *(const float4*)(o + 4 * i); ny[i] = *(const float4*)(o + 64 + 4 * i); nw[i] = *(const float4*)(o + 128 + 4 * i);
            nb[i] = *(const float4*)(o + 192 + 4 * i); nk[i] = *(const float4*)(o + 256 + 4 * i);
          }
          nvv = ob[jn * 392 + 320 + row]; nsc = *(const float2*)(ob + jn * 392 + 384);
        }
        f2 A[NV], Y[NV], W[NV], B[NV], K[NV];
#pragma unroll
        for (int i = 0; i < CPL / 4; ++i) {
          A[2 * i] = mk2(ca[i].x, ca[i].y); A[2 * i + 1] = mk2(ca[i].z, ca[i].w);
          Y[2 * i] = mk2(cy[i].x, cy[i].y); Y[2 * i + 1] = mk2(cy[i].z, cy[i].w);
          W[2 * i] = mk2(cw[i].x, cw[i].y); W[2 * i + 1] = mk2(cw[i].z, cw[i].w);
          B[2 * i] = mk2(cb[i].x, cb[i].y); B[2 * i + 1] = mk2(cb[i].z, cb[i].w);
          K[2 * i] = mk2(ck[i].x, ck[i].y); K[2 * i + 1] = mk2(ck[i].z, ck[i].w);
        }
        const float vv = cvv;
        f2 pa0 = S[0] * A[0], pa1 = S[1] * A[1], py0 = S[0] * Y[0], py1 = S[1] * Y[1];
#pragma unroll
        for (int i = 2; i < NV; i += 2) {
          pa0 = S[i] * A[i] + pa0; pa1 = S[i + 1] * A[i + 1] + pa1;
          py0 = S[i] * Y[i] + py0; py1 = S[i + 1] * Y[i + 1] + py1;
        }
        pa0 = pa0 + pa1; py0 = py0 + py1;
        float da = pa0.x + pa0.y, dy = py0.x + py0.y;
        const f2 vvv = mk2(vv, vv);
        f2 SW[NV];
#pragma unroll
        for (int i = 0; i < NV; ++i) SW[i] = S[i] * W[i] + vvv * K[i];
        da += __int_as_float(__builtin_amdgcn_update_dpp(0, __float_as_int(da), 0xB1, 0xf, 0xf, false));
        dy += __int_as_float(__builtin_amdgcn_update_dpp(0, __float_as_int(dy), 0xB1, 0xf, 0xf, false));
        da += __int_as_float(__builtin_amdgcn_update_dpp(0, __float_as_int(da), 0x4E, 0xf, 0xf, false));
        dy += __int_as_float(__builtin_amdgcn_update_dpp(0, __float_as_int(dy), 0x4E, 0xf, 0xf, false));
        if (CPL == 8) {
          da += __int_as_float(__builtin_amdgcn_update_dpp(0, __float_as_int(da), 0x141, 0xf, 0xf, false));
          dy += __int_as_float(__builtin_amdgcn_update_dpp(0, __float_as_int(dy), 0x141, 0xf, 0xf, false));
        }
        const f2 dav = mk2(da, da);
#pragma unroll
        for (int i = 0; i < NV; ++i) S[i] = dav * B[i] + SW[i];
        const float yv = dy + da * csc.x + vv * csc.y;
        ydst[jj * ystride] = yv;
#pragma unroll
        for (int i = 0; i < CPL / 4; ++i) { ca[i] = na[i]; cy[i] = ny[i]; cw[i] = nw[i]; cb[i] = nb[i]; ck[i] = nk[i]; }
        cvv = nvv; csc = nsc;
      }
      __syncthreads();
    }
    __builtin_amdgcn_s_setprio(0);
  }
  __syncthreads();
}

DI void shift_item(CP p, int layer, int ch, char* smem) {
  const int tid = tidx();
  int s, c;
  if (ch < 258) { s = ch / 129; c = ch - s * 129; } else { int x = ch - 258; s = 2 + x / 33; c = x - (s - 2) * 33; }
  const int L = seq_len(s), r0 = seq_start(s) + c * 64;
  const int nrows = min(64, L - c * 64);
  const int cgp = tid & 255, rg = tid >> 8;
  const int col = cgp * 8;
  const int rlo = rg * 32, rhi = min(rlo + 32, nrows);
  const bool act = cgp < 244 && rlo < nrows;
  typedef unsigned u32x4 __attribute__((ext_vector_type(4)));
  u32x4 prev = {0u, 0u, 0u, 0u}, cur = prev, lastn = prev;
  float mu0[8], mu1[8];
  u16* base = p.regB + (size_t)r0 * 1952 + col;
  if (act) {
#pragma unroll
    for (int e = 0; e < 8; ++e) { mu0[e] = p.shift_mu[(size_t)(layer * 2) * 1952 + col + e]; mu1[e] = p.shift_mu[(size_t)(layer * 2 + 1) * 1952 + col + e]; }
    if (rlo > 0) prev = *(const u32x4*)(base + (size_t)(rlo - 1) * 1952);
    else if (c > 0) prev = *(const u32x4*)(halo_ptr(p) + ((size_t)(ch - 1) * 2 + 1) * 1952 + col);
    cur = *(const u32x4*)(base + (size_t)rlo * 1952);
    if (rhi < nrows) lastn = *(const u32x4*)(base + (size_t)rhi * 1952);
    else if (c * 64 + nrows < L) lastn = *(const u32x4*)(halo_ptr(p) + ((size_t)(ch + 1) * 2) * 1952 + col);
  }
  __syncthreads();
  if (act) {
    const int kind = col < 1536 ? 0 : col < 1664 ? 1 : col < 1792 ? 0 : 2;
    for (int rb = rlo; rb < rhi; rb += 8) {
      u32x4 rw[9];
      rw[0] = cur;
#pragma unroll
      for (int i = 1; i < 9; ++i) { const int r = rb + i; rw[i] = (r < rhi) ? *(const u32x4*)(base + (size_t)r * 1952) : lastn; }
#pragma unroll
      for (int i = 0; i < 8; ++i) {
        const u32x4 cc = rw[i], nn = rw[i + 1];
        const unsigned pc[4] = {cc.x, cc.y, cc.z, cc.w}, pm[4] = {prev.x, prev.y, prev.z, prev.w}, pn[4] = {nn.x, nn.y, nn.z, nn.w};
        unsigned o[4];
#pragma unroll
        for (int e = 0; e < 4; ++e) {
          float c0 = bflo(pc[e]), c1 = bfhi(pc[e]);
          float x0 = c0 + mu0[2 * e] * (bflo(pm[e]) - c0) + mu1[2 * e] * (bflo(pn[e]) - c0);
          float x1 = c1 + mu0[2 * e + 1] * (bfhi(pm[e]) - c1) + mu1[2 * e + 1] * (bfhi(pn[e]) - c1);
          if (kind == 1) { x0 = 1.f - 2.f * __builtin_amdgcn_rcpf(__expf(2.f * x0) + 1.f); x1 = 1.f - 2.f * __builtin_amdgcn_rcpf(__expf(2.f * x1) + 1.f); }
          else if (kind == 2) { x0 = sigmoidf_(x0); x1 = sigmoidf_(x1); }
          o[e] = pack2(x0, x1);
        }
        { u32x4 ov = {o[0], o[1], o[2], o[3]}; *(u32x4*)(base + (size_t)(rb + i) * 1952) = ov; }
        prev = cc;
      }
      cur = rw[8];
    }
  }
  __syncthreads();
}

DI void init_rows(CP p, int item) {
  const int lane = tidx() & 63, wv = tidx() >> 6;
  const int r = item * 8 + wv;
  if (r >= TP) return;
  u16* dst = p.hb + (size_t)r * 1024 + lane * 16;
  float ss = 0.f;
  if (r < T) {
    int s, pos, L; row2seq(r, s, pos, L);
    const float* src = pos < 16 ? p.meta + pos * 1024
                     : (s < 2 ? p.x_prompt + ((size_t)s * 8192 + pos - 16) * 1024 : p.x_sample + ((size_t)(s - 2) * 2048 + pos - 16) * 1024);
    src += lane * 16;
    unsigned pk[8];
#pragma unroll
    for (int i = 0; i < 4; ++i) {
      float4 v = *(const float4*)(src + 4 * i);
      pk[2 * i] = pack2(v.x, v.y); pk[2 * i + 1] = pack2(v.z, v.w);
      float a = bflo(pk[2 * i]), b = bfhi(pk[2 * i]), c = bflo(pk[2 * i + 1]), dd = bfhi(pk[2 * i + 1]);
      ss += a * a + b * b + c * c + dd * dd;
    }
    *(uint4*)dst = make_uint4(pk[0], pk[1], pk[2], pk[3]);
    *(uint4*)(dst + 8) = make_uint4(pk[4], pk[5], pk[6], pk[7]);
  } else {
    *(uint4*)dst = make_uint4(0, 0, 0, 0);
    *(uint4*)(dst + 8) = make_uint4(0, 0, 0, 0);
  }
#pragma unroll
  for (int o = 32; o > 0; o >>= 1) ss += __shfl_xor(ss, o);
  if (lane < 16) p.ssq[(size_t)lane * TP + r] = lane == 0 ? ss : 0.f;
}
DI void init_rope(CP p, int item) {
  const int idx = item * NTHR + tidx();
  if (idx >= LPR * 16) return;
  const int pos = idx >> 4, i = idx & 15;
  double rev = (double)pos * ROPE_INV[i] * 0.15915494309189535;
  rev -= rint(rev);
  const float fr = (float)rev;
  p.ropec[idx] = __builtin_amdgcn_cosf(fr);
  p.ropes[idx] = __builtin_amdgcn_sinf(fr);
}
DI void final_rows(CP p, int item) {
  const int lane = tidx() & 63, wv = tidx() >> 6;
  const int orow = item * 8 + wv;
  int r;
  if (orow < 16384) { int s = orow >> 13; r = s * LPR + 16 + (orow & 8191); }
  else { int x = orow - 16384; int s = x >> 11; r = 2 * LPR + s * LSM + 16 + (x & 2047); }
  const float rs = rstd16(p.ssq, r);
  const u16* src = p.hb + (size_t)r * 1024 + lane * 16;
  uint4 a = *(const uint4*)src, b = *(const uint4*)(src + 8);
  unsigned w[8] = {a.x, a.y, a.z, a.w, b.x, b.y, b.z, b.w};
  float* dst = p.out + (size_t)orow * 1024 + lane * 16;
  const float* gn = p.final_norm + lane * 16;
#pragma unroll
  for (int i = 0; i < 4; ++i) {
    float4 o;
    o.x = bflo(w[2 * i]) * rs * gn[4 * i]; o.y = bfhi(w[2 * i]) * rs * gn[4 * i + 1];
    o.z = bflo(w[2 * i + 1]) * rs * gn[4 * i + 2]; o.w = bfhi(w[2 * i + 1]) * rs * gn[4 * i + 3];
    *(float4*)(dst + 4 * i) = o;
  }
}

#define XB_TMO      128
#define XB_XCNT(j)  (256  + 64 * (j))
#define XB_XSUB(j)  (1280 + 64 * (j))
#define XB_XGEN(j)  (2304 + 64 * (j))
#define XB_TOP      3328
#define XB_TOPGEN   3392
#define XCD_BAR_WORDS 3456
#define XB_SPIN_CAP (1u << 18)
#define LAS __attribute__((address_space(3)))

__device__ __forceinline__ unsigned xb_ld(unsigned* p)              { return __hip_atomic_load(p, __ATOMIC_RELAXED, __HIP_MEMORY_SCOPE_AGENT); }
__device__ __forceinline__ unsigned xb_add(unsigned* p, unsigned v) { return __hip_atomic_fetch_add(p, v, __ATOMIC_RELAXED, __HIP_MEMORY_SCOPE_AGENT); }
__device__ __forceinline__ unsigned xb_xcc_id() { return (unsigned)__builtin_amdgcn_s_getreg((3 << 11) | 20) & 0xFu; }
#define XB_SPIN(cond, bar) do { unsigned _sp = 0; while (cond) { __builtin_amdgcn_s_sleep(1); \
    if ((++_sp & 255u) == 0u) { if (xb_ld(&(bar)[XB_TMO])) break; if (_sp > XB_SPIN_CAP) { atomicAdd(&(bar)[XB_TMO], 1u); break; } } } } while (0)

struct XcdBarrier {
    unsigned* bar; unsigned x;
    volatile LAS unsigned* st;
};

__device__ __forceinline__ XcdBarrier xcd_barrier_post(unsigned* bar, volatile LAS unsigned* st) {
    XcdBarrier b; b.bar = bar; b.x = xb_xcc_id(); b.st = st;
    if (threadIdx.x == 0) (void)xb_add(&bar[XB_XCNT(b.x)], 1u);
    return b;
}
__device__ __forceinline__ void xcd_barrier_complete(unsigned* bar, unsigned x, unsigned& nloc, unsigned& nx) {
    const unsigned G = gridDim.x * gridDim.y * gridDim.z;
    unsigned sum, cnt, mine, sp = 0u;
    for (;;) {
        sum = 0u; cnt = 0u; mine = 0u;
#pragma unroll
        for (unsigned j = 0; j < 16; ++j) { const unsigned c = xb_ld(&bar[XB_XCNT(j)]); sum += c; cnt += (c > 0u) ? 1u : 0u; mine = (j == x) ? c : mine; }
        if (sum == G) break;
        __builtin_amdgcn_s_sleep(1);
        if ((++sp & 255u) == 0u) { if (xb_ld(&bar[XB_TMO])) break; if (sp > XB_SPIN_CAP) { atomicAdd(&bar[XB_TMO], 1u); break; } }
    }
    nloc = mine > 0u ? mine : 1u; nx = cnt > 0u ? cnt : 1u;
}

__device__ __forceinline__ void xcd_barrier(const XcdBarrier& b) {
    asm volatile("s_waitcnt vmcnt(0)" ::: "memory");
    __syncthreads();
    if (threadIdx.x == 0) {
        unsigned* bar = b.bar;
        __builtin_amdgcn_s_waitcnt(0);
        unsigned nloc = b.st[0], nx = b.st[1];
        if (nloc == 0u) { xcd_barrier_complete(bar, b.x, nloc, nx); b.st[0] = nloc; b.st[1] = nx; }
        const unsigned old = xb_add(&bar[XB_XSUB(b.x)], 1u);
        const unsigned gen = old / nloc;
        if (old + 1u == (gen + 1u) * nloc) {
            __builtin_amdgcn_fence(__ATOMIC_RELEASE, "agent");
            asm volatile("s_waitcnt vmcnt(0)" ::: "memory");
            const unsigned og = xb_add(&bar[XB_TOP], 1u);
            const unsigned tg = og / nx;
            if (og + 1u == (tg + 1u) * nx) xb_add(&bar[XB_TOPGEN], 1u);
            else XB_SPIN(xb_ld(&bar[XB_TOPGEN]) == tg, bar);
            __builtin_amdgcn_fence(__ATOMIC_ACQUIRE, "agent");
            xb_add(&bar[XB_XGEN(b.x)], 1u);
            asm volatile("s_waitcnt vmcnt(0)" ::: "memory");
        } else {
            XB_SPIN(xb_ld(&bar[XB_XGEN(b.x)]) == gen, bar);
            __builtin_amdgcn_fence(__ATOMIC_ACQUIRE, "agent");
            asm volatile("s_waitcnt vmcnt(0)" ::: "memory");
        }
    }
    __syncthreads();
}

constexpr int NPHASE = 21;
#ifndef ONLY
#define EN(x) true
#else
#define EN(x) ((x) == ONLY)
#endif
DI void run_phase(CP p, int ph, char* smem) {
  const int bid = blockIdx.x, nb = gridDim.x;
  const int fidx = (bid & 7) ? (bid >> 3) * 7 + (bid & 7) - 1 : -1, nfill = (nb >> 3) * 7;
  if (EN(100) && ph == 0) {
    const int n0 = NCONV_FFN, n1 = n0, n2 = n1 + TP / 8, n3 = n2 + (LPR * 16 + NTHR - 1) / NTHR;
    for (int it = bid; it < n3; it += nb) {
      if (it < n0) conv_ffn(p, 0, 0, it, smem);
      else if (it < n2) init_rows(p, it - n1);
      else init_rope(p, it - n2);
    }
    if (bid == 0 && tidx() < 4) p.ctr[tidx()] = 0u;
    return;
  }
  if (ph == 10) return;
  if (EN(102) && ph == 20) { for (int it = bid; it < 4096; it += nb) final_rows(p, it); return; }
  const int layer = ph > 10 ? 1 : 0;
  const int k = ph - (layer ? 11 : 1);
  GArgs g{};
  g.layer = layer; g.scale = 1.f;
  u16* outb = (u16*)p.out;
  switch (k) {
    case 0: case 7: if (EN(0)) {
      g.a0 = p.hb; g.ld0 = 1024; g.split = 1 << 30; g.ks0 = 64; g.a1 = p.hb; g.ld1 = 1024; g.W = (layer == 1 && k == 0) ? p.kn : p.wF; g.K = 1024;
      gemm_phase<0, EPI_UP, 256>(p, g, 22, smem);
      if (k == 7 && layer == 0 && fidx >= 0) for (int it = fidx; it < NCONV_FFN; it += nfill) conv_ffn(p, 1, 0, it, smem);
    } break;
    case 1: case 8: if (EN(1)) {
      g.a0 = p.regB; g.ld0 = 1408; g.split = 22; g.ks0 = 64; g.a1 = outb; g.ld1 = 1408; g.W = ((layer == 1 && k == 1) ? p.kn : p.wF) + OFF_WD; g.K = 2816; g.scale = 0.5f;
      gemm_phase<0, EPI_RES, 128>(p, g, 8, smem);
      if (layer == 0 && fidx >= 0) for (int it = fidx; it < NCONV_MIX; it += nfill) conv_mix(p, k == 1 ? 0 : 1, it, smem);
    } break;
    case 2: if (EN(2)) {
      g.a0 = p.hb; g.ld0 = 1024; g.split = 1 << 30; g.ks0 = 64; g.a1 = p.hb; g.ld1 = 1024; g.W = p.wM + OFF_IN; g.K = 1024;
      gemm_phase<0, EPI_INPROJ, 128>(p, g, 20, smem);
    } break;
    case 3: if (EN(3)) {
      const int nq = NMT * 6, nkv = NMT * 8, nsh = 522, ntot = nq + nkv + nsh;
      for (int it = bid; it < ntot; it += nb) {
        if (it < nq) {
          g.a0 = outb; g.ld0 = 512; g.split = 1 << 30; g.ks0 = 64; g.a1 = outb; g.ld1 = 512; g.W = p.wM + OFF_UQ; g.K = 256;
          gemm_phase_item<0, EPI_Q>(p, g, it, 6, smem);
        } else if (it < nq + nkv) {
          g.a0 = outb + 256; g.ld0 = 512; g.split = 1 << 30; g.ks0 = 64; g.a1 = outb; g.ld1 = 512; g.W = p.wM + OFF_UKV; g.K = 128;
          gemm_phase_item<0, EPI_KV>(p, g, it - nq, 8, smem);
        } else shift_item(p, layer, it - nq - nkv, smem);
      }
    } break;
    case 4: if (EN(4)) {
      for (int sc = bid; sc < 192; sc += nb) {
        if (sc < 64) { int x = sc >> 1; scan_block2<8>(p, layer, x >> 4, (x >> 3) & 1, x & 7, sc & 1, smem); }
        else { int x = sc - 64; scan_block2<16>(p, layer, 2 + (x >> 4), (x >> 3) & 1, x & 7, 0, smem); }
      }
      unsigned* bc = (unsigned*)(smem + SMEM_BYTES - 16);
      while (true) {
        __syncthreads();
        if (tidx() == 0) *bc = atomicAdd(p.ctr + layer, 1u);
        __syncthreads();
        const int it = (int)*bc;
        if (it >= 1104 + NCONV_FFN) break;
        if (it >= 1104) { conv_ffn(p, layer, 1, it - 1104, smem); continue; }
        int s, hd, qb;
        if (it < 528) { s = it / 264; int rem = it - s * 264; hd = rem / 33; qb = rem - hd * 33; }
        else { int x = it - 528; s = 2 + x / 72; int rem = x % 72; hd = rem / 9; qb = rem - hd * 9; }
#ifdef PROBE_ATT2
        attn_item(p, s, hd, qb, smem, p.ctr[8] == 12345u);
        __syncthreads();
#endif
        attn_item(p, s, hd, qb, smem);
      }
    } break;
    case 5: if (EN(5)) {
      g.W = p.wM + OFF_G; g.K = 192; g.a0 = p.regB + 1792; g.a1 = g.a0; g.ld0 = g.ld1 = 1952; g.split = 1 << 30; g.ks0 = 64;
      gemm_phase<0, EPI_POST, 128>(p, g, 4, smem);
    } break;
    case 6: if (EN(6)) {
      g.a0 = outb + (size_t)TP * 1024; g.ld0 = 768; g.split = 8; g.ks0 = 96; g.a1 = outb; g.ld1 = 1024; g.W = p.wM + OFF_OUT; g.K = 1024;
      gemm_phase<0, EPI_RES, 128>(p, g, 8, smem);
    } break;
  }
}

template <bool COOP>
__global__ void __launch_bounds__(NTHR) mega(Params pp, int lo, int hi) {
  extern __shared__ __attribute__((aligned(16))) char smem[];
  const __attribute__((address_space(4))) Params* kp = (const __attribute__((address_space(4))) Params*)__builtin_amdgcn_kernarg_segment_ptr();
  volatile LAS unsigned* st = (volatile LAS unsigned*)(smem + SMEM_BYTES - 32);
  if (threadIdx.x == 0) { st[0] = 0u; st[1] = 0u; }
  __syncthreads();
  XcdBarrier xb = xcd_barrier_post(kp->bar, st);
  for (int ph = lo; ph < hi; ++ph) {
    if (ph == 10) continue;
    asm volatile("" : "+s"(kp));
    run_phase(*kp, ph, smem);
    if (COOP && ph + 1 < hi) {
      if (ph == 0) cg::this_grid().sync();
      else xcd_barrier(xb);
    }
  }
}

extern "C" void kernel_launch(void* const* d_in, const int* in_sizes, int n_in, void* d_out, int out_size, void* d_ws, size_t ws_size,
                              hipStream_t stream) {
  Params p{};
  const float** pf = (const float**)&p;
  for (int i = 0; i < 30; ++i) pf[i] = (const float*)d_in[i];
  p.out = (float*)d_out;
  char* w = (char*)d_ws;
  size_t off = 0;
  auto take = [&](size_t bytes) { char* r = w + off; off += (bytes + 255) & ~(size_t)255; return r; };
  p.hb = (u16*)take((size_t)TP * 1024 * 2);
  p.regB = (u16*)take((size_t)TP * 1952 * 2);
  p.kn = (u16*)take((size_t)TP * 512 * 2);
  p.vt = (u16*)take((size_t)TP * 512 * 2);
  p.wF = (u16*)take((size_t)WF_ELEMS * 2);
  p.wM = (u16*)take((size_t)WM_ELEMS * 2);
  p.ssq = (float*)take((size_t)16 * TP * 4);
  p.ssqq = (float*)take((size_t)6 * TP * 4);
  p.bsc = (float*)take((size_t)2 * TP * 8 * 4);
  p.ropec = (float*)take((size_t)LPR * 16 * 4);
  p.ropes = (float*)take((size_t)LPR * 16 * 4);
  p.ctr = (unsigned*)take(256);
  p.bar = (unsigned*)take((size_t)XCD_BAR_WORDS * 4);
  if (off > ws_size) fprintf(stderr, "workspace too small: need %zu have %zu\n", off, ws_size);
#ifndef MULTI_LAUNCH
  static int grid_blocks = 0;
  if (!grid_blocks) {
    hipFuncSetAttribute((const void*)mega<true>, hipFuncAttributeMaxDynamicSharedMemorySize, SMEM_BYTES);
    int dev = 0, cus = 0, per_cu = 0;
    hipGetDevice(&dev);
    hipDeviceGetAttribute(&cus, hipDeviceAttributeMultiprocessorCount, dev);
    hipOccupancyMaxActiveBlocksPerMultiprocessor(&per_cu, mega<true>, NTHR, SMEM_BYTES);
    if (per_cu > 1) per_cu = 1;
    grid_blocks = cus * per_cu;
  }
  hipMemsetAsync(p.bar, 0, (size_t)XCD_BAR_WORDS * 4, stream);
  int lo = 0, hi = NPHASE;
  void* args[] = {&p, &lo, &hi};
  hipError_t e = hipLaunchCooperativeKernel((void*)mega<true>, dim3(grid_blocks), dim3(NTHR), args, SMEM_BYTES, stream);
  if (e != hipSuccess) fprintf(stderr, "cooperative launch failed: %s (grid %d)\n", hipGetErrorString(e), grid_blocks);
#else
  hipFuncSetAttribute((const void*)mega<false>, hipFuncAttributeMaxDynamicSharedMemorySize, SMEM_BYTES);
  for (int ph = 0; ph < NPHASE; ++ph) mega<false><<<256, NTHR, SMEM_BYTES, stream>>>(p, ph, ph + 1);
#endif
}
```

```cpp
#include <hip/hip_runtime.h>
#include <hip/hip_cooperative_groups.h>
#include <cstdio>
namespace cg = cooperative_groups;

typedef unsigned short u16;
typedef __attribute__((ext_vector_type(8))) short bf16x8;
typedef __attribute__((ext_vector_type(16))) float f32x16;
#define DI __device__ __forceinline__
#define MFMA(a, b, c) __builtin_amdgcn_mfma_f32_32x32x16_bf16((a), (b), (c), 0, 0, 0)

constexpr int T = 32928, TP = 33024, LPR = 8208, LSM = 2064, NMT = 129;
constexpr int NTHR = 512;
constexpr float RMS_EPS = 1e-6f, LNX_EPS = 64e-5f;
constexpr float QSCALE = 0.10206207261596575f * 1.4426950408889634f;
constexpr int OFF_IN = 0, OFF_UQ = 2621440, OFF_UKV = 2818048, OFF_DEC = 2949120, OFF_A = 3014656, OFF_G = 3080192, OFF_OUT = 3178496, WM_ELEMS = 4227072;
constexpr int OFF_WD = 5767168, WF_ELEMS = 8650752;
constexpr int SMEM_BYTES = 149504;

__constant__ double ROPE_INV[16] = {1.0, 0.5623413251903491, 0.31622776601683794, 0.1778279410038923, 0.1, 0.05623413251903491,
  0.031622776601683794, 0.01778279410038923, 0.01, 0.005623413251903491, 0.0031622776601683794, 0.001778279410038923,
  0.001, 0.0005623413251903491, 0.00031622776601683794, 0.0001778279410038923};

struct Params {
  const float *x_prompt, *x_sample, *meta, *ffn1_norm, *ffn1_wg, *ffn1_wu, *ffn1_wd, *mix_norm, *w_in, *shift_mu, *q_norm, *w_uq,
      *kv_norm, *w_ukv, *decay_w0, *decay_w2, *iclr_a0, *iclr_a2, *gate_g2, *key_k_k, *key_k_a, *bonus_r_k, *lnx_w, *lnx_b, *w_out,
      *ffn2_norm, *ffn2_wg, *ffn2_wu, *ffn2_wd, *final_norm;
  float* out;
  u16 *hb, *regB, *kn, *vt, *wF, *wM;
  float *ssq, *ssqq, *bsc, *ropec, *ropes;
  unsigned* ctr;
  unsigned* bar;
};

typedef const __attribute__((address_space(4))) Params& CP;
DI int tidx() { int t = __builtin_amdgcn_workitem_id_x(); asm volatile("" : "+v"(t)); return t; }
DI u16 f2bf(float x) { unsigned u = __float_as_uint(x); u += 0x7fffu + ((u >> 16) & 1u); return (u16)(u >> 16); }
DI float bf2f(u16 b) { return __uint_as_float(((unsigned)b) << 16); }
typedef __bf16 bf16x2_t __attribute__((ext_vector_type(2)));
typedef float fl2_t __attribute__((ext_vector_type(2)));
DI unsigned pack2(float a, float b) { fl2_t f; f.x = a; f.y = b; bf16x2_t r = __builtin_convertvector(f, bf16x2_t); return __builtin_bit_cast(unsigned, r); }
DI float bflo(unsigned u) { return __uint_as_float(u << 16); }
DI float bfhi(unsigned u) { return __uint_as_float(u & 0xffff0000u); }
DI float sigmoidf_(float x) { return __builtin_amdgcn_rcpf(1.f + __expf(-x)); }
DI int crow(int reg, int h) { return (reg & 3) + 8 * (reg >> 2) + 4 * h; }
DI void row2seq(int r, int& s, int& pos, int& L) {
  if (r < 2 * LPR) { s = r >= LPR ? 1 : 0; pos = r - s * LPR; L = LPR; }
  else { int q = (r - 2 * LPR) / LSM; s = 2 + q; pos = r - 2 * LPR - q * LSM; L = LSM; }
}
DI int seq_start(int s) { return s < 2 ? s * LPR : 2 * LPR + (s - 2) * LSM; }
DI int seq_len(int s) { return s < 2 ? LPR : LSM; }
DI float dpp_sum8(float x) {
  x += __int_as_float(__builtin_amdgcn_update_dpp(0, __float_as_int(x), 0xB1, 0xf, 0xf, false));
  x += __int_as_float(__builtin_amdgcn_update_dpp(0, __float_as_int(x), 0x4E, 0xf, 0xf, false));
  x += __int_as_float(__builtin_amdgcn_update_dpp(0, __float_as_int(x), 0x141, 0xf, 0xf, false));
  return x;
}
DI float sum16(float x) {
  x += __int_as_float(__builtin_amdgcn_update_dpp(0, __float_as_int(x), 0x128, 0xf, 0xf, false));
  x += __int_as_float(__builtin_amdgcn_update_dpp(0, __float_as_int(x), 0x124, 0xf, 0xf, false));
  x += __int_as_float(__builtin_amdgcn_update_dpp(0, __float_as_int(x), 0x122, 0xf, 0xf, false));
  x += __int_as_float(__builtin_amdgcn_update_dpp(0, __float_as_int(x), 0x121, 0xf, 0xf, false));
  return x;
}
DI float rstd16(const float* ssq, int m) {
  float s = 0.f;
#pragma unroll
  for (int c = 0; c < 16; ++c) s += ssq[(size_t)c * TP + m];
  return rsqrtf(s * (1.f / 1024.f) + RMS_EPS);
}

struct CJob { const float* src; const float* gain; u16* dst; int K, N, ld, map, nkt; };
DI int rowmap(int map, int n) {
  if (map == 1) return (n >> 5) * 64 + (n & 31);
  if (map == 2) return (n >> 5) * 64 + 32 + (n & 31);
  if (map == 3) return n < 416 ? n : n + 96;
  return n;
}
DI void conv_tile(const CJob& jb, int t, char* smem) {
  float* tile = (float*)smem;
  const int tid = tidx();
  const int kt = t % jb.nkt, ntile = t / jb.nkt;
  const int k0 = kt * 64, n0 = ntile * 64;
  const int tx = tid & 63, ty = tid >> 6;
#pragma unroll
  for (int i = 0; i < 8; ++i) {
    int k = k0 + ty + 8 * i;
    float v = 0.f;
    if (k < jb.K) { v = jb.src[(size_t)k * jb.N + n0 + tx]; if (jb.gain) v *= jb.gain[k]; }
    tile[(ty + 8 * i) * 65 + tx] = v;
  }
  __syncthreads();
  const int ny = tid >> 3, kx = tid & 7;
  uint4 o;
  o.x = pack2(tile[(kx * 8 + 0) * 65 + ny], tile[(kx * 8 + 1) * 65 + ny]);
  o.y = pack2(tile[(kx * 8 + 2) * 65 + ny], tile[(kx * 8 + 3) * 65 + ny]);
  o.z = pack2(tile[(kx * 8 + 4) * 65 + ny], tile[(kx * 8 + 5) * 65 + ny]);
  o.w = pack2(tile[(kx * 8 + 6) * 65 + ny], tile[(kx * 8 + 7) * 65 + ny]);
  *(uint4*)(jb.dst + (size_t)rowmap(jb.map, n0 + ny) * jb.ld + k0 + kx * 8) = o;
  __syncthreads();
}
constexpr int NCONV_FFN = 2112, NCONV_MIX = 1032;
DI void conv_ffn(CP p, int l, int f, int t, char* smem) {
  CJob jb;
  u16* slot = (l == 1 && f == 0) ? p.kn : p.wF;
  const float* wg = f ? p.ffn2_wg : p.ffn1_wg; const float* wu = f ? p.ffn2_wu : p.ffn1_wu; const float* wd = f ? p.ffn2_wd : p.ffn1_wd;
  const float* nr = f ? p.ffn2_norm : p.ffn1_norm;
  if (t < 704) { jb = CJob{wg + (size_t)l * 1024 * 2816, nr + l * 1024, slot, 1024, 2816, 1024, 1, 16}; }
  else if (t < 1408) { t -= 704; jb = CJob{wu + (size_t)l * 1024 * 2816, nr + l * 1024, slot, 1024, 2816, 1024, 2, 16}; }
  else { t -= 1408; jb = CJob{wd + (size_t)l * 2816 * 1024, nullptr, slot + OFF_WD, 2816, 1024, 2816, 0, 44}; }
  conv_tile(jb, t, smem);
}
DI void conv_mix(CP p, int l, int t, char* smem) {
  CJob jb;
  if (t < 592) jb = CJob{p.w_in + (size_t)l * 1024 * 2368, p.mix_norm + l * 1024, p.wM + OFF_IN, 1024, 2368, 1024, 3, 16};
  else if (t < 640) { t -= 592; jb = CJob{p.w_uq + (size_t)l * 256 * 768, p.q_norm + l * 256, p.wM + OFF_UQ, 256, 768, 256, 0, 4}; }
  else if (t < 672) { t -= 640; jb = CJob{p.w_ukv + (size_t)l * 128 * 1024, p.kv_norm + l * 128, p.wM + OFF_UKV, 128, 1024, 128, 0, 2}; }
  else if (t < 688) { t -= 672; int d = t >> 3; t &= 7; jb = CJob{p.decay_w2 + (size_t)(l * 2 + d) * 64 * 512, nullptr, p.wM + OFF_DEC + d * 32768, 64, 512, 64, 0, 1}; }
  else if (t < 704) { t -= 688; int d = t >> 3; t &= 7; jb = CJob{p.iclr_a2 + (size_t)(l * 2 + d) * 64 * 512, nullptr, p.wM + OFF_A + d * 32768, 64, 512, 64, 0, 1}; }
  else if (t < 728) { t -= 704; jb = CJob{p.gate_g2 + (size_t)l * 160 * 512, nullptr, p.wM + OFF_G, 160, 512, 192, 0, 3}; }
  else if (t < 984) { t -= 728; jb = CJob{p.w_out + (size_t)l * 1024 * 1024, nullptr, p.wM + OFF_OUT, 1024, 1024, 1024, 0, 16}; }
  else {
    t -= 984;
    size_t base = (t < 24) ? (size_t)416 * 1024 + (size_t)t * 4096 : (size_t)2464 * 1024 + (size_t)(t - 24) * 4096;
    *(uint4*)(p.wM + OFF_IN + base + tidx() * 8) = make_uint4(0, 0, 0, 0);
    return;
  }
  conv_tile(jb, t, smem);
}

struct GArgs { const u16 *a0, *a1; int ld0, ld1, split, ks0; const u16* W; int K; int layer; float scale; };
enum { EPI_UP = 0, EPI_RES = 1, EPI_INPROJ = 2, EPI_Q = 3, EPI_KV = 4, EPI_POST = 5 };

DI uint4 load_gate(CP p, int layer, int m, int k) {
  uint4 z = make_uint4(0, 0, 0, 0);
  if (m >= T || k >= 160) return z;
  int s, pos, L; row2seq(m, s, pos, L);
  const u16* pb = p.regB + (size_t)m * 1952 + 1792 + k;
  uint4 c = *(const uint4*)pb;
  uint4 pm = pos > 0 ? *(const uint4*)(pb - 1952) : z;
  uint4 pp = pos + 1 < L ? *(const uint4*)(pb + 1952) : z;
  const float* mu0 = p.shift_mu + (size_t)(layer * 2 + 0) * 1952 + 1792 + k;
  const float* mu1 = p.shift_mu + (size_t)(layer * 2 + 1) * 1952 + 1792 + k;
  unsigned cc[4] = {c.x, c.y, c.z, c.w}, mm[4] = {pm.x, pm.y, pm.z, pm.w}, nn[4] = {pp.x, pp.y, pp.z, pp.w};
  unsigned o[4];
#pragma unroll
  for (int e = 0; e < 4; ++e) {
    float c0 = bflo(cc[e]), c1 = bfhi(cc[e]);
    float x0 = c0 + mu0[2 * e] * (bflo(mm[e]) - c0) + mu1[2 * e] * (bflo(nn[e]) - c0);
    float x1 = c1 + mu0[2 * e + 1] * (bfhi(mm[e]) - c1) + mu1[2 * e + 1] * (bfhi(nn[e]) - c1);
    o[e] = pack2(sigmoidf_(x0), sigmoidf_(x1));
  }
  return make_uint4(o[0], o[1], o[2], o[3]);
}

template <int MODE>
DI uint4 load_a(CP p, const GArgs& g, int row, int kt, int kc) {
  if (MODE == 1) return load_gate(p, g.layer, row, kt * 64 + kc * 8);
  const u16* ap = (kt < g.split) ? g.a0 + (size_t)row * g.ld0 + kt * g.ks0 : g.a1 + (size_t)row * g.ld1 + (kt - g.split) * 64;
  return *(const uint4*)(ap + kc * 8);
}

DI u16* halo_ptr(CP p) { return (u16*)p.out + (size_t)TP * 1024 + (size_t)TP * 768 + (size_t)TP * 32; }
DI uint4 ldg16(const u16* p) { uint4 v = *(const uint4*)p; return v; }
DI void sts16(u16* p, uint4 v) { *(uint4*)p = v; }
DI void store4(u16* dst, float a, float b, float c, float d) { *(uint2*)dst = make_uint2(pack2(a, b), pack2(c, d)); }

template <int MODE, int EPI, int BN>
DI void gemm_tile(CP p, const GArgs& g, int mt, int nt, char* smem) {
  constexpr int WN = BN / 64, WM = 8 / WN, MI = 256 / WM / 32, NWC = BN / 64;
  u16* As = (u16*)smem;
  u16* Ws = As + 2 * 256 * 72;
  const int tid = tidx(), lane = tid & 63, wv = tid >> 6, wm = wv / WN, wn = wv % WN, l32 = lane & 31, hh = lane >> 5;
  const int m0 = mt * 256, n0 = nt * BN;
  const int nk = g.K >> 6;
  f32x16 acc[MI][2];
#pragma unroll
  for (int i = 0; i < MI; ++i)
#pragma unroll
    for (int j = 0; j < 2; ++j)
#pragma unroll
      for (int r = 0; r < 16; ++r) acc[i][j][r] = 0.f;
  uint4 ra0[4], ra1[4], rw0[4], rw1[4];
#define GLA(KT, DA, I) { const int c_ = tid + (I) * 512; DA[I] = load_a<MODE>(p, g, m0 + (c_ >> 3), (KT), c_ & 7); }
#define GLW(KT, DW, I) if ((I) < NWC) { const int c_ = tid + (I) * 512; DW[I] = ldg16(g.W + (size_t)(n0 + (c_ >> 3)) * g.K + (KT) * 64 + (c_ & 7) * 8); }
#define GLOAD(KT, DA, DW) do { GLA(KT, DA, 0) GLA(KT, DA, 1) GLA(KT, DA, 2) GLA(KT, DA, 3) GLW(KT, DW, 0) GLW(KT, DW, 1) GLW(KT, DW, 2) GLW(KT, DW, 3) } while (0)
#define LSA(BUF, DA, I) { const int c_ = tid + (I) * 512; sts16(As + ((BUF) * 256 + (c_ >> 3)) * 72 + (c_ & 7) * 8, DA[I]); }
#define LSW(BUF, DW, I) if ((I) < NWC) { const int c_ = tid + (I) * 512; sts16(Ws + ((BUF) * BN + (c_ >> 3)) * 72 + (c_ & 7) * 8, DW[I]); }
#define LSTORE(BUF, DA, DW) do { LSA(BUF, DA, 0) LSA(BUF, DA, 1) LSA(BUF, DA, 2) LSA(BUF, DA, 3) LSW(BUF, DW, 0) LSW(BUF, DW, 1) LSW(BUF, DW, 2) LSW(BUF, DW, 3) } while (0)
  auto compute = [&](int buf) {
    const u16* Ab = As + buf * 256 * 72 + (wm * (MI * 32) + l32) * 72 + hh * 8;
    const u16* Wb = Ws + buf * BN * 72 + (wn * 64 + l32) * 72 + hh * 8;
#pragma unroll
    for (int ks = 0; ks < 4; ++ks) {
      bf16x8 wf0 = *(const bf16x8*)(Wb + ks * 16);
      bf16x8 wf1 = *(const bf16x8*)(Wb + 32 * 72 + ks * 16);
#pragma unroll
      for (int i = 0; i < MI; ++i) {
        bf16x8 xf = *(const bf16x8*)(Ab + i * 32 * 72 + ks * 16);
        acc[i][0] = MFMA(wf0, xf, acc[i][0]);
        acc[i][1] = MFMA(wf1, xf, acc[i][1]);
      }
    }
  };
  if (true) {
    char* L0 = smem;
    constexpr int BUFB = (256 + BN) * 128;
    constexpr int NBUF = BN <= 128 ? 3 : 2;
    constexpr int NGL = 4 + BN / 64;
    const int gl_row = lane >> 3;
    auto issue = [&](int kt, int buf) {
      char* lb = L0 + buf * BUFB;
#pragma unroll
      for (int i = 0; i < 4; ++i) {
        const int seg = wv * 4 + i, row = seg * 8 + gl_row;
        const int c = (lane & 7) ^ ((row >> 1) & 7);
        const u16* ap = (kt < g.split) ? g.a0 + (size_t)(m0 + row) * g.ld0 + kt * g.ks0 : g.a1 + (size_t)(m0 + row) * g.ld1 + (kt - g.split) * 64;
        __builtin_amdgcn_global_load_lds((const unsigned*)(ap + c * 8), (__attribute__((address_space(3))) unsigned*)(lb + seg * 1024 + lane * 16), 16, 0, 0);
      }
#pragma unroll
      for (int i = 0; i < BN / 64; ++i) {
        const int seg = wv * (BN / 64) + i, row = seg * 8 + gl_row;
        const int c = (lane & 7) ^ ((row >> 1) & 7);
        __builtin_amdgcn_global_load_lds((const unsigned*)(g.W + (size_t)(n0 + row) * g.K + kt * 64 + c * 8),
                                         (__attribute__((address_space(3))) unsigned*)(lb + 256 * 128 + seg * 1024 + lane * 16), 16, 0, 0);
      }
    };
    auto compute2 = [&](int buf) {
      const char* lb = L0 + buf * BUFB;
#pragma unroll
      for (int ks = 0; ks < 4; ++ks) {
        const int c = ks * 2 + hh;
        bf16x8 wf[2], xf[MI];
#pragma unroll
        for (int j = 0; j < 2; ++j) { const int r = wn * 64 + j * 32 + l32; wf[j] = *(const bf16x8*)(lb + 256 * 128 + r * 128 + ((c ^ ((r >> 1) & 7)) << 4)); }
#pragma unroll
        for (int i = 0; i < MI; ++i) { const int r = wm * (MI * 32) + i * 32 + l32; xf[i] = *(const bf16x8*)(lb + r * 128 + ((c ^ ((r >> 1) & 7)) << 4)); }
#pragma unroll
        for (int i = 0; i < MI; ++i) {
          acc[i][0] = MFMA(wf[0], xf[i], acc[i][0]);
          acc[i][1] = MFMA(wf[1], xf[i], acc[i][1]);
        }
      }
    };
    if (NBUF == 3) {
      issue(0, 0);
      if (nk > 1) { issue(1, 1); if (BN == 128) asm volatile("s_waitcnt vmcnt(6)" ::: "memory"); else asm volatile("s_waitcnt vmcnt(5)" ::: "memory"); }
      else asm volatile("s_waitcnt vmcnt(0)" ::: "memory");
      asm volatile("s_waitcnt lgkmcnt(0)" ::: "memory");
      __builtin_amdgcn_s_barrier();
      int buf = 0;
      for (int kt = 0; kt < nk; ++kt) {
        const int b2 = buf == 0 ? 2 : buf - 1;
        if (kt + 2 < nk) issue(kt + 2, b2);
        compute2(buf);
        if (kt + 2 < nk) { if (BN == 128) asm volatile("s_waitcnt vmcnt(6)" ::: "memory"); else asm volatile("s_waitcnt vmcnt(5)" ::: "memory"); }
        else asm volatile("s_waitcnt vmcnt(0)" ::: "memory");
        asm volatile("s_waitcnt lgkmcnt(0)" ::: "memory");
        __builtin_amdgcn_s_barrier();
        buf = buf == 2 ? 0 : buf + 1;
      }
    } else {
      issue(0, 0);
      asm volatile("s_waitcnt vmcnt(0)" ::: "memory");
      __syncthreads();
      for (int kt = 0; kt < nk; ++kt) {
        const int buf = kt & 1;
        if (kt + 1 < nk) issue(kt + 1, buf ^ 1);
        compute2(buf);
        asm volatile("s_waitcnt vmcnt(0)" ::: "memory");
        __syncthreads();
      }
    }
    __syncthreads();
  } else {
    GLOAD(0, ra0, rw0);
    LSTORE(0, ra0, rw0);
    __syncthreads();
    for (int kt = 0; kt < nk; ++kt) {
      const int buf = kt & 1;
      if (kt + 1 < nk) GLOAD(kt + 1, ra0, rw0);
      compute(buf);
      if (kt + 1 < nk) LSTORE(buf ^ 1, ra0, rw0);
      __syncthreads();
    }
  }
#undef GLOAD
#undef LSTORE
  const int nw = n0 + wn * 64;
#pragma unroll
  for (int i = 0; i < MI; ++i) {
    const int m = m0 + wm * (MI * 32) + i * 32 + l32;
    if (EPI == EPI_UP) {
      const float rs = rstd16(p.ssq, m);
      const int hb0 = nw >> 1;
#pragma unroll
      for (int gq = 0; gq < 4; ++gq) {
        float v[4];
#pragma unroll
        for (int r = 0; r < 4; ++r) {
          float gt = acc[i][0][4 * gq + r] * rs, up = acc[i][1][4 * gq + r] * rs;
          v[r] = gt * sigmoidf_(gt) * up;
        }
        int hid = hb0 + 8 * gq + 4 * hh;
        u16* dst = hid < 1408 ? p.regB + (size_t)m * 1408 + hid : (u16*)p.out + (size_t)m * 1408 + (hid - 1408);
        store4(dst, v[0], v[1], v[2], v[3]);
      }
    } else if (EPI == EPI_RES) {
      float ss = 0.f;
#pragma unroll
      for (int j = 0; j < 2; ++j)
#pragma unroll
        for (int gq = 0; gq < 4; ++gq) {
          u16* hp = p.hb + (size_t)m * 1024 + nw + j * 32 + 8 * gq + 4 * hh;
          uint2 old = *(const uint2*)hp;
          float h0 = bflo(old.x) + g.scale * acc[i][j][4 * gq + 0];
          float h1 = bfhi(old.x) + g.scale * acc[i][j][4 * gq + 1];
          float h2 = bflo(old.y) + g.scale * acc[i][j][4 * gq + 2];
          float h3 = bfhi(old.y) + g.scale * acc[i][j][4 * gq + 3];
          unsigned p0 = pack2(h0, h1), p1 = pack2(h2, h3);
          *(uint2*)hp = make_uint2(p0, p1);
          float r0 = bflo(p0), r1 = bfhi(p0), r2 = bflo(p1), r3 = bfhi(p1);
          ss += r0 * r0 + r1 * r1 + r2 * r2 + r3 * r3;
        }
      ss += __shfl_xor(ss, 32);
      if (hh == 0) p.ssq[(size_t)(nw >> 6) * TP + m] = ss;
    } else if (EPI == EPI_INPROJ) {
      const float rs = rstd16(p.ssq, m);
      int s, pos, L; row2seq(m < T ? m : 0, s, pos, L);
      float ss = 0.f;
#pragma unroll
      for (int j = 0; j < 2; ++j) {
        const int nb = nw + j * 32;
        if (nb == 384) {
          u16* kr = (u16*)p.out + (size_t)TP * 1024 + (size_t)TP * 768 + (size_t)m * 32;
#pragma unroll
          for (int gq = 0; gq < 2; ++gq) {
            float o1[4], o2[4];
#pragma unroll
            for (int r = 0; r < 4; ++r) {
              int ii = 8 * gq + 4 * hh + r;
              float c = p.ropec[pos * 16 + ii], sn = p.ropes[pos * 16 + ii];
              float x1 = acc[i][j][4 * gq + r] * rs, x2 = acc[i][j][4 * (gq + 2) + r] * rs;
              o1[r] = x1 * c - x2 * sn; o2[r] = x2 * c + x1 * sn;
            }
            store4(kr + 8 * gq + 4 * hh, o1[0], o1[1], o1[2], o1[3]);
            store4(kr + 16 + 8 * gq + 4 * hh, o2[0], o2[1], o2[2], o2[3]);
          }
        } else {
#pragma unroll
          for (int gq = 0; gq < 4; ++gq) {
            int n = nb + 8 * gq + 4 * hh;
            unsigned p0 = pack2(acc[i][j][4 * gq] * rs, acc[i][j][4 * gq + 1] * rs);
            unsigned p1 = pack2(acc[i][j][4 * gq + 2] * rs, acc[i][j][4 * gq + 3] * rs);
            if (n < 512) {
              *(uint2*)((u16*)p.out + (size_t)m * 512 + n) = make_uint2(p0, p1);
              float r0 = bflo(p0), r1 = bfhi(p0), r2 = bflo(p1), r3 = bfhi(p1);
              ss += r0 * r0 + r1 * r1 + r2 * r2 + r3 * r3;
            } else if (n - 512 < 1952) {
              *(uint2*)(p.regB + (size_t)m * 1952 + (n - 512)) = make_uint2(p0, p1);
              if (m < T && ((pos & 63) == 0 || (pos & 63) == 63)) {
                const int ch = (s < 2 ? s * 129 : 258 + (s - 2) * 33) + (pos >> 6);
                *(uint2*)(halo_ptr(p) + ((size_t)ch * 2 + ((pos & 63) ? 1 : 0)) * 1952 + (n - 512)) = make_uint2(p0, p1);
              }
            }
          }
        }
      }
      if (nw < 384) {
        ss += __shfl_xor(ss, 32);
        if (hh == 0) p.ssqq[(size_t)(nw >> 6) * TP + m] = ss;
      }
    } else if (EPI == EPI_Q) {
      float sq = p.ssqq[m] + p.ssqq[(size_t)TP + m] + p.ssqq[(size_t)2 * TP + m] + p.ssqq[(size_t)3 * TP + m];
      const float rs = rsqrtf(sq * (1.f / 256.f) + RMS_EPS) * QSCALE;
      int s, pos, L; row2seq(m < T ? m : 0, s, pos, L);
      u16* qrow = (u16*)p.out + (size_t)TP * 1024 + (size_t)m * 768;
#pragma unroll
      for (int j = 0; j < 2; ++j) {
        const int nb = nw + j * 32;
        if (((nb >> 5) % 3) == 2) {
#pragma unroll
          for (int gq = 0; gq < 2; ++gq) {
            float o1[4], o2[4];
#pragma unroll
            for (int r = 0; r < 4; ++r) {
              int ii = 8 * gq + 4 * hh + r;
              float c = p.ropec[pos * 16 + ii], sn = p.ropes[pos * 16 + ii];
              float x1 = acc[i][j][4 * gq + r] * rs, x2 = acc[i][j][4 * (gq + 2) + r] * rs;
              o1[r] = x1 * c - x2 * sn; o2[r] = x2 * c + x1 * sn;
            }
            store4(qrow + nb + 8 * gq + 4 * hh, o1[0], o1[1], o1[2], o1[3]);
            store4(qrow + nb + 16 + 8 * gq + 4 * hh, o2[0], o2[1], o2[2], o2[3]);
          }
        } else {
#pragma unroll
          for (int gq = 0; gq < 4; ++gq)
            store4(qrow + nb + 8 * gq + 4 * hh, acc[i][j][4 * gq] * rs, acc[i][j][4 * gq + 1] * rs, acc[i][j][4 * gq + 2] * rs, acc[i][j][4 * gq + 3] * rs);
        }
      }
    } else if (EPI == EPI_KV) {
      if (m < T) {
        float sq = p.ssqq[(size_t)4 * TP + m] + p.ssqq[(size_t)5 * TP + m];
        const float rs = rsqrtf(sq * (1.f / 128.f) + RMS_EPS);
        int s, pos, L; row2seq(m, s, pos, L);
        const int head = nw >> 7;
        const int ppos = (pos & ~15) | (pos & 3) | (((pos >> 3) & 1) << 2) | (((pos >> 2) & 1) << 3);
#pragma unroll
        for (int j = 0; j < 2; ++j) {
          const int jj = (nw & 127) + j * 32;
#pragma unroll
          for (int gq = 0; gq < 4; ++gq) {
            int c = jj + 8 * gq + 4 * hh;
            if (jj < 64) {
              store4(p.kn + (size_t)m * 512 + head * 64 + c, acc[i][j][4 * gq] * rs, acc[i][j][4 * gq + 1] * rs, acc[i][j][4 * gq + 2] * rs, acc[i][j][4 * gq + 3] * rs);
            } else {
#pragma unroll
              for (int r = 0; r < 4; ++r) {
                int dv = c - 64 + r;
                p.vt[(size_t)seq_start(s) * 512 + (size_t)(head * 64 + dv) * L + ppos] = f2bf(acc[i][j][4 * gq + r] * rs);
              }
            }
          }
        }
      }
    } else if (EPI == EPI_POST) {
      if (m < T) {
        int s, pos, L; row2seq(m, s, pos, L);
        const int hd = nw >> 6;
        u16* yb = (u16*)p.out + (size_t)m * 1024;
        float y[2][16];
        float sum = 0.f;
#pragma unroll
        for (int j = 0; j < 2; ++j)
#pragma unroll
          for (int gq = 0; gq < 4; ++gq) {
            int n = nw + j * 32 + 8 * gq + 4 * hh;
            uint2 a = *(const uint2*)(yb + n), b = *(const uint2*)(yb + 512 + n);
            y[j][4 * gq + 0] = bflo(a.x) + bflo(b.x); y[j][4 * gq + 1] = bfhi(a.x) + bfhi(b.x);
            y[j][4 * gq + 2] = bflo(a.y) + bflo(b.y); y[j][4 * gq + 3] = bfhi(a.y) + bfhi(b.y);
            sum += y[j][4 * gq] + y[j][4 * gq + 1] + y[j][4 * gq + 2] + y[j][4 * gq + 3];
          }
        sum += __shfl_xor(sum, 32);
        const float mu = sum * (1.f / 64.f);
        float vs = 0.f;
#pragma unroll
        for (int j = 0; j < 2; ++j)
#pragma unroll
          for (int r = 0; r < 16; ++r) { float dlt = y[j][r] - mu; vs += dlt * dlt; }
        vs += __shfl_xor(vs, 32);
        const float rstd = rsqrtf(vs * (1.f / 64.f) + LNX_EPS);
        const float bsum = p.bsc[(size_t)m * 8 + hd] + p.bsc[((size_t)TP + m) * 8 + hd];
        const u16* vb = p.regB + (size_t)m * 1952 + 1024;
#pragma unroll
        for (int j = 0; j < 2; ++j)
#pragma unroll
          for (int gq = 0; gq < 4; ++gq) {
            int n = nw + j * 32 + 8 * gq + 4 * hh;
            uint2 c = *(const uint2*)(vb + n);
            float cv[4] = {bflo(c.x), bfhi(c.x), bflo(c.y), bfhi(c.y)};
            float o[4];
#pragma unroll
            for (int r = 0; r < 4; ++r) {
              float vsh = cv[r];
              float yn = (y[j][4 * gq + r] - mu) * rstd * p.lnx_w[g.layer * 512 + n + r] + p.lnx_b[g.layer * 512 + n + r];
              o[r] = (yn + bsum * vsh) * acc[i][j][4 * gq + r];
            }
            store4(yb + n, o[0], o[1], o[2], o[3]);
          }
      }
    }
  }
}

template <int MODE, int EPI, int BN = 128>
DI void gemm_phase_item(CP p, const GArgs& g, int item, int NT, char* smem) {
  const int grp = item / (8 * NT);
  const int gsz = min(8, NMT - grp * 8);
  const int idx = item - grp * 8 * NT;
  gemm_tile<MODE, EPI, BN>(p, g, grp * 8 + idx % gsz, idx / gsz, smem);
}

template <int MODE, int EPI, int BN>
DI void gemm_phase(CP p, const GArgs& g, int NT, char* smem) {
  const int x = blockIdx.x & 7, j = blockIdx.x >> 3, nj = gridDim.x >> 3;
  const int total = 16 * NT;
  for (int e = j; e < total; e += nj) {
    const int grp = e / (8 * NT);
    const int rem = e - grp * 8 * NT;
    gemm_tile<MODE, EPI, BN>(p, g, x + 8 * (grp * 8 + (rem & 7)), rem >> 3, smem);
  }
  const int ntail = NT * (BN / 64);
  for (int e = (int)gridDim.x - 1 - (int)blockIdx.x; e < ntail; e += gridDim.x) gemm_tile<MODE, EPI, 64>(p, g, NMT - 1, e, smem);
}

DI void attn_item(CP p, int s, int hd, int qb, char* smem, bool dostore = true) {
  u16* Ks = (u16*)smem;
  u16* Vs = Ks + 2 * 64 * 104;
  const int tid = tidx(), lane = tid & 63, wv = tid >> 6, l32 = lane & 31, hh = lane >> 5;
  const int L = seq_len(s), r0 = seq_start(s);
  const u16* Qb = (const u16*)p.out + (size_t)TP * 1024;
  const u16* KR = Qb + (size_t)TP * 768;
  const int qpos = qb * 256 + wv * 32 + l32;
  const bool wvalid = (qb * 256 + wv * 32) < L;
  const int qrow = r0 + min(qpos, L - 1);
  bf16x8 qf[6];
#pragma unroll
  for (int ks = 0; ks < 6; ++ks) qf[ks] = *(const bf16x8*)(Qb + (size_t)qrow * 768 + hd * 96 + ks * 16 + hh * 8);
  f32x16 o[2];
#pragma unroll
  for (int u = 0; u < 2; ++u)
#pragma unroll
    for (int r = 0; r < 16; ++r) o[u][r] = 0.f;
  float mrun = -1e30f, lrun = 0.f;
  const int nt = (L + 63) >> 6;
  const u16* vtb = p.vt + (size_t)r0 * 512 + (size_t)hd * 64 * L;
  uint4 rg[3];
  auto ldc = [&](int kt, int c) -> uint4 {
    uint4 z = make_uint4(0, 0, 0, 0);
    if (c < 768) {
      int key = c / 12, cc = c - key * 12, kpos = kt * 64 + key;
      if (kpos >= L) return z;
      const u16* src = cc < 8 ? p.kn + (size_t)(r0 + kpos) * 512 + hd * 64 + cc * 8 : KR + (size_t)(r0 + kpos) * 32 + (cc - 8) * 8;
      return *(const uint4*)src;
    } else {
      int c2 = c - 768, dv = c2 >> 3, kc = c2 & 7, kp0 = kt * 64 + kc * 8;
      if (kp0 >= L) return z;
      return *(const uint4*)(vtb + (size_t)dv * L + kp0);
    }
  };
  auto stc = [&](int buf, int c, uint4 v) {
    if (c < 768) { int key = c / 12, cc = c - key * 12; *(uint4*)(Ks + (buf * 64 + key) * 104 + cc * 8) = v; }
    else { int c2 = c - 768, dv = c2 >> 3, kc = c2 & 7; *(uint4*)(Vs + (buf * 64 + dv) * 72 + kc * 8) = v; }
  };
  rg[0] = ldc(0, tid); rg[1] = ldc(0, tid + 512); if (tid < 256) rg[2] = ldc(0, tid + 1024);
  stc(0, tid, rg[0]); stc(0, tid + 512, rg[1]); if (tid < 256) stc(0, tid + 1024, rg[2]);
  __syncthreads();
  for (int kt = 0; kt < nt; ++kt) {
    const int buf = kt & 1;
    if (kt + 1 < nt) { rg[0] = ldc(kt + 1, tid); rg[1] = ldc(kt + 1, tid + 512); if (tid < 256) rg[2] = ldc(kt + 1, tid + 1024); }
    if (wvalid) {
      f32x16 st[2];
#pragma unroll
      for (int t = 0; t < 2; ++t) {
#pragma unroll
        for (int r = 0; r < 16; ++r) st[t][r] = 0.f;
        const u16* kb = Ks + (buf * 64 + t * 32 + l32) * 104 + hh * 8;
#pragma unroll
        for (int ks = 0; ks < 6; ++ks) st[t] = MFMA(*(const bf16x8*)(kb + ks * 16), qf[ks], st[t]);
      }
      if (kt == nt - 1) {
#pragma unroll
        for (int t = 0; t < 2; ++t)
#pragma unroll
          for (int r = 0; r < 16; ++r) if (kt * 64 + t * 32 + crow(r, hh) >= L) st[t][r] = -1e30f;
      }
      float mx = -1e30f;
#pragma unroll
      for (int t = 0; t < 2; ++t)
#pragma unroll
        for (int r = 0; r < 16; ++r) mx = fmaxf(mx, st[t][r]);
      mx = fmaxf(mx, __shfl_xor(mx, 32));
      const float mnew = fmaxf(mrun, mx);
      const float alpha = __builtin_amdgcn_exp2f(mrun - mnew);
      float ls = 0.f;
#pragma unroll
      for (int t = 0; t < 2; ++t)
#pragma unroll
        for (int r = 0; r < 16; ++r) { float pv = __builtin_amdgcn_exp2f(st[t][r] - mnew); st[t][r] = pv; ls += pv; }
      lrun = lrun * alpha + ls; mrun = mnew;
#pragma unroll
      for (int u = 0; u < 2; ++u)
#pragma unroll
        for (int r = 0; r < 16; ++r) o[u][r] *= alpha;
#pragma unroll
      for (int t = 0; t < 2; ++t)
#pragma unroll
        for (int s2 = 0; s2 < 2; ++s2) {
          uint4 pk;
          pk.x = pack2(st[t][8 * s2 + 0], st[t][8 * s2 + 1]); pk.y = pack2(st[t][8 * s2 + 2], st[t][8 * s2 + 3]);
          pk.z = pack2(st[t][8 * s2 + 4], st[t][8 * s2 + 5]); pk.w = pack2(st[t][8 * s2 + 6], st[t][8 * s2 + 7]);
          bf16x8 pf = __builtin_bit_cast(bf16x8, pk);
#pragma unroll
          for (int u = 0; u < 2; ++u) {
            bf16x8 vf = *(const bf16x8*)(Vs + (buf * 64 + u * 32 + l32) * 72 + t * 32 + s2 * 16 + hh * 8);
            o[u] = MFMA(vf, pf, o[u]);
          }
        }
    }
    if (kt + 1 < nt) { stc(buf ^ 1, tid, rg[0]); stc(buf ^ 1, tid + 512, rg[1]); if (tid < 256) stc(buf ^ 1, tid + 1024, rg[2]); }
    __syncthreads();
  }
  if (wvalid) {
    float lt = lrun + __shfl_xor(lrun, 32);
    const float inv = 1.f / lt;
    if (qpos < L && dostore) {
      u16* dst = (u16*)p.out + (size_t)TP * 1024 + (size_t)(r0 + qpos) * 768 + hd * 96;
#pragma unroll
      for (int u = 0; u < 2; ++u)
#pragma unroll
        for (int gq = 0; gq < 4; ++gq)
          store4(dst + u * 32 + 8 * gq + 4 * hh, o[u][4 * gq] * inv, o[u][4 * gq + 1] * inv, o[u][4 * gq + 2] * inv, o[u][4 * gq + 3] * inv);
    }
  }
}

DI void scan_block(CP p, int layer, int s, int d, int hd, char* smem) {
  float* OP = (float*)smem;
  float* WA = OP + 32 * 392;
  float* YB = WA + 2 * 32 * 64;
  u16* XL = (u16*)(YB + 32 * 64);
  float* MU = (float*)(XL + 2 * 32 * 72);
  float* CS = MU + 5 * 2 * 64;
  const int tid = tidx(), lane = tid & 63, wv = tid >> 6, l32 = lane & 31, hh = lane >> 5;
  const int L = seq_len(s), r0 = seq_start(s);
  const int sj = tid >> 4, q = tid & 15;
  const int rloc = lane >> 3, cg8 = lane & 7, row = wv * 8 + rloc;
  const int aoff[5] = {hd * 64, 512 + hd * 64, 1024 + hd * 64, 1536 + d * 64, 1664 + d * 64};
  __syncthreads();
  for (int i = tid; i < 640; i += NTHR) {
    int a = i >> 7, w = (i >> 6) & 1, c = i & 63;
    int off = a == 0 ? aoff[0] : a == 1 ? aoff[1] : a == 2 ? aoff[2] : a == 3 ? aoff[3] : aoff[4];
    MU[i] = p.shift_mu[(size_t)(layer * 2 + w) * 1952 + off + c];
  }
  if (tid < 64) {
    CS[tid] = p.key_k_k[layer * 512 + hd * 64 + tid];
    CS[64 + tid] = p.key_k_a[layer * 512 + hd * 64 + tid];
    CS[128 + tid] = p.bonus_r_k[layer * 512 + hd * 64 + tid];
  }
  const int mat = (wv >> 1) & 1, ntile = wv & 1;
  bf16x8 wfr[4];
  {
    const u16* wb = p.wM + (mat ? OFF_A : OFF_DEC) + (size_t)(d * 512 + hd * 64 + ntile * 32 + l32) * 64 + hh * 8;
#pragma unroll
    for (int ks = 0; ks < 4; ++ks) wfr[ks] = *(const bf16x8*)(wb + ks * 16);
  }
  const float bias = mat ? p.iclr_a0[(size_t)(layer * 2 + d) * 512 + hd * 64 + ntile * 32 + l32]
                         : p.decay_w0[(size_t)(layer * 2 + d) * 512 + hd * 64 + ntile * 32 + l32];
  __syncthreads();
  float S[8];
#pragma unroll
  for (int i = 0; i < 8; ++i) S[i] = 0.f;
  const int nch = (L + 31) >> 5;
  uint2 raw[15];
  float r4[4], k4[4], kk4[4], v4[4];

  auto prefetch = [&](int c) {
    const int sidx = c * 32 + sj;
    const bool valid = sidx < L;
    const int tok = d == 0 ? sidx : L - 1 - sidx;
    const u16* base = p.regB + (size_t)(r0 + tok) * 1952 + 4 * q;
#pragma unroll
    for (int a = 0; a < 5; ++a) {
      const int off = a == 0 ? aoff[0] : a == 1 ? aoff[1] : a == 2 ? aoff[2] : a == 3 ? aoff[3] : aoff[4];
      raw[a * 3 + 0] = (valid && tok > 0) ? *(const uint2*)(base - 1952 + off) : make_uint2(0, 0);
      raw[a * 3 + 1] = valid ? *(const uint2*)(base + off) : make_uint2(0, 0);
      raw[a * 3 + 2] = (valid && tok + 1 < L) ? *(const uint2*)(base + 1952 + off) : make_uint2(0, 0);
    }
  };
  auto shift4 = [&](int a, float* x) {
    const float4 m0 = *(const float4*)(MU + (a * 2 + 0) * 64 + 4 * q);
    const float4 m1 = *(const float4*)(MU + (a * 2 + 1) * 64 + 4 * q);
    const uint2 pm = raw[a * 3], c = raw[a * 3 + 1], pp = raw[a * 3 + 2];
    float c0 = bflo(c.x), c1 = bfhi(c.x), c2 = bflo(c.y), c3 = bfhi(c.y);
    x[0] = c0 + m0.x * (bflo(pm.x) - c0) + m1.x * (bflo(pp.x) - c0);
    x[1] = c1 + m0.y * (bfhi(pm.x) - c1) + m1.y * (bfhi(pp.x) - c1);
    x[2] = c2 + m0.z * (bflo(pm.y) - c2) + m1.z * (bflo(pp.y) - c2);
    x[3] = c3 + m0.w * (bfhi(pm.y) - c3) + m1.w * (bfhi(pp.y) - c3);
  };
  auto stage = [&](int c) {
    shift4(0, r4); shift4(1, k4); shift4(2, v4);
    float xw[4], xa[4];
    shift4(3, xw); shift4(4, xa);
#pragma unroll
    for (int e = 0; e < 4; ++e) xw[e] = 1.f - 2.f / (__expf(2.f * xw[e]) + 1.f);
    store4(XL + sj * 72 + 4 * q, xw[0], xw[1], xw[2], xw[3]);
    store4(XL + 32 * 72 + sj * 72 + 4 * q, xa[0], xa[1], xa[2], xa[3]);
    {
      const float4 kkw = *(const float4*)(CS + 4 * q);
      float x0 = k4[0] * kkw.x, x1 = k4[1] * kkw.y, x2 = k4[2] * kkw.z, x3 = k4[3] * kkw.w;
      float ss = sum16(x0 * x0 + x1 * x1 + x2 * x2 + x3 * x3);
      float inv = 1.f / fmaxf(sqrtf(ss), 1e-12f);
      kk4[0] = x0 * inv; kk4[1] = x1 * inv; kk4[2] = x2 * inv; kk4[3] = x3 * inv;
    }
    __syncthreads();
    if (wv < 4) {
      f32x16 acc;
#pragma unroll
      for (int r = 0; r < 16; ++r) acc[r] = 0.f;
      const u16* xb = XL + mat * 32 * 72 + l32 * 72 + hh * 8;
#pragma unroll
      for (int ks = 0; ks < 4; ++ks) acc = MFMA(*(const bf16x8*)(xb + ks * 16), wfr[ks], acc);
#pragma unroll
      for (int r = 0; r < 16; ++r) {
        float x = acc[r] + bias;
        float sg = sigmoidf_(x);
        float val = mat ? sg : __expf(-0.6065306597126334f * sg);
        WA[(mat * 32 + crow(r, hh)) * 64 + ntile * 32 + l32] = val;
      }
    }
    __syncthreads();
    {
      const float4 w4 = *(const float4*)(WA + sj * 64 + 4 * q);
      const float4 a4 = *(const float4*)(WA + (32 + sj) * 64 + 4 * q);
      const float4 ka = *(const float4*)(CS + 64 + 4 * q);
      const float4 brk = *(const float4*)(CS + 128 + 4 * q);
      const float wv4[4] = {w4.x, w4.y, w4.z, w4.w}, av4[4] = {a4.x, a4.y, a4.z, a4.w};
      const float kav[4] = {ka.x, ka.y, ka.z, ka.w}, bkv[4] = {brk.x, brk.y, brk.z, brk.w};
      float aa[4], wr[4], bb[4], kd[4];
      float br = 0.f, kr = 0.f, bs = 0.f;
#pragma unroll
      for (int e = 0; e < 4; ++e) {
        aa[e] = -kk4[e]; wr[e] = wv4[e] * r4[e]; bb[e] = kk4[e] * av4[e];
        kd[e] = k4[e] * (1.f + (av4[e] - 1.f) * kav[e]);
        br += bb[e] * r4[e]; kr += kd[e] * r4[e]; bs += r4[e] * kd[e] * bkv[e];
      }
      br = sum16(br); kr = sum16(kr); bs = sum16(bs);
      float* o = OP + sj * 392 + 4 * q;
      *(float4*)(o) = make_float4(aa[0], aa[1], aa[2], aa[3]);
      *(float4*)(o + 64) = make_float4(wr[0], wr[1], wr[2], wr[3]);
      *(float4*)(o + 128) = w4;
      *(float4*)(o + 192) = make_float4(bb[0], bb[1], bb[2], bb[3]);
      *(float4*)(o + 256) = make_float4(kd[0], kd[1], kd[2], kd[3]);
      *(float4*)(o + 320) = make_float4(v4[0], v4[1], v4[2], v4[3]);
      if (q == 0) {
        OP[sj * 392 + 384] = br; OP[sj * 392 + 385] = kr;
        const int sidx = c * 32 + sj;
        if (sidx < L) { const int tok = d == 0 ? sidx : L - 1 - sidx; p.bsc[((size_t)d * TP + r0 + tok) * 8 + hd] = bs; }
      }
    }
    __syncthreads();
  };

  prefetch(0);
  stage(0);
  for (int c = 0; c < nch; ++c) {
    if (c + 1 < nch) prefetch(c + 1);
    const int nst = min(32, L - c * 32);
    for (int jj = 0; jj < nst; ++jj) {
      const float* o = OP + jj * 392;
      const float4 a0 = *(const float4*)(o + cg8 * 8), a1 = *(const float4*)(o + cg8 * 8 + 4);
      const float4 y0 = *(const float4*)(o + 64 + cg8 * 8), y1 = *(const float4*)(o + 64 + cg8 * 8 + 4);
      const float4 w0 = *(const float4*)(o + 128 + cg8 * 8), w1 = *(const float4*)(o + 128 + cg8 * 8 + 4);
      const float4 b0 = *(const float4*)(o + 192 + cg8 * 8), b1 = *(const float4*)(o + 192 + cg8 * 8 + 4);
      const float4 k0 = *(const float4*)(o + 256 + cg8 * 8), k1 = *(const float4*)(o + 256 + cg8 * 8 + 4);
      const float vv = o[320 + row];
      const float2 sc = *(const float2*)(o + 384);
      float da = S[0] * a0.x + S[1] * a0.y + S[2] * a0.z + S[3] * a0.w + S[4] * a1.x + S[5] * a1.y + S[6] * a1.z + S[7] * a1.w;
      float dy = S[0] * y0.x + S[1] * y0.y + S[2] * y0.z + S[3] * y0.w + S[4] * y1.x + S[5] * y1.y + S[6] * y1.z + S[7] * y1.w;
      da = dpp_sum8(da); dy = dpp_sum8(dy);
      const float yv = dy + da * sc.x + vv * sc.y;
      S[0] = S[0] * w0.x + da * b0.x + vv * k0.x; S[1] = S[1] * w0.y + da * b0.y + vv * k0.y;
      S[2] = S[2] * w0.z + da * b0.z + vv * k0.z; S[3] = S[3] * w0.w + da * b0.w + vv * k0.w;
      S[4] = S[4] * w1.x + da * b1.x + vv * k1.x; S[5] = S[5] * w1.y + da * b1.y + vv * k1.y;
      S[6] = S[6] * w1.z + da * b1.z + vv * k1.z; S[7] = S[7] * w1.w + da * b1.w + vv * k1.w;
      if (cg8 == 0) YB[jj * 64 + row] = yv;
    }
    __syncthreads();
    {
      const int sidx = c * 32 + sj;
      if (sidx < L) {
        const int tok = d == 0 ? sidx : L - 1 - sidx;
        const float4 yv = *(const float4*)(YB + sj * 64 + 4 * q);
        store4((u16*)p.out + (size_t)(r0 + tok) * 1024 + d * 512 + hd * 64 + 4 * q, yv.x, yv.y, yv.z, yv.w);
      }
    }
    if (c + 1 < nch) stage(c + 1);
  }
  __syncthreads();
}

typedef float f2 __attribute__((ext_vector_type(2)));
DI f2 mk2(float a, float b) { f2 r; r.x = a; r.y = b; return r; }
#define LDS_FENCE() asm volatile("s_waitcnt lgkmcnt(0)" ::: "memory")

template <int CPL>
DI void scan_block2(CP p, int layer, int s, int d, int hd, int rowhalf, char* smem) {
  float* OP = (float*)smem;
  float* YB = OP + 2 * 32 * 392;
  u16* XL = (u16*)(YB + 2 * 32 * 64);
  float* MU = (float*)(XL + 2 * 32 * 72);
  float* CS = MU + 640;
  u16* WL = (u16*)(CS + 192);
  const int tid = tidx(), lane = tid & 63, wv = tid >> 6, l32 = lane & 31, hh = lane >> 5;
  const int L = seq_len(s), r0 = seq_start(s);
  const int aoff0 = hd * 64, aoff1 = 512 + hd * 64, aoff2 = 1024 + hd * 64, aoff3 = 1536 + d * 64, aoff4 = 1664 + d * 64;
  __syncthreads();
  for (int i = tid; i < 640; i += NTHR) {
    int a = i >> 7, w = (i >> 6) & 1, c = i & 63;
    int off = a == 0 ? aoff0 : a == 1 ? aoff1 : a == 2 ? aoff2 : a == 3 ? aoff3 : aoff4;
    MU[i] = p.shift_mu[(size_t)(layer * 2 + w) * 1952 + off + c];
  }
#pragma unroll
  for (int i = 0; i < 2; ++i) {
    const int idx = tid + i * NTHR, mat = idx >> 9, col = (idx >> 3) & 63, kc = idx & 7;
    *(uint4*)(WL + (mat * 64 + col) * 72 + kc * 8) = *(const uint4*)(p.wM + (mat ? OFF_A : OFF_DEC) + (size_t)(d * 512 + hd * 64 + col) * 64 + kc * 8);
  }
  if (tid < 64) {
    CS[tid] = p.key_k_k[layer * 512 + hd * 64 + tid];
    CS[64 + tid] = p.key_k_a[layer * 512 + hd * 64 + tid];
    CS[128 + tid] = p.bonus_r_k[layer * 512 + hd * 64 + tid];
  }
  __syncthreads();
  const int nch = (L + 31) >> 5;

  if (wv >= 4) {
    const int sw = wv - 4;
    const int q = lane & 15;
    float bias[2][2];
#pragma unroll
    for (int mat = 0; mat < 2; ++mat)
#pragma unroll
      for (int nt2 = 0; nt2 < 2; ++nt2)
        bias[mat][nt2] = mat ? p.iclr_a0[(size_t)(layer * 2 + d) * 512 + hd * 64 + nt2 * 32 + l32]
                             : p.decay_w0[(size_t)(layer * 2 + d) * 512 + hd * 64 + nt2 * 32 + l32];
    uint2 raw[2][5];
    auto load_raw = [&](int c) {
#pragma unroll
      for (int u = 0; u < 2; ++u) {
        const int sj = 8 * sw + 4 * u + (lane >> 4);
        const int sidc = min(c * 32 + sj, L - 1);
        const int tok = d == 0 ? sidc : L - 1 - sidc;
        const u16* base = p.regB + (size_t)(r0 + tok) * 1952 + 4 * q;
        raw[u][0] = *(const uint2*)(base + aoff0); raw[u][1] = *(const uint2*)(base + aoff1); raw[u][2] = *(const uint2*)(base + aoff2);
        raw[u][3] = *(const uint2*)(base + aoff3); raw[u][4] = *(const uint2*)(base + aoff4);
      }
    };
    auto stage = [&](int c) {
      float r4[2][4], k4[2][4], kk4[2][4], v4[2][4];
#pragma unroll
      for (int u = 0; u < 2; ++u) {
        const int sj = 8 * sw + 4 * u + (lane >> 4);
        r4[u][0] = bflo(raw[u][0].x); r4[u][1] = bfhi(raw[u][0].x); r4[u][2] = bflo(raw[u][0].y); r4[u][3] = bfhi(raw[u][0].y);
        k4[u][0] = bflo(raw[u][1].x); k4[u][1] = bfhi(raw[u][1].x); k4[u][2] = bflo(raw[u][1].y); k4[u][3] = bfhi(raw[u][1].y);
        v4[u][0] = bflo(raw[u][2].x); v4[u][1] = bfhi(raw[u][2].x); v4[u][2] = bflo(raw[u][2].y); v4[u][3] = bfhi(raw[u][2].y);
        *(uint2*)(XL + sj * 72 + 4 * q) = raw[u][3];
        *(uint2*)(XL + 32 * 72 + sj * 72 + 4 * q) = raw[u][4];
        const float4 kkw = *(const float4*)(CS + 4 * q);
        float x0 = k4[u][0] * kkw.x, x1 = k4[u][1] * kkw.y, x2 = k4[u][2] * kkw.z, x3 = k4[u][3] * kkw.w;
        float ss = sum16(x0 * x0 + x1 * x1 + x2 * x2 + x3 * x3);
        float inv = __builtin_amdgcn_rsqf(fmaxf(ss, 1e-24f));
        kk4[u][0] = x0 * inv; kk4[u][1] = x1 * inv; kk4[u][2] = x2 * inv; kk4[u][3] = x3 * inv;
      }
      LDS_FENCE();
      float* OPn = OP + (c & 1) * 32 * 392;
#pragma unroll
      for (int mat = 0; mat < 2; ++mat)
#pragma unroll
        for (int nt2 = 0; nt2 < 2; ++nt2) {
          f32x16 acc;
#pragma unroll
          for (int r = 0; r < 16; ++r) acc[r] = 0.f;
          const u16* xb = XL + mat * 32 * 72 + (8 * sw + (l32 & 7)) * 72 + hh * 8;
#pragma unroll
          for (int ks = 0; ks < 4; ++ks) acc = MFMA(*(const bf16x8*)(xb + ks * 16), *(const bf16x8*)(WL + (mat * 64 + nt2 * 32 + l32) * 72 + ks * 16 + hh * 8), acc);
#pragma unroll
          for (int r = 0; r < 4; ++r) {
            float x = acc[r] + bias[mat][nt2];
            float sg = sigmoidf_(x);
            float val = mat ? sg : __expf(-0.6065306597126334f * sg);
            OPn[(8 * sw + 4 * hh + r) * 392 + (mat ? 0 : 128) + nt2 * 32 + l32] = val;
          }
        }
      LDS_FENCE();
#pragma unroll
      for (int u = 0; u < 2; ++u) {
        const int sj = 8 * sw + 4 * u + (lane >> 4);
        const float4 w4 = *(const float4*)(OPn + sj * 392 + 128 + 4 * q);
        const float4 a4 = *(const float4*)(OPn + sj * 392 + 4 * q);
        const float4 ka = *(const float4*)(CS + 64 + 4 * q);
        const float4 brk = *(const float4*)(CS + 128 + 4 * q);
        const float wv4[4] = {w4.x, w4.y, w4.z, w4.w}, av4[4] = {a4.x, a4.y, a4.z, a4.w};
        const float kav[4] = {ka.x, ka.y, ka.z, ka.w}, bkv[4] = {brk.x, brk.y, brk.z, brk.w};
        float aa[4], wr[4], bb[4], kd[4];
        float br = 0.f, kr = 0.f, bs = 0.f;
#pragma unroll
        for (int e = 0; e < 4; ++e) {
          aa[e] = -kk4[u][e]; wr[e] = wv4[e] * r4[u][e]; bb[e] = kk4[u][e] * av4[e];
          kd[e] = k4[u][e] * (1.f + (av4[e] - 1.f) * kav[e]);
          br += bb[e] * r4[u][e]; kr += kd[e] * r4[u][e]; bs += r4[u][e] * kd[e] * bkv[e];
        }
        br = sum16(br); kr = sum16(kr); bs = sum16(bs);
        float* o = OPn + sj * 392 + 4 * q;
        *(float4*)(o) = make_float4(aa[0], aa[1], aa[2], aa[3]);
        *(float4*)(o + 64) = make_float4(wr[0], wr[1], wr[2], wr[3]);
        *(float4*)(o + 128) = w4;
        *(float4*)(o + 192) = make_float4(bb[0], bb[1], bb[2], bb[3]);
        *(float4*)(o + 256) = make_float4(kd[0], kd[1], kd[2], kd[3]);
        *(float4*)(o + 320) = make_float4(v4[u][0], v4[u][1], v4[u][2], v4[u][3]);
        if (q == 0) {
          OPn[sj * 392 + 384] = br; OPn[sj * 392 + 385] = kr;
          const int sidx = c * 32 + sj;
          if (sidx < L && rowhalf == 0) { const int tok = d == 0 ? sidx : L - 1 - sidx; p.bsc[((size_t)d * TP + r0 + tok) * 8 + hd] = bs; }
        }
      }
    };
    auto writeout = [&](int c) {
      const float* yb = YB + (c & 1) * 2048;
#pragma unroll
      for (int u = 0; u < 2; ++u) {
        const int sj = 8 * sw + 4 * u + (lane >> 4);
        const int sidx = c * 32 + sj;
        const bool mine = CPL == 16 ? true : ((q >> 3) == rowhalf);
        if (sidx < L && mine) {
          const int tok = d == 0 ? sidx : L - 1 - sidx;
          const float4 yv = *(const float4*)(yb + sj * 64 + 4 * q);
          store4((u16*)p.out + (size_t)(r0 + tok) * 1024 + d * 512 + hd * 64 + 4 * q, yv.x, yv.y, yv.z, yv.w);
        }
      }
    };
    load_raw(0);
    stage(0);
    if (nch > 1) load_raw(1);
    __syncthreads();
    for (int c = 0; c < nch; ++c) {
      if (c + 1 < nch) { stage(c + 1); if (c + 2 < nch) load_raw(c + 2); }
      if (c >= 1) writeout(c - 1);
      __syncthreads();
    }
    writeout(nch - 1);
  } else {
    constexpr int LPRW = 64 / CPL;
    constexpr int NV = CPL / 2;
    const int cg = lane % LPRW;
    const int row = (CPL == 8 ? rowhalf * 32 + wv * 8 : wv * 16) + lane / LPRW;
    f2 S[NV];
#pragma unroll
    for (int i = 0; i < NV; ++i) S[i] = mk2(0.f, 0.f);
    __builtin_amdgcn_s_setprio(3);
    __syncthreads();
    for (int c = 0; c < nch; ++c) {
      const int nst = min(32, L - c * 32);
      const float* ob = OP + (c & 1) * 32 * 392;
      float* yb = YB + (c & 1) * 2048;
      float* ydst = cg == 0 ? yb + row : (float*)(smem + 147712) + lane;
      const int ystride = cg == 0 ? 64 : 0;
      float4 ca[CPL / 4], cy[CPL / 4], cw[CPL / 4], cb[CPL / 4], ck[CPL / 4];
      float cvv; float2 csc;
      {
        const float* o = ob + cg * CPL;
#pragma unroll
        for (int i = 0; i < CPL / 4; ++i) {
          ca[i] = *(const float4*)(o + 4 * i); cy[i] = *(const float4*)(o + 64 + 4 * i); cw[i] = *(const float4*)(o + 128 + 4 * i);
          cb[i] = *(const float4*)(o + 192 + 4 * i); ck[i] = *(const float4*)(o + 256 + 4 * i);
        }
        cvv = ob[320 + row]; csc = *(const float2*)(ob + 384);
      }
#pragma unroll 4
      for (int jj = 0; jj < nst; ++jj) {
        float4 na[CPL / 4], ny[CPL / 4], nw[CPL / 4], nb[CPL / 4], nk[CPL / 4];
        float nvv; float2 nsc;
        {
          const int jn = jj + 1;
          const float* o = ob + jn * 392 + cg * CPL;
#pragma unroll
          for (int i = 0; i < CPL / 4; ++i) {
            na[i] = *(const float4*)(o + 4 * i); ny[i] = *(const float4*)(o + 64 + 4 * i); nw[i] = *(const float4*)(o + 128 + 4 * i);
            nb[i] = *(const float4*)(o + 192 + 4 * i); nk[i] = *(const float4*)(o + 256 + 4 * i);
          }
          nvv = ob[jn * 392 + 320 + row]; nsc = *(const float2*)(ob + jn * 392 + 384);
        }
        f2 A[NV], Y[NV], W[NV], B[NV], K[NV];
#pragma unroll
        for (int i = 0; i < CPL / 4; ++i) {
          A[2 * i] = mk2(ca[i].x, ca[i].y); A[2 * i + 1] = mk2(ca[i].z, ca[i].w);
          Y[2 * i] = mk2(cy[i].x, cy[i].y); Y[2 * i + 1] = mk2(cy[i].z, cy[i].w);
          W[2 * i] = mk2(cw[i].x, cw[i].y); W[2 * i + 1] = mk2(cw[i].z, cw[i].w);
          B[2 * i] = mk2(cb[i].x, cb[i].y); B[2 * i + 1] = mk2(cb[i].z, cb[i].w);
          K[2 * i] = mk2(ck[i].x, ck[i].y); K[2 * i + 1] = mk2(ck[i].z, ck[i].w);
        }
        const float vv = cvv;
        f2 pa0 = S[0] * A[0], pa1 = S[1] * A[1], py0 = S[0] * Y[0], py1 = S[1] * Y[1];
#pragma unroll
        for (int i = 2; i < NV; i += 2) {
          pa0 = S[i] * A[i] + pa0; pa1 = S[i + 1] * A[i + 1] + pa1;
          py0 = S[i] * Y[i] + py0; py1 = S[i + 1] * Y[i + 1] + py1;
        }
        pa0 = pa0 + pa1; py0 = py0 + py1;
        float da = pa0.x + pa0.y, dy = py0.x + py0.y;
        const f2 vvv = mk2(vv, vv);
        f2 SW[NV];
#pragma unroll
        for (int i = 0; i < NV; ++i) SW[i] = S[i] * W[i] + vvv * K[i];
        da += __int_as_float(__builtin_amdgcn_update_dpp(0, __float_as_int(da), 0xB1, 0xf, 0xf, false));
        dy += __int_as_float(__builtin_amdgcn_update_dpp(0, __float_as_int(dy), 0xB1, 0xf, 0xf, false));
        da += __int_as_float(__builtin_amdgcn_update_dpp(0, __float_as_int(da), 0x4E, 0xf, 0xf, false));
        dy += __int_as_float(__builtin_amdgcn_update_dpp(0, __float_as_int(dy), 0x4E, 0xf, 0xf, false));
        if (CPL == 8) {
          da += __int_as_float(__builtin_amdgcn_update_dpp(0, __float_as_int(da), 0x141, 0xf, 0xf, false));
          dy += __int_as_float(__builtin_amdgcn_update_dpp(0, __float_as_int(dy), 0x141, 0xf, 0xf, false));
        }
        const f2 dav = mk2(da, da);
#pragma unroll
        for (int i = 0; i < NV; ++i) S[i] = dav * B[i] + SW[i];
        const float yv = dy + da * csc.x + vv * csc.y;
        ydst[jj * ystride] = yv;
#pragma unroll
        for (int i = 0; i < CPL / 4; ++i) { ca[i] = na[i]; cy[i] = ny[i]; cw[i] = nw[i]; cb[i] = nb[i]; ck[i] = nk[i]; }
        cvv = nvv; csc = nsc;
      }
      __syncthreads();
    }
    __builtin_amdgcn_s_setprio(0);
  }
  __syncthreads();
}

DI void shift_item(CP p, int layer, int ch, char* smem) {
  const int tid = tidx();
  int s, c;
  if (ch < 258) { s = ch / 129; c = ch - s * 129; } else { int x = ch - 258; s = 2 + x / 33; c = x - (s - 2) * 33; }
  const int L = seq_len(s), r0 = seq_start(s) + c * 64;
  const int nrows = min(64, L - c * 64);
  const int cgp = tid & 255, rg = tid >> 8;
  const int col = cgp * 8;
  const int rlo = rg * 32, rhi = min(rlo + 32, nrows);
  const bool act = cgp < 244 && rlo < nrows;
  typedef unsigned u32x4 __attribute__((ext_vector_type(4)));
  u32x4 prev = {0u, 0u, 0u, 0u}, cur = prev, lastn = prev;
  float mu0[8], mu1[8];
  u16* base = p.regB + (size_t)r0 * 1952 + col;
  if (act) {
#pragma unroll
    for (int e = 0; e < 8; ++e) { mu0[e] = p.shift_mu[(size_t)(layer * 2) * 1952 + col + e]; mu1[e] = p.shift_mu[(size_t)(layer * 2 + 1) * 1952 + col + e]; }
    if (rlo > 0) prev = *(const u32x4*)(base + (size_t)(rlo - 1) * 1952);
    else if (c > 0) prev = *(const u32x4*)(halo_ptr(p) + ((size_t)(ch - 1) * 2 + 1) * 1952 + col);
    cur = *(const u32x4*)(base + (size_t)rlo * 1952);
    if (rhi < nrows) lastn = *(const u32x4*)(base + (size_t)rhi * 1952);
    else if (c * 64 + nrows < L) lastn = *(const u32x4*)(halo_ptr(p) + ((size_t)(ch + 1) * 2) * 1952 + col);
  }
  __syncthreads();
  if (act) {
    const int kind = col < 1536 ? 0 : col < 1664 ? 1 : col < 1792 ? 0 : 2;
    for (int rb = rlo; rb < rhi; rb += 8) {
      u32x4 rw[9];
      rw[0] = cur;
#pragma unroll
      for (int i = 1; i < 9; ++i) { const int r = rb + i; rw[i] = (r < rhi) ? *(const u32x4*)(base + (size_t)r * 1952) : lastn; }
#pragma unroll
      for (int i = 0; i < 8; ++i) {
        const u32x4 cc = rw[i], nn = rw[i + 1];
        const unsigned pc[4] = {cc.x, cc.y, cc.z, cc.w}, pm[4] = {prev.x, prev.y, prev.z, prev.w}, pn[4] = {nn.x, nn.y, nn.z, nn.w};
        unsigned o[4];
#pragma unroll
        for (int e = 0; e < 4; ++e) {
          float c0 = bflo(pc[e]), c1 = bfhi(pc[e]);
          float x0 = c0 + mu0[2 * e] * (bflo(pm[e]) - c0) + mu1[2 * e] * (bflo(pn[e]) - c0);
          float x1 = c1 + mu0[2 * e + 1] * (bfhi(pm[e]) - c1) + mu1[2 * e + 1] * (bfhi(pn[e]) - c1);
          if (kind == 1) { x0 = 1.f - 2.f * __builtin_amdgcn_rcpf(__expf(2.f * x0) + 1.f); x1 = 1.f - 2.f * __builtin_amdgcn_rcpf(__expf(2.f * x1) + 1.f); }
          else if (kind == 2) { x0 = sigmoidf_(x0); x1 = sigmoidf_(x1); }
          o[e] = pack2(x0, x1);
        }
        { u32x4 ov = {o[0], o[1], o[2], o[3]}; *(u32x4*)(base + (size_t)(rb + i) * 1952) = ov; }
        prev = cc;
      }
      cur = rw[8];
    }
  }
  __syncthreads();
}

DI void init_rows(CP p, int item) {
  const int lane = tidx() & 63, wv = tidx() >> 6;
  const int r = item * 8 + wv;
  if (r >= TP) return;
  u16* dst = p.hb + (size_t)r * 1024 + lane * 16;
  float ss = 0.f;
  if (r < T) {
    int s, pos, L; row2seq(r, s, pos, L);
    const float* src = pos < 16 ? p.meta + pos * 1024
                     : (s < 2 ? p.x_prompt + ((size_t)s * 8192 + pos - 16) * 1024 : p.x_sample + ((size_t)(s - 2) * 2048 + pos - 16) * 1024);
    src += lane * 16;
    unsigned pk[8];
#pragma unroll
    for (int i = 0; i < 4; ++i) {
      float4 v = *(const float4*)(src + 4 * i);
      pk[2 * i] = pack2(v.x, v.y); pk[2 * i + 1] = pack2(v.z, v.w);
      float a = bflo(pk[2 * i]), b = bfhi(pk[2 * i]), c = bflo(pk[2 * i + 1]), dd = bfhi(pk[2 * i + 1]);
      ss += a * a + b * b + c * c + dd * dd;
    }
    *(uint4*)dst = make_uint4(pk[0], pk[1], pk[2], pk[3]);
    *(uint4*)(dst + 8) = make_uint4(pk[4], pk[5], pk[6], pk[7]);
  } else {
    *(uint4*)dst = make_uint4(0, 0, 0, 0);
    *(uint4*)(dst + 8) = make_uint4(0, 0, 0, 0);
  }
#pragma unroll
  for (int o = 32; o > 0; o >>= 1) ss += __shfl_xor(ss, o);
  if (lane < 16) p.ssq[(size_t)lane * TP + r] = lane == 0 ? ss : 0.f;
}
DI void init_rope(CP p, int item) {
  const int idx = item * NTHR + tidx();
  if (idx >= LPR * 16) return;
  const int pos = idx >> 4, i = idx & 15;
  double rev = (double)pos * ROPE_INV[i] * 0.15915494309189535;
  rev -= rint(rev);
  const float fr = (float)rev;
  p.ropec[idx] = __builtin_amdgcn_cosf(fr);
  p.ropes[idx] = __builtin_amdgcn_sinf(fr);
}
DI void final_rows(CP p, int item) {
  const int lane = tidx() & 63, wv = tidx() >> 6;
  const int orow = item * 8 + wv;
  int r;
  if (orow < 16384) { int s = orow >> 13; r = s * LPR + 16 + (orow & 8191); }
  else { int x = orow - 16384; int s = x >> 11; r = 2 * LPR + s * LSM + 16 + (x & 2047); }
  const float rs = rstd16(p.ssq, r);
  const u16* src = p.hb + (size_t)r * 1024 + lane * 16;
  uint4 a = *(const uint4*)src, b = *(const uint4*)(src + 8);
  unsigned w[8] = {a.x, a.y, a.z, a.w, b.x, b.y, b.z, b.w};
  float* dst = p.out + (size_t)orow * 1024 + lane * 16;
  const float* gn = p.final_norm + lane * 16;
#pragma unroll
  for (int i = 0; i < 4; ++i) {
    float4 o;
    o.x = bflo(w[2 * i]) * rs * gn[4 * i]; o.y = bfhi(w[2 * i]) * rs * gn[4 * i + 1];
    o.z = bflo(w[2 * i + 1]) * rs * gn[4 * i + 2]; o.w = bfhi(w[2 * i + 1]) * rs * gn[4 * i + 3];
    *(float4*)(dst + 4 * i) = o;
  }
}

#define XB_TMO      128
#define XB_XCNT(j)  (256  + 64 * (j))
#define XB_XSUB(j)  (1280 + 64 * (j))
#define XB_XGEN(j)  (2304 + 64 * (j))
#define XB_TOP      3328
#define XB_TOPGEN   3392
#define XCD_BAR_WORDS 3456
#define XB_SPIN_CAP (1u << 18)
#define LAS __attribute__((address_space(3)))

__device__ __forceinline__ unsigned xb_ld(unsigned* p)              { return __hip_atomic_load(p, __ATOMIC_RELAXED, __HIP_MEMORY_SCOPE_AGENT); }
__device__ __forceinline__ unsigned xb_add(unsigned* p, unsigned v) { return __hip_atomic_fetch_add(p, v, __ATOMIC_RELAXED, __HIP_MEMORY_SCOPE_AGENT); }
__device__ __forceinline__ unsigned xb_xcc_id() { return (unsigned)__builtin_amdgcn_s_getreg((3 << 11) | 20) & 0xFu; }
#define XB_SPIN(cond, bar) do { unsigned _sp = 0; while (cond) { __builtin_amdgcn_s_sleep(1); \
    if ((++_sp & 255u) == 0u) { if (xb_ld(&(bar)[XB_TMO])) break; if (_sp > XB_SPIN_CAP) { atomicAdd(&(bar)[XB_TMO], 1u); break; } } } } while (0)

struct XcdBarrier {
    unsigned* bar; unsigned x;
    volatile LAS unsigned* st;
};

__device__ __forceinline__ XcdBarrier xcd_barrier_post(unsigned* bar, volatile LAS unsigned* st) {
    XcdBarrier b; b.bar = bar; b.x = xb_xcc_id(); b.st = st;
    if (threadIdx.x == 0) (void)xb_add(&bar[XB_XCNT(b.x)], 1u);
    return b;
}
__device__ __forceinline__ void xcd_barrier_complete(unsigned* bar, unsigned x, unsigned& nloc, unsigned& nx) {
    const unsigned G = gridDim.x * gridDim.y * gridDim.z;
    unsigned sum, cnt, mine, sp = 0u;
    for (;;) {
        sum = 0u; cnt = 0u; mine = 0u;
#pragma unroll
        for (unsigned j = 0; j < 16; ++j) { const unsigned c = xb_ld(&bar[XB_XCNT(j)]); sum += c; cnt += (c > 0u) ? 1u : 0u; mine = (j == x) ? c : mine; }
        if (sum == G) break;
        __builtin_amdgcn_s_sleep(1);
        if ((++sp & 255u) == 0u) { if (xb_ld(&bar[XB_TMO])) break; if (sp > XB_SPIN_CAP) { atomicAdd(&bar[XB_TMO], 1u); break; } }
    }
    nloc = mine > 0u ? mine : 1u; nx = cnt > 0u ? cnt : 1u;
}

__device__ __forceinline__ void xcd_barrier(const XcdBarrier& b) {
    asm volatile("s_waitcnt vmcnt(0)" ::: "memory");
    __syncthreads();
    if (threadIdx.x == 0) {
        unsigned* bar = b.bar;
        __builtin_amdgcn_s_waitcnt(0);
        unsigned nloc = b.st[0], nx = b.st[1];
        if (nloc == 0u) { xcd_barrier_complete(bar, b.x, nloc, nx); b.st[0] = nloc; b.st[1] = nx; }
        const unsigned old = xb_add(&bar[XB_XSUB(b.x)], 1u);
        const unsigned gen = old / nloc;
        if (old + 1u == (gen + 1u) * nloc) {
            __builtin_amdgcn_fence(__ATOMIC_RELEASE, "agent");
            asm volatile("s_waitcnt vmcnt(0)" ::: "memory");
            const unsigned og = xb_add(&bar[XB_TOP], 1u);
            const unsigned tg = og / nx;
            if (og + 1u == (tg + 1u) * nx) xb_add(&bar[XB_TOPGEN], 1u);
            else XB_SPIN(xb_ld(&bar[XB_TOPGEN]) == tg, bar);
            __builtin_amdgcn_fence(__ATOMIC_ACQUIRE, "agent");
            xb_add(&bar[XB_XGEN(b.x)], 1u);
            asm volatile("s_waitcnt vmcnt(0)" ::: "memory");
        } else {
            XB_SPIN(xb_ld(&bar[XB_XGEN(b.x)]) == gen, bar);
            __builtin_amdgcn_fence(__ATOMIC_ACQUIRE, "agent");
            asm volatile("s_waitcnt vmcnt(0)" ::: "memory");
        }
    }
    __syncthreads();
}

constexpr int NPHASE = 21;
#ifndef ONLY
#define EN(x) true
#else
#define EN(x) ((x) == ONLY)
#endif
DI void run_phase(CP p, int ph, char* smem) {
  const int bid = blockIdx.x, nb = gridDim.x;
  const int fidx = (bid & 7) ? (bid >> 3) * 7 + (bid & 7) - 1 : -1, nfill = (nb >> 3) * 7;
  if (EN(100) && ph == 0) {
    const int n0 = NCONV_FFN, n1 = n0, n2 = n1 + TP / 8, n3 = n2 + (LPR * 16 + NTHR - 1) / NTHR;
    for (int it = bid; it < n3; it += nb) {
      if (it < n0) conv_ffn(p, 0, 0, it, smem);
      else if (it < n2) init_rows(p, it - n1);
      else init_rope(p, it - n2);
    }
    if (bid == 0 && tidx() < 4) p.ctr[tidx()] = 0u;
    return;
  }
  if (ph == 10) return;
  if (EN(102) && ph == 20) { for (int it = bid; it < 4096; it += nb) final_rows(p, it); return; }
  const int layer = ph > 10 ? 1 : 0;
  const int k = ph - (layer ? 11 : 1);
  GArgs g{};
  g.layer = layer; g.scale = 1.f;
  u16* outb = (u16*)p.out;
  switch (k) {
    case 0: case 7: if (EN(0)) {
      g.a0 = p.hb; g.ld0 = 1024; g.split = 1 << 30; g.ks0 = 64; g.a1 = p.hb; g.ld1 = 1024; g.W = (layer == 1 && k == 0) ? p.kn : p.wF; g.K = 1024;
      gemm_phase<0, EPI_UP, 256>(p, g, 22, smem);
      if (k == 7 && layer == 0 && fidx >= 0) for (int it = fidx; it < NCONV_FFN; it += nfill) conv_ffn(p, 1, 0, it, smem);
    } break;
    case 1: case 8: if (EN(1)) {
      g.a0 = p.regB; g.ld0 = 1408; g.split = 22; g.ks0 = 64; g.a1 = outb; g.ld1 = 1408; g.W = ((layer == 1 && k == 1) ? p.kn : p.wF) + OFF_WD; g.K = 2816; g.scale = 0.5f;
      gemm_phase<0, EPI_RES, 128>(p, g, 8, smem);
      if (layer == 0 && fidx >= 0) for (int it = fidx; it < NCONV_MIX; it += nfill) conv_mix(p, k == 1 ? 0 : 1, it, smem);
    } break;
    case 2: if (EN(2)) {
      g.a0 = p.hb; g.ld0 = 1024; g.split = 1 << 30; g.ks0 = 64; g.a1 = p.hb; g.ld1 = 1024; g.W = p.wM + OFF_IN; g.K = 1024;
      gemm_phase<0, EPI_INPROJ, 128>(p, g, 20, smem);
    } break;
    case 3: if (EN(3)) {
      const int nq = NMT * 6, nkv = NMT * 8, nsh = 522, ntot = nq + nkv + nsh;
      for (int it = bid; it < ntot; it += nb) {
        if (it < nq) {
          g.a0 = outb; g.ld0 = 512; g.split = 1 << 30; g.ks0 = 64; g.a1 = outb; g.ld1 = 512; g.W = p.wM + OFF_UQ; g.K = 256;
          gemm_phase_item<0, EPI_Q>(p, g, it, 6, smem);
        } else if (it < nq + nkv) {
          g.a0 = outb + 256; g.ld0 = 512; g.split = 1 << 30; g.ks0 = 64; g.a1 = outb; g.ld1 = 512; g.W = p.wM + OFF_UKV; g.K = 128;
          gemm_phase_item<0, EPI_KV>(p, g, it - nq, 8, smem);
        } else shift_item(p, layer, it - nq - nkv, smem);
      }
    } break;
    case 4: if (EN(4)) {
      for (int sc = bid; sc < 192; sc += nb) {
        if (sc < 64) { int x = sc >> 1; scan_block2<8>(p, layer, x >> 4, (x >> 3) & 1, x & 7, sc & 1, smem); }
        else { int x = sc - 64; scan_block2<16>(p, layer, 2 + (x >> 4), (x >> 3) & 1, x & 7, 0, smem); }
      }
      unsigned* bc = (unsigned*)(smem + SMEM_BYTES - 16);
      while (true) {
        __syncthreads();
        if (tidx() == 0) *bc = atomicAdd(p.ctr + layer, 1u);
        __syncthreads();
        const int it = (int)*bc;
        if (it >= 1104 + NCONV_FFN) break;
        if (it >= 1104) { conv_ffn(p, layer, 1, it - 1104, smem); continue; }
        int s, hd, qb;
        if (it < 528) { s = it / 264; int rem = it - s * 264; hd = rem / 33; qb = rem - hd * 33; }
        else { int x = it - 528; s = 2 + x / 72; int rem = x % 72; hd = rem / 9; qb = rem - hd * 9; }
#ifdef PROBE_ATT2
        attn_item(p, s, hd, qb, smem, p.ctr[8] == 12345u);
        __syncthreads();
#endif
        attn_item(p, s, hd, qb, smem);
      }
    } break;
    case 5: if (EN(5)) {
      g.W = p.wM + OFF_G; g.K = 192; g.a0 = p.regB + 1792; g.a1 = g.a0; g.ld0 = g.ld1 = 1952; g.split = 1 << 30; g.ks0 = 64;
      gemm_phase<0, EPI_POST, 128>(p, g, 4, smem);
    } break;
    case 6: if (EN(6)) {
      g.a0 = outb + (size_t)TP * 1024; g.ld0 = 768; g.split = 8; g.ks0 = 96; g.a1 = outb; g.ld1 = 1024; g.W = p.wM + OFF_OUT; g.K = 1024;
      gemm_phase<0, EPI_RES, 128>(p, g, 8, smem);
    } break;
  }
}

template <bool COOP>
__global__ void __launch_bounds__(NTHR) mega(Params pp, int lo, int hi) {
  extern __shared__ __attribute__((aligned(16))) char smem[];
  const __attribute__((address_space(4))) Params* kp = (const __attribute__((address_space(4))) Params*)__builtin_amdgcn_kernarg_segment_ptr();
  volatile LAS unsigned* st = (volatile LAS unsigned*)(smem + SMEM_BYTES - 32);
  if (threadIdx.x == 0) { st[0] = 0u; st[1] = 0u; }
  __syncthreads();
  XcdBarrier xb = xcd_barrier_post(kp->bar, st);
  for (int ph = lo; ph < hi; ++ph) {
    if (ph == 10) continue;
    asm volatile("" : "+s"(kp));
    run_phase(*kp, ph, smem);
    if (COOP && ph + 1 < hi) {
      if (ph == 0) cg::this_grid().sync();
      else xcd_barrier(xb);
    }
  }
}

extern "C" void kernel_launch(void* const* d_in, const int* in_sizes, int n_in, void* d_out, int out_size, void* d_ws, size_t ws_size,
                              hipStream_t stream) {
  Params p{};
  const float** pf = (const float**)&p;
  for (int i = 0; i < 30; ++i) pf[i] = (const float*)d_in[i];
  p.out = (float*)d_out;
  char* w = (char*)d_ws;
  size_t off = 0;
  auto take = [&](size_t bytes) { char* r = w + off; off += (bytes + 255) & ~(size_t)255; return r; };
  p.hb = (u16*)take((size_t)TP * 1024 * 2);
  p.regB = (u16*)take((size_t)TP * 1952 * 2);
  p.kn = (u16*)take((size_t)TP * 512 * 2);
  p.vt = (u16*)take((size_t)TP * 512 * 2);
  p.wF = (u16*)take((size_t)WF_ELEMS * 2);
  p.wM = (u16*)take((size_t)WM_ELEMS * 2);
  p.ssq = (float*)take((size_t)16 * TP * 4);
  p.ssqq = (float*)take((size_t)6 * TP * 4);
  p.bsc = (float*)take((size_t)2 * TP * 8 * 4);
  p.ropec = (float*)take((size_t)LPR * 16 * 4);
  p.ropes = (float*)take((size_t)LPR * 16 * 4);
  p.ctr = (unsigned*)take(256);
  p.bar = (unsigned*)take((size_t)XCD_BAR_WORDS * 4);
  if (off > ws_size) fprintf(stderr, "workspace too small: need %zu have %zu\n", off, ws_size);
#ifndef MULTI_LAUNCH
  static int grid_blocks = 0;
  if (!grid_blocks) {
    hipFuncSetAttribute((const void*)mega<true>, hipFuncAttributeMaxDynamicSharedMemorySize, SMEM_BYTES);
    int dev = 0, cus = 0, per_cu = 0;
    hipGetDevice(&dev);
    hipDeviceGetAttribute(&cus, hipDeviceAttributeMultiprocessorCount, dev);
    hipOccupancyMaxActiveBlocksPerMultiprocessor(&per_cu, mega<true>, NTHR, SMEM_BYTES);
    if (per_cu > 1) per_cu = 1;
    grid_blocks = cus * per_cu;
  }
  hipMemsetAsync(p.bar, 0, (size_t)XCD_BAR_WORDS * 4, stream);
  int lo = 0, hi = NPHASE;
  void* args[] = {&p, &lo, &hi};
  hipError_t e = hipLaunchCooperativeKernel((void*)mega<true>, dim3(grid_blocks), dim3(NTHR), args, SMEM_BYTES, stream);
  if (e != hipSuccess) fprintf(stderr, "cooperative launch failed: %s (grid %d)\n", hipGetErrorString(e), grid_blocks);
#else
  hipFuncSetAttribute((const void*)mega<false>, hipFuncAttributeMaxDynamicSharedMemorySize, SMEM_BYTES);
  for (int ph = 0; ph < NPHASE; ++ph) mega<false><<<256, NTHR, SMEM_BYTES, stream>>>(p, ph, ph + 1);
#endif
}
```

```cpp
#include <hip/hip_runtime.h>
#include <hip/hip_cooperative_groups.h>
#include <cstdio>
namespace cg = cooperative_groups;

typedef unsigned short u16;
typedef __attribute__((ext_vector_type(8))) short bf16x8;
typedef __attribute__((ext_vector_type(16))) float f32x16;
#define DI __device__ __forceinline__
#define MFMA(a, b, c) __builtin_amdgcn_mfma_f32_32x32x16_bf16((a), (b), (c), 0, 0, 0)

constexpr int T = 32928, TP = 33024, LPR = 8208, LSM = 2064, NMT = 129;
constexpr int NTHR = 512;
constexpr float RMS_EPS = 1e-6f, LNX_EPS = 64e-5f;
constexpr float QSCALE = 0.10206207261596575f * 1.4426950408889634f;
constexpr int OFF_IN = 0, OFF_UQ = 2621440, OFF_UKV = 2818048, OFF_DEC = 2949120, OFF_A = 3014656, OFF_G = 3080192, OFF_OUT = 3178496, WM_ELEMS = 4227072;
constexpr int OFF_WD = 5767168, WF_ELEMS = 8650752;
constexpr int SMEM_BYTES = 149504;

__constant__ double ROPE_INV[16] = {1.0, 0.5623413251903491, 0.31622776601683794, 0.1778279410038923, 0.1, 0.05623413251903491,
  0.031622776601683794, 0.01778279410038923, 0.01, 0.005623413251903491, 0.0031622776601683794, 0.001778279410038923,
  0.001, 0.0005623413251903491, 0.00031622776601683794, 0.0001778279410038923};

struct Params {
  const float *x_prompt, *x_sample, *meta, *ffn1_norm, *ffn1_wg, *ffn1_wu, *ffn1_wd, *mix_norm, *w_in, *shift_mu, *q_norm, *w_uq,
      *kv_norm, *w_ukv, *decay_w0, *decay_w2, *iclr_a0, *iclr_a2, *gate_g2, *key_k_k, *key_k_a, *bonus_r_k, *lnx_w, *lnx_b, *w_out,
      *ffn2_norm, *ffn2_wg, *ffn2_wu, *ffn2_wd, *final_norm;
  float* out;
  u16 *hb, *regB, *kn, *vt, *wF, *wM;
  float *ssq, *ssqq, *bsc, *ropec, *ropes;
  unsigned* ctr;
  unsigned* bar;
};

typedef const __attribute__((address_space(4))) Params& CP;
DI int tidx() { int t = __builtin_amdgcn_workitem_id_x(); asm volatile("" : "+v"(t)); return t; }
DI u16 f2bf(float x) { unsigned u = __float_as_uint(x); u += 0x7fffu + ((u >> 16) & 1u); return (u16)(u >> 16); }
DI float bf2f(u16 b) { return __uint_as_float(((unsigned)b) << 16); }
typedef __bf16 bf16x2_t __attribute__((ext_vector_type(2)));
typedef float fl2_t __attribute__((ext_vector_type(2)));
DI unsigned pack2(float a, float b) { fl2_t f; f.x = a; f.y = b; bf16x2_t r = __builtin_convertvector(f, bf16x2_t); return __builtin_bit_cast(unsigned, r); }
DI float bflo(unsigned u) { return __uint_as_float(u << 16); }
DI float bfhi(unsigned u) { return __uint_as_float(u & 0xffff0000u); }
DI float sigmoidf_(float x) { return __builtin_amdgcn_rcpf(1.f + __expf(-x)); }
DI int crow(int reg, int h) { return (reg & 3) + 8 * (reg >> 2) + 4 * h; }
DI void row2seq(int r, int& s, int& pos, int& L) {
  if (r < 2 * LPR) { s = r >= LPR ? 1 : 0; pos = r - s * LPR; L = LPR; }
  else { int q = (r - 2 * LPR) / LSM; s = 2 + q; pos = r - 2 * LPR - q * LSM; L = LSM; }
}
DI int seq_start(int s) { return s < 2 ? s * LPR : 2 * LPR + (s - 2) * LSM; }
DI int seq_len(int s) { return s < 2 ? LPR : LSM; }
DI float dpp_sum8(float x) {
  x += __int_as_float(__builtin_amdgcn_update_dpp(0, __float_as_int(x), 0xB1, 0xf, 0xf, false));
  x += __int_as_float(__builtin_amdgcn_update_dpp(0, __float_as_int(x), 0x4E, 0xf, 0xf, false));
  x += __int_as_float(__builtin_amdgcn_update_dpp(0, __float_as_int(x), 0x141, 0xf, 0xf, false));
  return x;
}
DI float sum16(float x) {
  x += __int_as_float(__builtin_amdgcn_update_dpp(0, __float_as_int(x), 0x128, 0xf, 0xf, false));
  x += __int_as_float(__builtin_amdgcn_update_dpp(0, __float_as_int(x), 0x124, 0xf, 0xf, false));
  x += __int_as_float(__builtin_amdgcn_update_dpp(0, __float_as_int(x), 0x122, 0xf, 0xf, false));
  x += __int_as_float(__builtin_amdgcn_update_dpp(0, __float_as_int(x), 0x121, 0xf, 0xf, false));
  return x;
}
DI float rstd16(const float* ssq, int m) {
  float s = 0.f;
#pragma unroll
  for (int c = 0; c < 16; ++c) s += ssq[(size_t)c * TP + m];
  return rsqrtf(s * (1.f / 1024.f) + RMS_EPS);
}

struct CJob { const float* src; const float* gain; u16* dst; int K, N, ld, map, nkt; };
DI int rowmap(int map, int n) {
  if (map == 1) return (n >> 5) * 64 + (n & 31);
  if (map == 2) return (n >> 5) * 64 + 32 + (n & 31);
  if (map == 3) return n < 416 ? n : n + 96;
  return n;
}
DI void conv_tile(const CJob& jb, int t, char* smem) {
  float* tile = (float*)smem;
  const int tid = tidx();
  const int kt = t % jb.nkt, ntile = t / jb.nkt;
  const int k0 = kt * 64, n0 = ntile * 64;
  const int tx = tid & 63, ty = tid >> 6;
#pragma unroll
  for (int i = 0; i < 8; ++i) {
    int k = k0 + ty + 8 * i;
    float v = 0.f;
    if (k < jb.K) { v = jb.src[(size_t)k * jb.N + n0 + tx]; if (jb.gain) v *= jb.gain[k]; }
    tile[(ty + 8 * i) * 65 + tx] = v;
  }
  __syncthreads();
  const int ny = tid >> 3, kx = tid & 7;
  uint4 o;
  o.x = pack2(tile[(kx * 8 + 0) * 65 + ny], tile[(kx * 8 + 1) * 65 + ny]);
  o.y = pack2(tile[(kx * 8 + 2) * 65 + ny], tile[(kx * 8 + 3) * 65 + ny]);
  o.z = pack2(tile[(kx * 8 + 4) * 65 + ny], tile[(kx * 8 + 5) * 65 + ny]);
  o.w = pack2(tile[(kx * 8 + 6) * 65 + ny], tile[(kx * 8 + 7) * 65 + ny]);
  *(uint4*)(jb.dst + (size_t)rowmap(jb.map, n0 + ny) * jb.ld + k0 + kx * 8) = o;
  __syncthreads();
}
constexpr int NCONV_FFN = 2112, NCONV_MIX = 1032;
DI void conv_ffn(CP p, int l, int f, int t, char* smem) {
  CJob jb;
  u16* slot = (l == 1 && f == 0) ? p.kn : p.wF;
  const float* wg = f ? p.ffn2_wg : p.ffn1_wg; const float* wu = f ? p.ffn2_wu : p.ffn1_wu; const float* wd = f ? p.ffn2_wd : p.ffn1_wd;
  const float* nr = f ? p.ffn2_norm : p.ffn1_norm;
  if (t < 704) { jb = CJob{wg + (size_t)l * 1024 * 2816, nr + l * 1024, slot, 1024, 2816, 1024, 1, 16}; }
  else if (t < 1408) { t -= 704; jb = CJob{wu + (size_t)l * 1024 * 2816, nr + l * 1024, slot, 1024, 2816, 1024, 2, 16}; }
  else { t -= 1408; jb = CJob{wd + (size_t)l * 2816 * 1024, nullptr, slot + OFF_WD, 2816, 1024, 2816, 0, 44}; }
  conv_tile(jb, t, smem);
}
DI void conv_mix(CP p, int l, int t, char* smem) {
  CJob jb;
  if (t < 592) jb = CJob{p.w_in + (size_t)l * 1024 * 2368, p.mix_norm + l * 1024, p.wM + OFF_IN, 1024, 2368, 1024, 3, 16};
  else if (t < 640) { t -= 592; jb = CJob{p.w_uq + (size_t)l * 256 * 768, p.q_norm + l * 256, p.wM + OFF_UQ, 256, 768, 256, 0, 4}; }
  else if (t < 672) { t -= 640; jb = CJob{p.w_ukv + (size_t)l * 128 * 1024, p.kv_norm + l * 128, p.wM + OFF_UKV, 128, 1024, 128, 0, 2}; }
  else if (t < 688) { t -= 672; int d = t >> 3; t &= 7; jb = CJob{p.decay_w2 + (size_t)(l * 2 + d) * 64 * 512, nullptr, p.wM + OFF_DEC + d * 32768, 64, 512, 64, 0, 1}; }
  else if (t < 704) { t -= 688; int d = t >> 3; t &= 7; jb = CJob{p.iclr_a2 + (size_t)(l * 2 + d) * 64 * 512, nullptr, p.wM + OFF_A + d * 32768, 64, 512, 64, 0, 1}; }
  else if (t < 728) { t -= 704; jb = CJob{p.gate_g2 + (size_t)l * 160 * 512, nullptr, p.wM + OFF_G, 160, 512, 192, 0, 3}; }
  else if (t < 984) { t -= 728; jb = CJob{p.w_out + (size_t)l * 1024 * 1024, nullptr, p.wM + OFF_OUT, 1024, 1024, 1024, 0, 16}; }
  else {
    t -= 984;
    size_t base = (t < 24) ? (size_t)416 * 1024 + (size_t)t * 4096 : (size_t)2464 * 1024 + (size_t)(t - 24) * 4096;
    *(uint4*)(p.wM + OFF_IN + base + tidx() * 8) = make_uint4(0, 0, 0, 0);
    return;
  }
  conv_tile(jb, t, smem);
}

struct GArgs { const u16 *a0, *a1; int ld0, ld1, split, ks0; const u16* W; int K; int layer; float scale; };
enum { EPI_UP = 0, EPI_RES = 1, EPI_INPROJ = 2, EPI_Q = 3, EPI_KV = 4, EPI_POST = 5 };

DI uint4 load_gate(CP p, int layer, int m, int k) {
  uint4 z = make_uint4(0, 0, 0, 0);
  if (m >= T || k >= 160) return z;
  int s, pos, L; row2seq(m, s, pos, L);
  const u16* pb = p.regB + (size_t)m * 1952 + 1792 + k;
  uint4 c = *(const uint4*)pb;
  uint4 pm = pos > 0 ? *(const uint4*)(pb - 1952) : z;
  uint4 pp = pos + 1 < L ? *(const uint4*)(pb + 1952) : z;
  const float* mu0 = p.shift_mu + (size_t)(layer * 2 + 0) * 1952 + 1792 + k;
  const float* mu1 = p.shift_mu + (size_t)(layer * 2 + 1) * 1952 + 1792 + k;
  unsigned cc[4] = {c.x, c.y, c.z, c.w}, mm[4] = {pm.x, pm.y, pm.z, pm.w}, nn[4] = {pp.x, pp.y, pp.z, pp.w};
  unsigned o[4];
#pragma unroll
  for (int e = 0; e < 4; ++e) {
    float c0 = bflo(cc[e]), c1 = bfhi(cc[e]);
    float x0 = c0 + mu0[2 * e] * (bflo(mm[e]) - c0) + mu1[2 * e] * (bflo(nn[e]) - c0);
    float x1 = c1 + mu0[2 * e + 1] * (bfhi(mm[e]) - c1) + mu1[2 * e + 1] * (bfhi(nn[e]) - c1);
    o[e] = pack2(sigmoidf_(x0), sigmoidf_(x1));
  }
  return make_uint4(o[0], o[1], o[2], o[3]);
}

template <int MODE>
DI uint4 load_a(CP p, const GArgs& g, int row, int kt, int kc) {
  if (MODE == 1) return load_gate(p, g.layer, row, kt * 64 + kc * 8);
  const u16* ap = (kt < g.split) ? g.a0 + (size_t)row * g.ld0 + kt * g.ks0 : g.a1 + (size_t)row * g.ld1 + (kt - g.split) * 64;
  return *(const uint4*)(ap + kc * 8);
}

DI u16* halo_ptr(CP p) { return (u16*)p.out + (size_t)TP * 1024 + (size_t)TP * 768 + (size_t)TP * 32; }
DI uint4 ldg16(const u16* p) { uint4 v = *(const uint4*)p; return v; }
DI void sts16(u16* p, uint4 v) { *(uint4*)p = v; }
DI void store4(u16* dst, float a, float b, float c, float d) { *(uint2*)dst = make_uint2(pack2(a, b), pack2(c, d)); }

template <int MODE, int EPI, int BN>
DI void gemm_tile(CP p, const GArgs& g, int mt, int nt, char* smem) {
  constexpr int WN = BN / 64, WM = 8 / WN, MI = 256 / WM / 32, NWC = BN / 64;
  u16* As = (u16*)smem;
  u16* Ws = As + 2 * 256 * 72;
  const int tid = tidx(), lane = tid & 63, wv = tid >> 6, wm = wv / WN, wn = wv % WN, l32 = lane & 31, hh = lane >> 5;
  const int m0 = mt * 256, n0 = nt * BN;
  const int nk = g.K >> 6;
  f32x16 acc[MI][2];
#pragma unroll
  for (int i = 0; i < MI; ++i)
#pragma unroll
    for (int j = 0; j < 2; ++j)
#pragma unroll
      for (int r = 0; r < 16; ++r) acc[i][j][r] = 0.f;
  uint4 ra0[4], ra1[4], rw0[4], rw1[4];
#define GLA(KT, DA, I) { const int c_ = tid + (I) * 512; DA[I] = load_a<MODE>(p, g, m0 + (c_ >> 3), (KT), c_ & 7); }
#define GLW(KT, DW, I) if ((I) < NWC) { const int c_ = tid + (I) * 512; DW[I] = ldg16(g.W + (size_t)(n0 + (c_ >> 3)) * g.K + (KT) * 64 + (c_ & 7) * 8); }
#define GLOAD(KT, DA, DW) do { GLA(KT, DA, 0) GLA(KT, DA, 1) GLA(KT, DA, 2) GLA(KT, DA, 3) GLW(KT, DW, 0) GLW(KT, DW, 1) GLW(KT, DW, 2) GLW(KT, DW, 3) } while (0)
#define LSA(BUF, DA, I) { const int c_ = tid + (I) * 512; sts16(As + ((BUF) * 256 + (c_ >> 3)) * 72 + (c_ & 7) * 8, DA[I]); }
#define LSW(BUF, DW, I) if ((I) < NWC) { const int c_ = tid + (I) * 512; sts16(Ws + ((BUF) * BN + (c_ >> 3)) * 72 + (c_ & 7) * 8, DW[I]); }
#define LSTORE(BUF, DA, DW) do { LSA(BUF, DA, 0) LSA(BUF, DA, 1) LSA(BUF, DA, 2) LSA(BUF, DA, 3) LSW(BUF, DW, 0) LSW(BUF, DW, 1) LSW(BUF, DW, 2) LSW(BUF, DW, 3) } while (0)
  auto compute = [&](int buf) {
    const u16* Ab = As + buf * 256 * 72 + (wm * (MI * 32) + l32) * 72 + hh * 8;
    const u16* Wb = Ws + buf * BN * 72 + (wn * 64 + l32) * 72 + hh * 8;
#pragma unroll
    for (int ks = 0; ks < 4; ++ks) {
      bf16x8 wf0 = *(const bf16x8*)(Wb + ks * 16);
      bf16x8 wf1 = *(const bf16x8*)(Wb + 32 * 72 + ks * 16);
#pragma unroll
      for (int i = 0; i < MI; ++i) {
        bf16x8 xf = *(const bf16x8*)(Ab + i * 32 * 72 + ks * 16);
        acc[i][0] = MFMA(wf0, xf, acc[i][0]);
        acc[i][1] = MFMA(wf1, xf, acc[i][1]);
      }
    }
  };
  if (true) {
    char* L0 = smem;
    constexpr int BUFB = (256 + BN) * 128;
    constexpr int NBUF = BN <= 128 ? 3 : 2;
    constexpr int NGL = 4 + BN / 64;
    const int gl_row = lane >> 3;
    auto issue = [&](int kt, int buf) {
      char* lb = L0 + buf * BUFB;
#pragma unroll
      for (int i = 0; i < 4; ++i) {
        const int seg = wv * 4 + i, row = seg * 8 + gl_row;
        const int c = (lane & 7) ^ ((row >> 1) & 7);
        const u16* ap = (kt < g.split) ? g.a0 + (size_t)(m0 + row) * g.ld0 + kt * g.ks0 : g.a1 + (size_t)(m0 + row) * g.ld1 + (kt - g.split) * 64;
        __builtin_amdgcn_global_load_lds((const unsigned*)(ap + c * 8), (__attribute__((address_space(3))) unsigned*)(lb + seg * 1024 + lane * 16), 16, 0, 0);
      }
#pragma unroll
      for (int i = 0; i < BN / 64; ++i) {
        const int seg = wv * (BN / 64) + i, row = seg * 8 + gl_row;
        const int c = (lane & 7) ^ ((row >> 1) & 7);
        __builtin_amdgcn_global_load_lds((const unsigned*)(g.W + (size_t)(n0 + row) * g.K + kt * 64 + c * 8),
                                         (__attribute__((address_space(3))) unsigned*)(lb + 256 * 128 + seg * 1024 + lane * 16), 16, 0, 0);
      }
    };
    auto compute2 = [&](int buf) {
      const char* lb = L0 + buf * BUFB;
#pragma unroll
      for (int ks = 0; ks < 4; ++ks) {
        const int c = ks * 2 + hh;
        bf16x8 wf[2], xf[MI];
#pragma unroll
        for (int j = 0; j < 2; ++j) { const int r = wn * 64 + j * 32 + l32; wf[j] = *(const bf16x8*)(lb + 256 * 128 + r * 128 + ((c ^ ((r >> 1) & 7)) << 4)); }
#pragma unroll
        for (int i = 0; i < MI; ++i) { const int r = wm * (MI * 32) + i * 32 + l32; xf[i] = *(const bf16x8*)(lb + r * 128 + ((c ^ ((r >> 1) & 7)) << 4)); }
#pragma unroll
        for (int i = 0; i < MI; ++i) {
          acc[i][0] = MFMA(wf[0], xf[i], acc[i][0]);
          acc[i][1] = MFMA(wf[1], xf[i], acc[i][1]);
        }
      }
    };
    if (NBUF == 3) {
      issue(0, 0);
      if (nk > 1) { issue(1, 1); if (BN == 128) asm volatile("s_waitcnt vmcnt(6)" ::: "memory"); else asm volatile("s_waitcnt vmcnt(5)" ::: "memory"); }
      else asm volatile("s_waitcnt vmcnt(0)" ::: "memory");
      asm volatile("s_waitcnt lgkmcnt(0)" ::: "memory");
      __builtin_amdgcn_s_barrier();
      int buf = 0;
      for (int kt = 0; kt < nk; ++kt) {
        const int b2 = buf == 0 ? 2 : buf - 1;
        if (kt + 2 < nk) issue(kt + 2, b2);
        compute2(buf);
        if (kt + 2 < nk) { if (BN == 128) asm volatile("s_waitcnt vmcnt(6)" ::: "memory"); else asm volatile("s_waitcnt vmcnt(5)" ::: "memory"); }
        else asm volatile("s_waitcnt vmcnt(0)" ::: "memory");
        asm volatile("s_waitcnt lgkmcnt(0)" ::: "memory");
        __builtin_amdgcn_s_barrier();
        buf = buf == 2 ? 0 : buf + 1;
      }
    } else {
      issue(0, 0);
      asm volatile("s_waitcnt vmcnt(0)" ::: "memory");
      __syncthreads();
      for (int kt = 0; kt < nk; ++kt) {
        const int buf = kt & 1;
        if (kt + 1 < nk) issue(kt + 1, buf ^ 1);
        compute2(buf);
        asm volatile("s_waitcnt vmcnt(0)" ::: "memory");
        __syncthreads();
      }
    }
    __syncthreads();
  } else {
    GLOAD(0, ra0, rw0);
    LSTORE(0, ra0, rw0);
    __syncthreads();
    for (int kt = 0; kt < nk; ++kt) {
      const int buf = kt & 1;
      if (kt + 1 < nk) GLOAD(kt + 1, ra0, rw0);
      compute(buf);
      if (kt + 1 < nk) LSTORE(buf ^ 1, ra0, rw0);
      __syncthreads();
    }
  }
#undef GLOAD
#undef LSTORE
  const int nw = n0 + wn * 64;
#pragma unroll
  for (int i = 0; i < MI; ++i) {
    const int m = m0 + wm * (MI * 32) + i * 32 + l32;
    if (EPI == EPI_UP) {
      const float rs = rstd16(p.ssq, m);
      const int hb0 = nw >> 1;
#pragma unroll
      for (int gq = 0; gq < 4; ++gq) {
        float v[4];
#pragma unroll
        for (int r = 0; r < 4; ++r) {
          float gt = acc[i][0][4 * gq + r] * rs, up = acc[i][1][4 * gq + r] * rs;
          v[r] = gt * sigmoidf_(gt) * up;
        }
        int hid = hb0 + 8 * gq + 4 * hh;
        u16* dst = hid < 1408 ? p.regB + (size_t)m * 1408 + hid : (u16*)p.out + (size_t)m * 1408 + (hid - 1408);
        store4(dst, v[0], v[1], v[2], v[3]);
      }
    } else if (EPI == EPI_RES) {
      float ss = 0.f;
#pragma unroll
      for (int j = 0; j < 2; ++j)
#pragma unroll
        for (int gq = 0; gq < 4; ++gq) {
          u16* hp = p.hb + (size_t)m * 1024 + nw + j * 32 + 8 * gq + 4 * hh;
          uint2 old = *(const uint2*)hp;
          float h0 = bflo(old.x) + g.scale * acc[i][j][4 * gq + 0];
          float h1 = bfhi(old.x) + g.scale * acc[i][j][4 * gq + 1];
          float h2 = bflo(old.y) + g.scale * acc[i][j][4 * gq + 2];
          float h3 = bfhi(old.y) + g.scale * acc[i][j][4 * gq + 3];
          unsigned p0 = pack2(h0, h1), p1 = pack2(h2, h3);
          *(uint2*)hp = make_uint2(p0, p1);
          float r0 = bflo(p0), r1 = bfhi(p0), r2 = bflo(p1), r3 = bfhi(p1);
          ss += r0 * r0 + r1 * r1 + r2 * r2 + r3 * r3;
        }
      ss += __shfl_xor(ss, 32);
      if (hh == 0) p.ssq[(size_t)(nw >> 6) * TP + m] = ss;
    } else if (EPI == EPI_INPROJ) {
      const float rs = rstd16(p.ssq, m);
      int s, pos, L; row2seq(m < T ? m : 0, s, pos, L);
      float ss = 0.f;
#pragma unroll
      for (int j = 0; j < 2; ++j) {
        const int nb = nw + j * 32;
        if (nb == 384) {
          u16* kr = (u16*)p.out + (size_t)TP * 1024 + (size_t)TP * 768 + (size_t)m * 32;
#pragma unroll
          for (int gq = 0; gq < 2; ++gq) {
            float o1[4], o2[4];
#pragma unroll
            for (int r = 0; r < 4; ++r) {
              int ii = 8 * gq + 4 * hh + r;
              float c = p.ropec[pos * 16 + ii], sn = p.ropes[pos * 16 + ii];
              float x1 = acc[i][j][4 * gq + r] * rs, x2 = acc[i][j][4 * (gq + 2) + r] * rs;
              o1[r] = x1 * c - x2 * sn; o2[r] = x2 * c + x1 * sn;
            }
            store4(kr + 8 * gq + 4 * hh, o1[0], o1[1], o1[2], o1[3]);
            store4(kr + 16 + 8 * gq + 4 * hh, o2[0], o2[1], o2[2], o2[3]);
          }
        } else {
#pragma unroll
          for (int gq = 0; gq < 4; ++gq) {
            int n = nb + 8 * gq + 4 * hh;
            unsigned p0 = pack2(acc[i][j][4 * gq] * rs, acc[i][j][4 * gq + 1] * rs);
            unsigned p1 = pack2(acc[i][j][4 * gq + 2] * rs, acc[i][j][4 * gq + 3] * rs);
            if (n < 512) {
              *(uint2*)((u16*)p.out + (size_t)m * 512 + n) = make_uint2(p0, p1);
              float r0 = bflo(p0), r1 = bfhi(p0), r2 = bflo(p1), r3 = bfhi(p1);
              ss += r0 * r0 + r1 * r1 + r2 * r2 + r3 * r3;
            } else if (n - 512 < 1952) {
              *(uint2*)(p.regB + (size_t)m * 1952 + (n - 512)) = make_uint2(p0, p1);
              if (m < T && ((pos & 63) == 0 || (pos & 63) == 63)) {
                const int ch = (s < 2 ? s * 129 : 258 + (s - 2) * 33) + (pos >> 6);
                *(uint2*)(halo_ptr(p) + ((size_t)ch * 2 + ((pos & 63) ? 1 : 0)) * 1952 + (n - 512)) = make_uint2(p0, p1);
              }
            }
          }
        }
      }
      if (nw < 384) {
        ss += __shfl_xor(ss, 32);
        if (hh == 0) p.ssqq[(size_t)(nw >> 6) * TP + m] = ss;
      }
    } else if (EPI == EPI_Q) {
      float sq = p.ssqq[m] + p.ssqq[(size_t)TP + m] + p.ssqq[(size_t)2 * TP + m] + p.ssqq[(size_t)3 * TP + m];
      const float rs = rsqrtf(sq * (1.f / 256.f) + RMS_EPS) * QSCALE;
      int s, pos, L; row2seq(m < T ? m : 0, s, pos, L);
      u16* qrow = (u16*)p.out + (size_t)TP * 1024 + (size_t)m * 768;
#pragma unroll
      for (int j = 0; j < 2; ++j) {
        const int nb = nw + j * 32;
        if (((nb >> 5) % 3) == 2) {
#pragma unroll
          for (int gq = 0; gq < 2; ++gq) {
            float o1[4], o2[4];
#pragma unroll
            for (int r = 0; r < 4; ++r) {
              int ii = 8 * gq + 4 * hh + r;
              float c = p.ropec[pos * 16 + ii], sn = p.ropes[pos * 16 + ii];
              float x1 = acc[i][j][4 * gq + r] * rs, x2 = acc[i][j][4 * (gq + 2) + r] * rs;
              o1[r] = x1 * c - x2 * sn; o2[r] = x2 * c + x1 * sn;
            }
            store4(qrow + nb + 8 * gq + 4 * hh, o1[0], o1[1], o1[2], o1[3]);
            store4(qrow + nb + 16 + 8 * gq + 4 * hh, o2[0], o2[1], o2[2], o2[3]);
          }
        } else {
#pragma unroll
          for (int gq = 0; gq < 4; ++gq)
            store4(qrow + nb + 8 * gq + 4 * hh, acc[i][j][4 * gq] * rs, acc[i][j][4 * gq + 1] * rs, acc[i][j][4 * gq + 2] * rs, acc[i][j][4 * gq + 3] * rs);
        }
      }
    } else if (EPI == EPI_KV) {
      if (m < T) {
        float sq = p.ssqq[(size_t)4 * TP + m] + p.ssqq[(size_t)5 * TP + m];
        const float rs = rsqrtf(sq * (1.f / 128.f) + RMS_EPS);
        int s, pos, L; row2seq(m, s, pos, L);
        const int head = nw >> 7;
        const int ppos = (pos & ~15) | (pos & 3) | (((pos >> 3) & 1) << 2) | (((pos >> 2) & 1) << 3);
#pragma unroll
        for (int j = 0; j < 2; ++j) {
          const int jj = (nw & 127) + j * 32;
#pragma unroll
          for (int gq = 0; gq < 4; ++gq) {
            int c = jj + 8 * gq + 4 * hh;
            if (jj < 64) {
              store4(p.kn + (size_t)m * 512 + head * 64 + c, acc[i][j][4 * gq] * rs, acc[i][j][4 * gq + 1] * rs, acc[i][j][4 * gq + 2] * rs, acc[i][j][4 * gq + 3] * rs);
            } else {
#pragma unroll
              for (int r = 0; r < 4; ++r) {
                int dv = c - 64 + r;
                p.vt[(size_t)seq_start(s) * 512 + (size_t)(head * 64 + dv) * L + ppos] = f2bf(acc[i][j][4 * gq + r] * rs);
              }
            }
          }
        }
      }
    } else if (EPI == EPI_POST) {
      if (m < T) {
        int s, pos, L; row2seq(m, s, pos, L);
        const int hd = nw >> 6;
        u16* yb = (u16*)p.out + (size_t)m * 1024;
        float y[2][16];
        float sum = 0.f;
#pragma unroll
        for (int j = 0; j < 2; ++j)
#pragma unroll
          for (int gq = 0; gq < 4; ++gq) {
            int n = nw + j * 32 + 8 * gq + 4 * hh;
            uint2 a = *(const uint2*)(yb + n), b = *(const uint2*)(yb + 512 + n);
            y[j][4 * gq + 0] = bflo(a.x) + bflo(b.x); y[j][4 * gq + 1] = bfhi(a.x) + bfhi(b.x);
            y[j][4 * gq + 2] = bflo(a.y) + bflo(b.y); y[j][4 * gq + 3] = bfhi(a.y) + bfhi(b.y);
            sum += y[j][4 * gq] + y[j][4 * gq + 1] + y[j][4 * gq + 2] + y[j][4 * gq + 3];
          }
        sum += __shfl_xor(sum, 32);
        const float mu = sum * (1.f / 64.f);
        float vs = 0.f;
#pragma unroll
        for (int j = 0; j < 2; ++j)
#pragma unroll
          for (int r = 0; r < 16; ++r) { float dlt = y[j][r] - mu; vs += dlt * dlt; }
        vs += __shfl_xor(vs, 32);
        const float rstd = rsqrtf(vs * (1.f / 64.f) + LNX_EPS);
        const float bsum = p.bsc[(size_t)m * 8 + hd] + p.bsc[((size_t)TP + m) * 8 + hd];
        const u16* vb = p.regB + (size_t)m * 1952 + 1024;
#pragma unroll
        for (int j = 0; j < 2; ++j)
#pragma unroll
          for (int gq = 0; gq < 4; ++gq) {
            int n = nw + j * 32 + 8 * gq + 4 * hh;
            uint2 c = *(const uint2*)(vb + n);
            float cv[4] = {bflo(c.x), bfhi(c.x), bflo(c.y), bfhi(c.y)};
            float o[4];
#pragma unroll
            for (int r = 0; r < 4; ++r) {
              float vsh = cv[r];
              float yn = (y[j][4 * gq + r] - mu) * rstd * p.lnx_w[g.layer * 512 + n + r] + p.lnx_b[g.layer * 512 + n + r];
              o[r] = (yn + bsum * vsh) * acc[i][j][4 * gq + r];
            }
            store4(yb + n, o[0], o[1], o[2], o[3]);
          }
      }
    }
  }
}

template <int MODE, int EPI, int BN = 128>
DI void gemm_phase_item(CP p, const GArgs& g, int item, int NT, char* smem) {
  const int grp = item / (8 * NT);
  const int gsz = min(8, NMT - grp * 8);
  const int idx = item - grp * 8 * NT;
  gemm_tile<MODE, EPI, BN>(p, g, grp * 8 + idx % gsz, idx / gsz, smem);
}

template <int MODE, int EPI, int BN>
DI void gemm_phase(CP p, const GArgs& g, int NT, char* smem) {
  const int x = blockIdx.x & 7, j = blockIdx.x >> 3, nj = gridDim.x >> 3;
  const int total = 16 * NT;
  for (int e = j; e < total; e += nj) {
    const int grp = e / (8 * NT);
    const int rem = e - grp * 8 * NT;
    gemm_tile<MODE, EPI, BN>(p, g, x + 8 * (grp * 8 + (rem & 7)), rem >> 3, smem);
  }
  const int ntail = NT * (BN / 64);
  for (int e = (int)gridDim.x - 1 - (int)blockIdx.x; e < ntail; e += gridDim.x) gemm_tile<MODE, EPI, 64>(p, g, NMT - 1, e, smem);
}

DI void attn_item(CP p, int s, int hd, int qb, char* smem, bool dostore = true) {
  u16* Ks = (u16*)smem;
  u16* Vs = Ks + 2 * 64 * 104;
  const int tid = tidx(), lane = tid & 63, wv = tid >> 6, l32 = lane & 31, hh = lane >> 5;
  const int L = seq_len(s), r0 = seq_start(s);
  const u16* Qb = (const u16*)p.out + (size_t)TP * 1024;
  const u16* KR = Qb + (size_t)TP * 768;
  const int qpos = qb * 256 + wv * 32 + l32;
  const bool wvalid = (qb * 256 + wv * 32) < L;
  const int qrow = r0 + min(qpos, L - 1);
  bf16x8 qf[6];
#pragma unroll
  for (int ks = 0; ks < 6; ++ks) qf[ks] = *(const bf16x8*)(Qb + (size_t)qrow * 768 + hd * 96 + ks * 16 + hh * 8);
  f32x16 o[2];
#pragma unroll
  for (int u = 0; u < 2; ++u)
#pragma unroll
    for (int r = 0; r < 16; ++r) o[u][r] = 0.f;
  float mrun = -1e30f, lrun = 0.f;
  const int nt = (L + 63) >> 6;
  const u16* vtb = p.vt + (size_t)r0 * 512 + (size_t)hd * 64 * L;
  uint4 rg[3];
  auto ldc = [&](int kt, int c) -> uint4 {
    uint4 z = make_uint4(0, 0, 0, 0);
    if (c < 768) {
      int key = c / 12, cc = c - key * 12, kpos = kt * 64 + key;
      if (kpos >= L) return z;
      const u16* src = cc < 8 ? p.kn + (size_t)(r0 + kpos) * 512 + hd * 64 + cc * 8 : KR + (size_t)(r0 + kpos) * 32 + (cc - 8) * 8;
      return *(const uint4*)src;
    } else {
      int c2 = c - 768, dv = c2 >> 3, kc = c2 & 7, kp0 = kt * 64 + kc * 8;
      if (kp0 >= L) return z;
      return *(const uint4*)(vtb + (size_t)dv * L + kp0);
    }
  };
  auto stc = [&](int buf, int c, uint4 v) {
    if (c < 768) { int key = c / 12, cc = c - key * 12; *(uint4*)(Ks + (buf * 64 + key) * 104 + cc * 8) = v; }
    else { int c2 = c - 768, dv = c2 >> 3, kc = c2 & 7; *(uint4*)(Vs + (buf * 64 + dv) * 72 + kc * 8) = v; }
  };
  rg[0] = ldc(0, tid); rg[1] = ldc(0, tid + 512); if (tid < 256) rg[2] = ldc(0, tid + 1024);
  stc(0, tid, rg[0]); stc(0, tid + 512, rg[1]); if (tid < 256) stc(0, tid + 1024, rg[2]);
  __syncthreads();
  for (int kt = 0; kt < nt; ++kt) {
    const int buf = kt & 1;
    if (kt + 1 < nt) { rg[0] = ldc(kt + 1, tid); rg[1] = ldc(kt + 1, tid + 512); if (tid < 256) rg[2] = ldc(kt + 1, tid + 1024); }
    if (wvalid) {
      f32x16 st[2];
#pragma unroll
      for (int t = 0; t < 2; ++t) {
#pragma unroll
        for (int r = 0; r < 16; ++r) st[t][r] = 0.f;
        const u16* kb = Ks + (buf * 64 + t * 32 + l32) * 104 + hh * 8;
#pragma unroll
        for (int ks = 0; ks < 6; ++ks) st[t] = MFMA(*(const bf16x8*)(kb + ks * 16), qf[ks], st[t]);
      }
      if (kt == nt - 1) {
#pragma unroll
        for (int t = 0; t < 2; ++t)
#pragma unroll
          for (int r = 0; r < 16; ++r) if (kt * 64 + t * 32 + crow(r, hh) >= L) st[t][r] = -1e30f;
      }
      float mx = -1e30f;
#pragma unroll
      for (int t = 0; t < 2; ++t)
#pragma unroll
        for (int r = 0; r < 16; ++r) mx = fmaxf(mx, st[t][r]);
      mx = fmaxf(mx, __shfl_xor(mx, 32));
      const float mnew = fmaxf(mrun, mx);
      const float alpha = __builtin_amdgcn_exp2f(mrun - mnew);
      float ls = 0.f;
#pragma unroll
      for (int t = 0; t < 2; ++t)
#pragma unroll
        for (int r = 0; r < 16; ++r) { float pv = __builtin_amdgcn_exp2f(st[t][r] - mnew); st[t][r] = pv; ls += pv; }
      lrun = lrun * alpha + ls; mrun = mnew;
#pragma unroll
      for (int u = 0; u < 2; ++u)
#pragma unroll
        for (int r = 0; r < 16; ++r) o[u][r] *= alpha;
#pragma unroll
      for (int t = 0; t < 2; ++t)
#pragma unroll
        for (int s2 = 0; s2 < 2; ++s2) {
          uint4 pk;
          pk.x = pack2(st[t][8 * s2 + 0], st[t][8 * s2 + 1]); pk.y = pack2(st[t][8 * s2 + 2], st[t][8 * s2 + 3]);
          pk.z = pack2(st[t][8 * s2 + 4], st[t][8 * s2 + 5]); pk.w = pack2(st[t][8 * s2 + 6], st[t][8 * s2 + 7]);
          bf16x8 pf = __builtin_bit_cast(bf16x8, pk);
#pragma unroll
          for (int u = 0; u < 2; ++u) {
            bf16x8 vf = *(const bf16x8*)(Vs + (buf * 64 + u * 32 + l32) * 72 + t * 32 + s2 * 16 + hh * 8);
            o[u] = MFMA(vf, pf, o[u]);
          }
        }
    }
    if (kt + 1 < nt) { stc(buf ^ 1, tid, rg[0]); stc(buf ^ 1, tid + 512, rg[1]); if (tid < 256) stc(buf ^ 1, tid + 1024, rg[2]); }
    __syncthreads();
  }
  if (wvalid) {
    float lt = lrun + __shfl_xor(lrun, 32);
    const float inv = 1.f / lt;
    if (qpos < L && dostore) {
      u16* dst = (u16*)p.out + (size_t)TP * 1024 + (size_t)(r0 + qpos) * 768 + hd * 96;
#pragma unroll
      for (int u = 0; u < 2; ++u)
#pragma unroll
        for (int gq = 0; gq < 4; ++gq)
          store4(dst + u * 32 + 8 * gq + 4 * hh, o[u][4 * gq] * inv, o[u][4 * gq + 1] * inv, o[u][4 * gq + 2] * inv, o[u][4 * gq + 3] * inv);
    }
  }
}

DI void scan_block(CP p, int layer, int s, int d, int hd, char* smem) {
  float* OP = (float*)smem;
  float* WA = OP + 32 * 392;
  float* YB = WA + 2 * 32 * 64;
  u16* XL = (u16*)(YB + 32 * 64);
  float* MU = (float*)(XL + 2 * 32 * 72);
  float* CS = MU + 5 * 2 * 64;
  const int tid = tidx(), lane = tid & 63, wv = tid >> 6, l32 = lane & 31, hh = lane >> 5;
  const int L = seq_len(s), r0 = seq_start(s);
  const int sj = tid >> 4, q = tid & 15;
  const int rloc = lane >> 3, cg8 = lane & 7, row = wv * 8 + rloc;
  const int aoff[5] = {hd * 64, 512 + hd * 64, 1024 + hd * 64, 1536 + d * 64, 1664 + d * 64};
  __syncthreads();
  for (int i = tid; i < 640; i += NTHR) {
    int a = i >> 7, w = (i >> 6) & 1, c = i & 63;
    int off = a == 0 ? aoff[0] : a == 1 ? aoff[1] : a == 2 ? aoff[2] : a == 3 ? aoff[3] : aoff[4];
    MU[i] = p.shift_mu[(size_t)(layer * 2 + w) * 1952 + off + c];
  }
  if (tid < 64) {
    CS[tid] = p.key_k_k[layer * 512 + hd * 64 + tid];
    CS[64 + tid] = p.key_k_a[layer * 512 + hd * 64 + tid];
    CS[128 + tid] = p.bonus_r_k[layer * 512 + hd * 64 + tid];
  }
  const int mat = (wv >> 1) & 1, ntile = wv & 1;
  bf16x8 wfr[4];
  {
    const u16* wb = p.wM + (mat ? OFF_A : OFF_DEC) + (size_t)(d * 512 + hd * 64 + ntile * 32 + l32) * 64 + hh * 8;
#pragma unroll
    for (int ks = 0; ks < 4; ++ks) wfr[ks] = *(const bf16x8*)(wb + ks * 16);
  }
  const float bias = mat ? p.iclr_a0[(size_t)(layer * 2 + d) * 512 + hd * 64 + ntile * 32 + l32]
                         : p.decay_w0[(size_t)(layer * 2 + d) * 512 + hd * 64 + ntile * 32 + l32];
  __syncthreads();
  float S[8];
#pragma unroll
  for (int i = 0; i < 8; ++i) S[i] = 0.f;
  const int nch = (L + 31) >> 5;
  uint2 raw[15];
  float r4[4], k4[4], kk4[4], v4[4];

  auto prefetch = [&](int c) {
    const int sidx = c * 32 + sj;
    const bool valid = sidx < L;
    const int tok = d == 0 ? sidx : L - 1 - sidx;
    const u16* base = p.regB + (size_t)(r0 + tok) * 1952 + 4 * q;
#pragma unroll
    for (int a = 0; a < 5; ++a) {
      const int off = a == 0 ? aoff[0] : a == 1 ? aoff[1] : a == 2 ? aoff[2] : a == 3 ? aoff[3] : aoff[4];
      raw[a * 3 + 0] = (valid && tok > 0) ? *(const uint2*)(base - 1952 + off) : make_uint2(0, 0);
      raw[a * 3 + 1] = valid ? *(const uint2*)(base + off) : make_uint2(0, 0);
      raw[a * 3 + 2] = (valid && tok + 1 < L) ? *(const uint2*)(base + 1952 + off) : make_uint2(0, 0);
    }
  };
  auto shift4 = [&](int a, float* x) {
    const float4 m0 = *(const float4*)(MU + (a * 2 + 0) * 64 + 4 * q);
    const float4 m1 = *(const float4*)(MU + (a * 2 + 1) * 64 + 4 * q);
    const uint2 pm = raw[a * 3], c = raw[a * 3 + 1], pp = raw[a * 3 + 2];
    float c0 = bflo(c.x), c1 = bfhi(c.x), c2 = bflo(c.y), c3 = bfhi(c.y);
    x[0] = c0 + m0.x * (bflo(pm.x) - c0) + m1.x * (bflo(pp.x) - c0);
    x[1] = c1 + m0.y * (bfhi(pm.x) - c1) + m1.y * (bfhi(pp.x) - c1);
    x[2] = c2 + m0.z * (bflo(pm.y) - c2) + m1.z * (bflo(pp.y) - c2);
    x[3] = c3 + m0.w * (bfhi(pm.y) - c3) + m1.w * (bfhi(pp.y) - c3);
  };
  auto stage = [&](int c) {
    shift4(0, r4); shift4(1, k4); shift4(2, v4);
    float xw[4], xa[4];
    shift4(3, xw); shift4(4, xa);
#pragma unroll
    for (int e = 0; e < 4; ++e) xw[e] = 1.f - 2.f / (__expf(2.f * xw[e]) + 1.f);
    store4(XL + sj * 72 + 4 * q, xw[0], xw[1], xw[2], xw[3]);
    store4(XL + 32 * 72 + sj * 72 + 4 * q, xa[0], xa[1], xa[2], xa[3]);
    {
      const float4 kkw = *(const float4*)(CS + 4 * q);
      float x0 = k4[0] * kkw.x, x1 = k4[1] * kkw.y, x2 = k4[2] * kkw.z, x3 = k4[3] * kkw.w;
      float ss = sum16(x0 * x0 + x1 * x1 + x2 * x2 + x3 * x3);
      float inv = 1.f / fmaxf(sqrtf(ss), 1e-12f);
      kk4[0] = x0 * inv; kk4[1] = x1 * inv; kk4[2] = x2 * inv; kk4[3] = x3 * inv;
    }
    __syncthreads();
    if (wv < 4) {
      f32x16 acc;
#pragma unroll
      for (int r = 0; r < 16; ++r) acc[r] = 0.f;
      const u16* xb = XL + mat * 32 * 72 + l32 * 72 + hh * 8;
#pragma unroll
      for (int ks = 0; ks < 4; ++ks) acc = MFMA(*(const bf16x8*)(xb + ks * 16), wfr[ks], acc);
#pragma unroll
      for (int r = 0; r < 16; ++r) {
        float x = acc[r] + bias;
        float sg = sigmoidf_(x);
        float val = mat ? sg : __expf(-0.6065306597126334f * sg);
        WA[(mat * 32 + crow(r, hh)) * 64 + ntile * 32 + l32] = val;
      }
    }
    __syncthreads();
    {
      const float4 w4 = *(const float4*)(WA + sj * 64 + 4 * q);
      const float4 a4 = *(const float4*)(WA + (32 + sj) * 64 + 4 * q);
      const float4 ka = *(const float4*)(CS + 64 + 4 * q);
      const float4 brk = *(const float4*)(CS + 128 + 4 * q);
      const float wv4[4] = {w4.x, w4.y, w4.z, w4.w}, av4[4] = {a4.x, a4.y, a4.z, a4.w};
      const float kav[4] = {ka.x, ka.y, ka.z, ka.w}, bkv[4] = {brk.x, brk.y, brk.z, brk.w};
      float aa[4], wr[4], bb[4], kd[4];
      float br = 0.f, kr = 0.f, bs = 0.f;
#pragma unroll
      for (int e = 0; e < 4; ++e) {
        aa[e] = -kk4[e]; wr[e] = wv4[e] * r4[e]; bb[e] = kk4[e] * av4[e];
        kd[e] = k4[e] * (1.f + (av4[e] - 1.f) * kav[e]);
        br += bb[e] * r4[e]; kr += kd[e] * r4[e]; bs += r4[e] * kd[e] * bkv[e];
      }
      br = sum16(br); kr = sum16(kr); bs = sum16(bs);
      float* o = OP + sj * 392 + 4 * q;
      *(float4*)(o) = make_float4(aa[0], aa[1], aa[2], aa[3]);
      *(float4*)(o + 64) = make_float4(wr[0], wr[1], wr[2], wr[3]);
      *(float4*)(o + 128) = w4;
      *(float4*)(o + 192) = make_float4(bb[0], bb[1], bb[2], bb[3]);
      *(float4*)(o + 256) = make_float4(kd[0], kd[1], kd[2], kd[3]);
      *(float4*)(o + 320) = make_float4(v4[0], v4[1], v4[2], v4[3]);
      if (q == 0) {
        OP[sj * 392 + 384] = br; OP[sj * 392 + 385] = kr;
        const int sidx = c * 32 + sj;
        if (sidx < L) { const int tok = d == 0 ? sidx : L - 1 - sidx; p.bsc[((size_t)d * TP + r0 + tok) * 8 + hd] = bs; }
      }
    }
    __syncthreads();
  };

  prefetch(0);
  stage(0);
  for (int c = 0; c < nch; ++c) {
    if (c + 1 < nch) prefetch(c + 1);
    const int nst = min(32, L - c * 32);
    for (int jj = 0; jj < nst; ++jj) {
      const float* o = OP + jj * 392;
      const float4 a0 = *(const float4*)(o + cg8 * 8), a1 = *(const float4*)(o + cg8 * 8 + 4);
      const float4 y0 = *(const float4*)(o + 64 + cg8 * 8), y1 = *(const float4*)(o + 64 + cg8 * 8 + 4);
      const float4 w0 = *(const float4*)(o + 128 + cg8 * 8), w1 = *(const float4*)(o + 128 + cg8 * 8 + 4);
      const float4 b0 = *(const float4*)(o + 192 + cg8 * 8), b1 = *(const float4*)(o + 192 + cg8 * 8 + 4);
      const float4 k0 = *(const float4*)(o + 256 + cg8 * 8), k1 = *(const float4*)(o + 256 + cg8 * 8 + 4);
      const float vv = o[320 + row];
      const float2 sc = *(const float2*)(o + 384);
      float da = S[0] * a0.x + S[1] * a0.y + S[2] * a0.z + S[3] * a0.w + S[4] * a1.x + S[5] * a1.y + S[6] * a1.z + S[7] * a1.w;
      float dy = S[0] * y0.x + S[1] * y0.y + S[2] * y0.z + S[3] * y0.w + S[4] * y1.x + S[5] * y1.y + S[6] * y1.z + S[7] * y1.w;
      da = dpp_sum8(da); dy = dpp_sum8(dy);
      const float yv = dy + da * sc.x + vv * sc.y;
      S[0] = S[0] * w0.x + da * b0.x + vv * k0.x; S[1] = S[1] * w0.y + da * b0.y + vv * k0.y;
      S[2] = S[2] * w0.z + da * b0.z + vv * k0.z; S[3] = S[3] * w0.w + da * b0.w + vv * k0.w;
      S[4] = S[4] * w1.x + da * b1.x + vv * k1.x; S[5] = S[5] * w1.y + da * b1.y + vv * k1.y;
      S[6] = S[6] * w1.z + da * b1.z + vv * k1.z; S[7] = S[7] * w1.w + da * b1.w + vv * k1.w;
      if (cg8 == 0) YB[jj * 64 + row] = yv;
    }
    __syncthreads();
    {
      const int sidx = c * 32 + sj;
      if (sidx < L) {
        const int tok = d == 0 ? sidx : L - 1 - sidx;
        const float4 yv = *(const float4*)(YB + sj * 64 + 4 * q);
        store4((u16*)p.out + (size_t)(r0 + tok) * 1024 + d * 512 + hd * 64 + 4 * q, yv.x, yv.y, yv.z, yv.w);
      }
    }
    if (c + 1 < nch) stage(c + 1);
  }
  __syncthreads();
}

typedef float f2 __attribute__((ext_vector_type(2)));
DI f2 mk2(float a, float b) { f2 r; r.x = a; r.y = b; return r; }
#define LDS_FENCE() asm volatile("s_waitcnt lgkmcnt(0)" ::: "memory")

template <int CPL>
DI void scan_block2(CP p, int layer, int s, int d, int hd, int rowhalf, char* smem) {
  float* OP = (float*)smem;
  float* YB = OP + 2 * 32 * 392;
  u16* XL = (u16*)(YB + 2 * 32 * 64);
  float* MU = (float*)(XL + 2 * 32 * 72);
  float* CS = MU + 640;
  u16* WL = (u16*)(CS + 192);
  const int tid = tidx(), lane = tid & 63, wv = tid >> 6, l32 = lane & 31, hh = lane >> 5;
  const int L = seq_len(s), r0 = seq_start(s);
  const int aoff0 = hd * 64, aoff1 = 512 + hd * 64, aoff2 = 1024 + hd * 64, aoff3 = 1536 + d * 64, aoff4 = 1664 + d * 64;
  __syncthreads();
  for (int i = tid; i < 640; i += NTHR) {
    int a = i >> 7, w = (i >> 6) & 1, c = i & 63;
    int off = a == 0 ? aoff0 : a == 1 ? aoff1 : a == 2 ? aoff2 : a == 3 ? aoff3 : aoff4;
    MU[i] = p.shift_mu[(size_t)(layer * 2 + w) * 1952 + off + c];
  }
#pragma unroll
  for (int i = 0; i < 2; ++i) {
    const int idx = tid + i * NTHR, mat = idx >> 9, col = (idx >> 3) & 63, kc = idx & 7;
    *(uint4*)(WL + (mat * 64 + col) * 72 + kc * 8) = *(const uint4*)(p.wM + (mat ? OFF_A : OFF_DEC) + (size_t)(d * 512 + hd * 64 + col) * 64 + kc * 8);
  }
  if (tid < 64) {
    CS[tid] = p.key_k_k[layer * 512 + hd * 64 + tid];
    CS[64 + tid] = p.key_k_a[layer * 512 + hd * 64 + tid];
    CS[128 + tid] = p.bonus_r_k[layer * 512 + hd * 64 + tid];
  }
  __syncthreads();
  const int nch = (L + 31) >> 5;

  if (wv >= 4) {
    const int sw = wv - 4;
    const int q = lane & 15;
    float bias[2][2];
#pragma unroll
    for (int mat = 0; mat < 2; ++mat)
#pragma unroll
      for (int nt2 = 0; nt2 < 2; ++nt2)
        bias[mat][nt2] = mat ? p.iclr_a0[(size_t)(layer * 2 + d) * 512 + hd * 64 + nt2 * 32 + l32]
                             : p.decay_w0[(size_t)(layer * 2 + d) * 512 + hd * 64 + nt2 * 32 + l32];
    uint2 raw[2][5];
    auto load_raw = [&](int c) {
#pragma unroll
      for (int u = 0; u < 2; ++u) {
        const int sj = 8 * sw + 4 * u + (lane >> 4);
        const int sidc = min(c * 32 + sj, L - 1);
        const int tok = d == 0 ? sidc : L - 1 - sidc;
        const u16* base = p.regB + (size_t)(r0 + tok) * 1952 + 4 * q;
        raw[u][0] = *(const uint2*)(base + aoff0); raw[u][1] = *(const uint2*)(base + aoff1); raw[u][2] = *(const uint2*)(base + aoff2);
        raw[u][3] = *(const uint2*)(base + aoff3); raw[u][4] = *(const uint2*)(base + aoff4);
      }
    };
    auto stage = [&](int c) {
      float r4[2][4], k4[2][4], kk4[2][4], v4[2][4];
#pragma unroll
      for (int u = 0; u < 2; ++u) {
        const int sj = 8 * sw + 4 * u + (lane >> 4);
        r4[u][0] = bflo(raw[u][0].x); r4[u][1] = bfhi(raw[u][0].x); r4[u][2] = bflo(raw[u][0].y); r4[u][3] = bfhi(raw[u][0].y);
        k4[u][0] = bflo(raw[u][1].x); k4[u][1] = bfhi(raw[u][1].x); k4[u][2] = bflo(raw[u][1].y); k4[u][3] = bfhi(raw[u][1].y);
        v4[u][0] = bflo(raw[u][2].x); v4[u][1] = bfhi(raw[u][2].x); v4[u][2] = bflo(raw[u][2].y); v4[u][3] = bfhi(raw[u][2].y);
        *(uint2*)(XL + sj * 72 + 4 * q) = raw[u][3];
        *(uint2*)(XL + 32 * 72 + sj * 72 + 4 * q) = raw[u][4];
        const float4 kkw = *(const float4*)(CS + 4 * q);
        float x0 = k4[u][0] * kkw.x, x1 = k4[u][1] * kkw.y, x2 = k4[u][2] * kkw.z, x3 = k4[u][3] * kkw.w;
        float ss = sum16(x0 * x0 + x1 * x1 + x2 * x2 + x3 * x3);
        float inv = __builtin_amdgcn_rsqf(fmaxf(ss, 1e-24f));
        kk4[u][0] = x0 * inv; kk4[u][1] = x1 * inv; kk4[u][2] = x2 * inv; kk4[u][3] = x3 * inv;
      }
      LDS_FENCE();
      float* OPn = OP + (c & 1) * 32 * 392;
#pragma unroll
      for (int mat = 0; mat < 2; ++mat)
#pragma unroll
        for (int nt2 = 0; nt2 < 2; ++nt2) {
          f32x16 acc;
#pragma unroll
          for (int r = 0; r < 16; ++r) acc[r] = 0.f;
          const u16* xb = XL + mat * 32 * 72 + (8 * sw + (l32 & 7)) * 72 + hh * 8;
#pragma unroll
          for (int ks = 0; ks < 4; ++ks) acc = MFMA(*(const bf16x8*)(xb + ks * 16), *(const bf16x8*)(WL + (mat * 64 + nt2 * 32 + l32) * 72 + ks * 16 + hh * 8), acc);
#pragma unroll
          for (int r = 0; r < 4; ++r) {
            float x = acc[r] + bias[mat][nt2];
            float sg = sigmoidf_(x);
            float val = mat ? sg : __expf(-0.6065306597126334f * sg);
            OPn[(8 * sw + 4 * hh + r) * 392 + (mat ? 0 : 128) + nt2 * 32 + l32] = val;
          }
        }
      LDS_FENCE();
#pragma unroll
      for (int u = 0; u < 2; ++u) {
        const int sj = 8 * sw + 4 * u + (lane >> 4);
        const float4 w4 = *(const float4*)(OPn + sj * 392 + 128 + 4 * q);
        const float4 a4 = *(const float4*)(OPn + sj * 392 + 4 * q);
        const float4 ka = *(const float4*)(CS + 64 + 4 * q);
        const float4 brk = *(const float4*)(CS + 128 + 4 * q);
        const float wv4[4] = {w4.x, w4.y, w4.z, w4.w}, av4[4] = {a4.x, a4.y, a4.z, a4.w};
        const float kav[4] = {ka.x, ka.y, ka.z, ka.w}, bkv[4] = {brk.x, brk.y, brk.z, brk.w};
        float aa[4], wr[4], bb[4], kd[4];
        float br = 0.f, kr = 0.f, bs = 0.f;
#pragma unroll
        for (int e = 0; e < 4; ++e) {
          aa[e] = -kk4[u][e]; wr[e] = wv4[e] * r4[u][e]; bb[e] = kk4[u][e] * av4[e];
          kd[e] = k4[u][e] * (1.f + (av4[e] - 1.f) * kav[e]);
          br += bb[e] * r4[u][e]; kr += kd[e] * r4[u][e]; bs += r4[u][e] * kd[e] * bkv[e];
        }
        br = sum16(br); kr = sum16(kr); bs = sum16(bs);
        float* o = OPn + sj * 392 + 4 * q;
        *(float4*)(o) = make_float4(aa[0], aa[1], aa[2], aa[3]);
        *(float4*)(o + 64) = make_float4(wr[0], wr[1], wr[2], wr[3]);
        *(float4*)(o + 128) = w4;
        *(float4*)(o + 192) = make_float4(bb[0], bb[1], bb[2], bb[3]);
        *(float4*)(o + 256) = make_float4(kd[0], kd[1], kd[2], kd[3]);
        *(float4*)(o + 320) = make_float4(v4[u][0], v4[u][1], v4[u][2], v4[u][3]);
        if (q == 0) {
          OPn[sj * 392 + 384] = br; OPn[sj * 392 + 385] = kr;
          const int sidx = c * 32 + sj;
          if (sidx < L && rowhalf == 0) { const int tok = d == 0 ? sidx : L - 1 - sidx; p.bsc[((size_t)d * TP + r0 + tok) * 8 + hd] = bs; }
        }
      }
    };
    auto writeout = [&](int c) {
      const float* yb = YB + (c & 1) * 2048;
#pragma unroll
      for (int u = 0; u < 2; ++u) {
        const int sj = 8 * sw + 4 * u + (lane >> 4);
        const int sidx = c * 32 + sj;
        const bool mine = CPL == 16 ? true : ((q >> 3) == rowhalf);
        if (sidx < L && mine) {
          const int tok = d == 0 ? sidx : L - 1 - sidx;
          const float4 yv = *(const float4*)(yb + sj * 64 + 4 * q);
          store4((u16*)p.out + (size_t)(r0 + tok) * 1024 + d * 512 + hd * 64 + 4 * q, yv.x, yv.y, yv.z, yv.w);
        }
      }
    };
    load_raw(0);
    stage(0);
    if (nch > 1) load_raw(1);
    __syncthreads();
    for (int c = 0; c < nch; ++c) {
      if (c + 1 < nch) { stage(c + 1); if (c + 2 < nch) load_raw(c + 2); }
      if (c >= 1) writeout(c - 1);
      __syncthreads();
    }
    writeout(nch - 1);
  } else {
    constexpr int LPRW = 64 / CPL;
    constexpr int NV = CPL / 2;
    const int cg = lane % LPRW;
    const int row = (CPL == 8 ? rowhalf * 32 + wv * 8 : wv * 16) + lane / LPRW;
    f2 S[NV];
#pragma unroll
    for (int i = 0; i < NV; ++i) S[i] = mk2(0.f, 0.f);
    __builtin_amdgcn_s_setprio(3);
    __syncthreads();
    for (int c = 0; c < nch; ++c) {
      const int nst = min(32, L - c * 32);
      const float* ob = OP + (c & 1) * 32 * 392;
      float* yb = YB + (c & 1) * 2048;
      float* ydst = cg == 0 ? yb + row : (float*)(smem + 147712) + lane;
      const int ystride = cg == 0 ? 64 : 0;
      float4 ca[CPL / 4], cy[CPL / 4], cw[CPL / 4], cb[CPL / 4], ck[CPL / 4];
      float cvv; float2 csc;
      {
        const float* o = ob + cg * CPL;
#pragma unroll
        for (int i = 0; i < CPL / 4; ++i) {
          ca[i] = *(const float4*)(o + 4 * i); cy[i] = *(const float4*)(o + 64 + 4 * i); cw[i] = *(const float4*)(o + 128 + 4 * i);
          cb[i] = *(const float4*)(o + 192 + 4 * i); ck[i] = *(const float4*)(o + 256 + 4 * i);
        }
        cvv = ob[320 + row]; csc = *(const float2*)(ob + 384);
      }
#pragma unroll 4
      for (int jj = 0; jj < nst; ++jj) {
        float4 na[CPL / 4], ny[CPL / 4], nw[CPL / 4], nb[CPL / 4], nk[CPL / 4];
        float nvv; float2 nsc;
        {
          const int jn = jj + 1;
          const float* o = ob + jn * 392 + cg * CPL;
#pragma unroll
          for (int i = 0; i < CPL / 4; ++i) {
            na[i] = *(const float4*)(o + 4 * i); ny[i] = *(const float4*)(o + 64 + 4 * i); nw[i] = *(const float4*)(o + 128 + 4 * i);
            nb[i] = *(const float4*)(o + 192 + 4 * i); nk[i] = *(const float4*)(o + 256 + 4 * i);
          }
          nvv = ob[jn * 392 + 320 + row]; nsc = *(const float2*)(ob + jn * 392 + 384);
        }
        f2 A[NV], Y[NV], W[NV], B[NV], K[NV];
#pragma unroll
        for (int i = 0; i < CPL / 4; ++i) {
          A[2 * i] = mk2(ca[i].x, ca[i].y); A[2 * i + 1] = mk2(ca[i].z, ca[i].w);
          Y[2 * i] = mk2(cy[i].x, cy[i].y); Y[2 * i + 1] = mk2(cy[i].z, cy[i].w);
          W[2 * i] = mk2(cw[i].x, cw[i].y); W[2 * i + 1] = mk2(cw[i].z, cw[i].w);
          B[2 * i] = mk2(cb[i].x, cb[i].y); B[2 * i + 1] = mk2(cb[i].z, cb[i].w);
          K[2 * i] = mk2(ck[i].x, ck[i].y); K[2 * i + 1] = mk2(ck[i].z, ck[i].w);
        }
        const float vv = cvv;
        f2 pa0 = S[0] * A[0], pa1 = S[1] * A[1], py0 = S[0] * Y[0], py1 = S[1] * Y[1];
#pragma unroll
        for (int i = 2; i < NV; i += 2) {
          pa0 = S[i] * A[i] + pa0; pa1 = S[i + 1] * A[i + 1] + pa1;
          py0 = S[i] * Y[i] + py0; py1 = S[i + 1] * Y[i + 1] + py1;
        }
        pa0 = pa0 + pa1; py0 = py0 + py1;
        float da = pa0.x + pa0.y, dy = py0.x + py0.y;
        const f2 vvv = mk2(vv, vv);
        f2 SW[NV];
#pragma unroll
        for (int i = 0; i < NV; ++i) SW[i] = S[i] * W[i] + vvv * K[i];
        da += __int_as_float(__builtin_amdgcn_update_dpp(0, __float_as_int(da), 0xB1, 0xf, 0xf, false));
        dy += __int_as_float(__builtin_amdgcn_update_dpp(0, __float_as_int(dy), 0xB1, 0xf, 0xf, false));
        da += __int_as_float(__builtin_amdgcn_update_dpp(0, __float_as_int(da), 0x4E, 0xf, 0xf, false));
        dy += __int_as_float(__builtin_amdgcn_update_dpp(0, __float_as_int(dy), 0x4E, 0xf, 0xf, false));
        if (CPL == 8) {
          da += __int_as_float(__builtin_amdgcn_update_dpp(0, __float_as_int(da), 0x141, 0xf, 0xf, false));
          dy += __int_as_float(__builtin_amdgcn_update_dpp(0, __float_as_int(dy), 0x141, 0xf, 0xf, false));
        }
        const f2 dav = mk2(da, da);
#pragma unroll
        for (int i = 0; i < NV; ++i) S[i] = dav * B[i] + SW[i];
        const float yv = dy + da * csc.x + vv * csc.y;
        ydst[jj * ystride] = yv;
#pragma unroll
        for (int i = 0; i < CPL / 4; ++i) { ca[i] = na[i]; cy[i] = ny[i]; cw[i] = nw[i]; cb[i] = nb[i]; ck[i] = nk[i]; }
        cvv = nvv; csc = nsc;
      }
      __syncthreads();
    }
    __builtin_amdgcn_s_setprio(0);
  }
  __syncthreads();
}

DI void shift_item(CP p, int layer, int ch, char* smem) {
  const int tid = tidx();
  int s, c;
  if (ch < 258) { s = ch / 129; c = ch - s * 129; } else { int x = ch - 258; s = 2 + x / 33; c = x - (s - 2) * 33; }
  const int L = seq_len(s), r0 = seq_start(s) + c * 64;
  const int nrows = min(64, L - c * 64);
  const int cgp = tid & 255, rg = tid >> 8;
  const int col = cgp * 8;
  const int rlo = rg * 32, rhi = min(rlo + 32, nrows);
  const bool act = cgp < 244 && rlo < nrows;
  typedef unsigned u32x4 __attribute__((ext_vector_type(4)));
  u32x4 prev = {0u, 0u, 0u, 0u}, cur = prev, lastn = prev;
  float mu0[8], mu1[8];
  u16* base = p.regB + (size_t)r0 * 1952 + col;
  if (act) {
#pragma unroll
    for (int e = 0; e < 8; ++e) { mu0[e] = p.shift_mu[(size_t)(layer * 2) * 1952 + col + e]; mu1[e] = p.shift_mu[(size_t)(layer * 2 + 1) * 1952 + col + e]; }
    if (rlo > 0) prev = *(const u32x4*)(base + (size_t)(rlo - 1) * 1952);
    else if (c > 0) prev = *(const u32x4*)(halo_ptr(p) + ((size_t)(ch - 1) * 2 + 1) * 1952 + col);
    cur = *(const u32x4*)(base + (size_t)rlo * 1952);
    if (rhi < nrows) lastn = *(const u32x4*)(base + (size_t)rhi * 1952);
    else if (c * 64 + nrows < L) lastn = *(const u32x4*)(halo_ptr(p) + ((size_t)(ch + 1) * 2) * 1952 + col);
  }
  __syncthreads();
  if (act) {
    const int kind = col < 1536 ? 0 : col < 1664 ? 1 : col < 1792 ? 0 : 2;
    for (int rb = rlo; rb < rhi; rb += 8) {
      u32x4 rw[9];
      rw[0] = cur;
#pragma unroll
      for (int i = 1; i < 9; ++i) { const int r = rb + i; rw[i] = (r < rhi) ? *(const u32x4*)(base + (size_t)r * 1952) : lastn; }
#pragma unroll
      for (int i = 0; i < 8; ++i) {
        const u32x4 cc = rw[i], nn = rw[i + 1];
        const unsigned pc[4] = {cc.x, cc.y, cc.z, cc.w}, pm[4] = {prev.x, prev.y, prev.z, prev.w}, pn[4] = {nn.x, nn.y, nn.z, nn.w};
        unsigned o[4];
#pragma unroll
        for (int e = 0; e < 4; ++e) {
          float c0 = bflo(pc[e]), c1 = bfhi(pc[e]);
          float x0 = c0 + mu0[2 * e] * (bflo(pm[e]) - c0) + mu1[2 * e] * (bflo(pn[e]) - c0);
          float x1 = c1 + mu0[2 * e + 1] * (bfhi(pm[e]) - c1) + mu1[2 * e + 1] * (bfhi(pn[e]) - c1);
          if (kind == 1) { x0 = 1.f - 2.f * __builtin_amdgcn_rcpf(__expf(2.f * x0) + 1.f); x1 = 1.f - 2.f * __builtin_amdgcn_rcpf(__expf(2.f * x1) + 1.f); }
          else if (kind == 2) { x0 = sigmoidf_(x0); x1 = sigmoidf_(x1); }
          o[e] = pack2(x0, x1);
        }
        { u32x4 ov = {o[0], o[1], o[2], o[3]}; *(u32x4*)(base + (size_t)(rb + i) * 1952) = ov; }
        prev = cc;
      }
      cur = rw[8];
    }
  }
  __syncthreads();
}

DI void init_rows(CP p, int item) {
  const int lane = tidx() & 63, wv = tidx() >> 6;
  const int r = item * 8 + wv;
  if (r >= TP) return;
  u16* dst = p.hb + (size_t)r * 1024 + lane * 16;
  float ss = 0.f;
  if (r < T) {
    int s, pos, L; row2seq(r, s, pos, L);
    const float* src = pos < 16 ? p.meta + pos * 1024
                     : (s < 2 ? p.x_prompt + ((size_t)s * 8192 + pos - 16) * 1024 : p.x_sample + ((size_t)(s - 2) * 2048 + pos - 16) * 1024);
    src += lane * 16;
    unsigned pk[8];
#pragma unroll
    for (int i = 0; i < 4; ++i) {
      float4 v = *(const float4*)(src + 4 * i);
      pk[2 * i] = pack2(v.x, v.y); pk[2 * i + 1] = pack2(v.z, v.w);
      float a = bflo(pk[2 * i]), b = bfhi(pk[2 * i]), c = bflo(pk[2 * i + 1]), dd = bfhi(pk[2 * i + 1]);
      ss += a * a + b * b + c * c + dd * dd;
    }
    *(uint4*)dst = make_uint4(pk[0], pk[1], pk[2], pk[3]);
    *(uint4*)(dst + 8) = make_uint4(pk[4], pk[5], pk[6], pk[7]);
  } else {
    *(uint4*)dst = make_uint4(0, 0, 0, 0);
    *(uint4*)(dst + 8) = make_uint4(0, 0, 0, 0);
  }
#pragma unroll
  for (int o = 32; o > 0; o >>= 1) ss += __shfl_xor(ss, o);
  if (lane < 16) p.ssq[(size_t)lane * TP + r] = lane == 0 ? ss : 0.f;
}
DI void init_rope(CP p, int item) {
  const int idx = item * NTHR + tidx();
  if (idx >= LPR * 16) return;
  const int pos = idx >> 4, i = idx & 15;
  double rev = (double)pos * ROPE_INV[i] * 0.15915494309189535;
  rev -= rint(rev);
  const float fr = (float)rev;
  p.ropec[idx] = __builtin_amdgcn_cosf(fr);
  p.ropes[idx] = __builtin_amdgcn_sinf(fr);
}
DI void final_rows(CP p, int item) {
  const int lane = tidx() & 63, wv = tidx() >> 6;
  const int orow = item * 8 + wv;
  int r;
  if (orow < 16384) { int s = orow >> 13; r = s * LPR + 16 + (orow & 8191); }
  else { int x = orow - 16384; int s = x >> 11; r = 2 * LPR + s * LSM + 16 + (x & 2047); }
  const float rs = rstd16(p.ssq, r);
  const u16* src = p.hb + (size_t)r * 1024 + lane * 16;
  uint4 a = *(const uint4*)src, b = *(const uint4*)(src + 8);
  unsigned w[8] = {a.x, a.y, a.z, a.w, b.x, b.y, b.z, b.w};
  float* dst = p.out + (size_t)orow * 1024 + lane * 16;
  const float* gn = p.final_norm + lane * 16;
#pragma unroll
  for (int i = 0; i < 4; ++i) {
    float4 o;
    o.x = bflo(w[2 * i]) * rs * gn[4 * i]; o.y = bfhi(w[2 * i]) * rs * gn[4 * i + 1];
    o.z = bflo(w[2 * i + 1]) * rs * gn[4 * i + 2]; o.w = bfhi(w[2 * i + 1]) * rs * gn[4 * i + 3];
    *(float4*)(dst + 4 * i) = o;
  }
}

#define XB_TMO      128
#define XB_XCNT(j)  (256  + 64 * (j))
#define XB_XSUB(j)  (1280 + 64 * (j))
#define XB_XGEN(j)  (2304 + 64 * (j))
#define XB_TOP      3328
#define XB_TOPGEN   3392
#define XCD_BAR_WORDS 3456
#define XB_SPIN_CAP (1u << 18)
#define LAS __attribute__((address_space(3)))

__device__ __forceinline__ unsigned xb_ld(unsigned* p)              { return __hip_atomic_load(p, __ATOMIC_RELAXED, __HIP_MEMORY_SCOPE_AGENT); }
__device__ __forceinline__ unsigned xb_add(unsigned* p, unsigned v) { return __hip_atomic_fetch_add(p, v, __ATOMIC_RELAXED, __HIP_MEMORY_SCOPE_AGENT); }
__device__ __forceinline__ unsigned xb_xcc_id() { return (unsigned)__builtin_amdgcn_s_getreg((3 << 11) | 20) & 0xFu; }
#define XB_SPIN(cond, bar) do { unsigned _sp = 0; while (cond) { __builtin_amdgcn_s_sleep(1); \
    if ((++_sp & 255u) == 0u) { if (xb_ld(&(bar)[XB_TMO])) break; if (_sp > XB_SPIN_CAP) { atomicAdd(&(bar)[XB_TMO], 1u); break; } } } } while (0)

struct XcdBarrier {
    unsigned* bar; unsigned x;
    volatile LAS unsigned* st;
};

__device__ __forceinline__ XcdBarrier xcd_barrier_post(unsigned* bar, volatile LAS unsigned* st) {
    XcdBarrier b; b.bar = bar; b.x = xb_xcc_id(); b.st = st;
    if (threadIdx.x == 0) (void)xb_add(&bar[XB_XCNT(b.x)], 1u);
    return b;
}
__device__ __forceinline__ void xcd_barrier_complete(unsigned* bar, unsigned x, unsigned& nloc, unsigned& nx) {
    const unsigned G = gridDim.x * gridDim.y * gridDim.z;
    unsigned sum, cnt, mine, sp = 0u;
    for (;;) {
        sum = 0u; cnt = 0u; mine = 0u;
#pragma unroll
        for (unsigned j = 0; j < 16; ++j) { const unsigned c = xb_ld(&bar[XB_XCNT(j)]); sum += c; cnt += (c > 0u) ? 1u : 0u; mine = (j == x) ? c : mine; }
        if (sum == G) break;
        __builtin_amdgcn_s_sleep(1);
        if ((++sp & 255u) == 0u) { if (xb_ld(&bar[XB_TMO])) break; if (sp > XB_SPIN_CAP) { atomicAdd(&bar[XB_TMO], 1u); break; } }
    }
    nloc = mine > 0u ? mine : 1u; nx = cnt > 0u ? cnt : 1u;
}

__device__ __forceinline__ void xcd_barrier(const XcdBarrier& b) {
    asm volatile("s_waitcnt vmcnt(0)" ::: "memory");
    __syncthreads();
    if (threadIdx.x == 0) {
        unsigned* bar = b.bar;
        __builtin_amdgcn_s_waitcnt(0);
        unsigned nloc = b.st[0], nx = b.st[1];
        if (nloc == 0u) { xcd_barrier_complete(bar, b.x, nloc, nx); b.st[0] = nloc; b.st[1] = nx; }
        const unsigned old = xb_add(&bar[XB_XSUB(b.x)], 1u);
        const unsigned gen = old / nloc;
        if (old + 1u == (gen + 1u) * nloc) {
            __builtin_amdgcn_fence(__ATOMIC_RELEASE, "agent");
            asm volatile("s_waitcnt vmcnt(0)" ::: "memory");
            const unsigned og = xb_add(&bar[XB_TOP], 1u);
            const unsigned tg = og / nx;
            if (og + 1u == (tg + 1u) * nx) xb_add(&bar[XB_TOPGEN], 1u);
            else XB_SPIN(xb_ld(&bar[XB_TOPGEN]) == tg, bar);
            __builtin_amdgcn_fence(__ATOMIC_ACQUIRE, "agent");
            xb_add(&bar[XB_XGEN(b.x)], 1u);
            asm volatile("s_waitcnt vmcnt(0)" ::: "memory");
        } else {
            XB_SPIN(xb_ld(&bar[XB_XGEN(b.x)]) == gen, bar);
            __builtin_amdgcn_fence(__ATOMIC_ACQUIRE, "agent");
            asm volatile("s_waitcnt vmcnt(0)" ::: "memory");
        }
    }
    __syncthreads();
}

constexpr int NPHASE = 21;
#ifndef ONLY
#define EN(x) true
#else
#define EN(x) ((x) == ONLY)
#endif
DI void run_phase(CP p, int ph, char* smem) {
  const int bid = blockIdx.x, nb = gridDim.x;
  const int fidx = (bid & 7) ? (bid >> 3) * 7 + (bid & 7) - 1 : -1, nfill = (nb >> 3) * 7;
  if (EN(100) && ph == 0) {
    const int n0 = NCONV_FFN, n1 = n0, n2 = n1 + TP / 8, n3 = n2 + (LPR * 16 + NTHR - 1) / NTHR;
    for (int it = bid; it < n3; it += nb) {
      if (it < n0) conv_ffn(p, 0, 0, it, smem);
      else if (it < n2) init_rows(p, it - n1);
      else init_rope(p, it - n2);
    }
    if (bid == 0 && tidx() < 4) p.ctr[tidx()] = 0u;
    return;
  }
  if (ph == 10) return;
  if (EN(102) && ph == 20) { for (int it = bid; it < 4096; it += nb) final_rows(p, it); return; }
  const int layer = ph > 10 ? 1 : 0;
  const int k = ph - (layer ? 11 : 1);
  GArgs g{};
  g.layer = layer; g.scale = 1.f;
  u16* outb = (u16*)p.out;
  switch (k) {
    case 0: case 7: if (EN(0)) {
      g.a0 = p.hb; g.ld0 = 1024; g.split = 1 << 30; g.ks0 = 64; g.a1 = p.hb; g.ld1 = 1024; g.W = (layer == 1 && k == 0) ? p.kn : p.wF; g.K = 1024;
      gemm_phase<0, EPI_UP, 256>(p, g, 22, smem);
      if (k == 7 && layer == 0 && fidx >= 0) for (int it = fidx; it < NCONV_FFN; it += nfill) conv_ffn(p, 1, 0, it, smem);
    } break;
    case 1: case 8: if (EN(1)) {
      g.a0 = p.regB; g.ld0 = 1408; g.split = 22; g.ks0 = 64; g.a1 = outb; g.ld1 = 1408; g.W = ((layer == 1 && k == 1) ? p.kn : p.wF) + OFF_WD; g.K = 2816; g.scale = 0.5f;
      gemm_phase<0, EPI_RES, 256>(p, g, 4, smem);
      if (layer == 0 && fidx >= 0) for (int it = fidx; it < NCONV_MIX; it += nfill) conv_mix(p, k == 1 ? 0 : 1, it, smem);
    } break;
    case 2: if (EN(2)) {
      g.a0 = p.hb; g.ld0 = 1024; g.split = 1 << 30; g.ks0 = 64; g.a1 = p.hb; g.ld1 = 1024; g.W = p.wM + OFF_IN; g.K = 1024;
      gemm_phase<0, EPI_INPROJ, 256>(p, g, 10, smem);
    } break;
    case 3: if (EN(3)) {
      const int nq = NMT * 6, nkv = NMT * 8, nsh = 522, ntot = nq + nkv + nsh;
      for (int it = bid; it < ntot; it += nb) {
        if (it < nq) {
          g.a0 = outb; g.ld0 = 512; g.split = 1 << 30; g.ks0 = 64; g.a1 = outb; g.ld1 = 512; g.W = p.wM + OFF_UQ; g.K = 256;
          gemm_phase_item<0, EPI_Q>(p, g, it, 6, smem);
        } else if (it < nq + nkv) {
          g.a0 = outb + 256; g.ld0 = 512; g.split = 1 << 30; g.ks0 = 64; g.a1 = outb; g.ld1 = 512; g.W = p.wM + OFF_UKV; g.K = 128;
          gemm_phase_item<0, EPI_KV>(p, g, it - nq, 8, smem);
        } else shift_item(p, layer, it - nq - nkv, smem);
      }
    } break;
    case 4: if (EN(4)) {
      for (int sc = bid; sc < 192; sc += nb) {
        if (sc < 64) { int x = sc >> 1; scan_block2<8>(p, layer, x >> 4, (x >> 3) & 1, x & 7, sc & 1, smem); }
        else { int x = sc - 64; scan_block2<16>(p, layer, 2 + (x >> 4), (x >> 3) & 1, x & 7, 0, smem); }
      }
      unsigned* bc = (unsigned*)(smem + SMEM_BYTES - 16);
      while (true) {
        __syncthreads();
        if (tidx() == 0) *bc = atomicAdd(p.ctr + layer, 1u);
        __syncthreads();
        const int it = (int)*bc;
        if (it >= 1104 + NCONV_FFN) break;
        if (it >= 1104) { conv_ffn(p, layer, 1, it - 1104, smem); continue; }
        int s, hd, qb;
        if (it < 528) { s = it / 264; int rem = it - s * 264; hd = rem / 33; qb = rem - hd * 33; }
        else { int x = it - 528; s = 2 + x / 72; int rem = x % 72; hd = rem / 9; qb = rem - hd * 9; }
#ifdef PROBE_ATT2
        attn_item(p, s, hd, qb, smem, p.ctr[8] == 12345u);
        __syncthreads();
#endif
        attn_item(p, s, hd, qb, smem);
      }
    } break;
    case 5: if (EN(5)) {
      g.W = p.wM + OFF_G; g.K = 192; g.a0 = p.regB + 1792; g.a1 = g.a0; g.ld0 = g.ld1 = 1952; g.split = 1 << 30; g.ks0 = 64;
      gemm_phase<0, EPI_POST, 256>(p, g, 2, smem);
    } break;
    case 6: if (EN(6)) {
      g.a0 = outb + (size_t)TP * 1024; g.ld0 = 768; g.split = 8; g.ks0 = 96; g.a1 = outb; g.ld1 = 1024; g.W = p.wM + OFF_OUT; g.K = 1024;
      gemm_phase<0, EPI_RES, 256>(p, g, 4, smem);
    } break;
  }
}

template <bool COOP>
__global__ void __launch_bounds__(NTHR) mega(Params pp, int lo, int hi) {
  extern __shared__ __attribute__((aligned(16))) char smem[];
  const __attribute__((address_space(4))) Params* kp = (const __attribute__((address_space(4))) Params*)__builtin_amdgcn_kernarg_segment_ptr();
  volatile LAS unsigned* st = (volatile LAS unsigned*)(smem + SMEM_BYTES - 32);
  if (threadIdx.x == 0) { st[0] = 0u; st[1] = 0u; }
  __syncthreads();
  XcdBarrier xb = xcd_barrier_post(kp->bar, st);
  for (int ph = lo; ph < hi; ++ph) {
    if (ph == 10) continue;
    asm volatile("" : "+s"(kp));
    run_phase(*kp, ph, smem);
    if (COOP && ph + 1 < hi) {
      if (ph == 0) cg::this_grid().sync();
      else xcd_barrier(xb);
    }
  }
}

extern "C" void kernel_launch(void* const* d_in, const int* in_sizes, int n_in, void* d_out, int out_size, void* d_ws, size_t ws_size,
                              hipStream_t stream) {
  Params p{};
  const float** pf = (const float**)&p;
  for (int i = 0; i < 30; ++i) pf[i] = (const float*)d_in[i];
  p.out = (float*)d_out;
  char* w = (char*)d_ws;
  size_t off = 0;
  auto take = [&](size_t bytes) { char* r = w + off; off += (bytes + 255) & ~(size_t)255; return r; };
  p.hb = (u16*)take((size_t)TP * 1024 * 2);
  p.regB = (u16*)take((size_t)TP * 1952 * 2);
  p.kn = (u16*)take((size_t)TP * 512 * 2);
  p.vt = (u16*)take((size_t)TP * 512 * 2);
  p.wF = (u16*)take((size_t)WF_ELEMS * 2);
  p.wM = (u16*)take((size_t)WM_ELEMS * 2);
  p.ssq = (float*)take((size_t)16 * TP * 4);
  p.ssqq = (float*)take((size_t)6 * TP * 4);
  p.bsc = (float*)take((size_t)2 * TP * 8 * 4);
  p.ropec = (float*)take((size_t)LPR * 16 * 4);
  p.ropes = (float*)take((size_t)LPR * 16 * 4);
  p.ctr = (unsigned*)take(256);
  p.bar = (unsigned*)take((size_t)XCD_BAR_WORDS * 4);
  if (off > ws_size) fprintf(stderr, "workspace too small: need %zu have %zu\n", off, ws_size);
#ifndef MULTI_LAUNCH
  static int grid_blocks = 0;
  if (!grid_blocks) {
    hipFuncSetAttribute((const void*)mega<true>, hipFuncAttributeMaxDynamicSharedMemorySize, SMEM_BYTES);
    int dev = 0, cus = 0, per_cu = 0;
    hipGetDevice(&dev);
    hipDeviceGetAttribute(&cus, hipDeviceAttributeMultiprocessorCount, dev);
    hipOccupancyMaxActiveBlocksPerMultiprocessor(&per_cu, mega<true>, NTHR, SMEM_BYTES);
    if (per_cu > 1) per_cu = 1;
    grid_blocks = cus * per_cu;
  }
  hipMemsetAsync(p.bar, 0, (size_t)XCD_BAR_WORDS * 4, stream);
  int lo = 0, hi = NPHASE;
  void* args[] = {&p, &lo, &hi};
  hipError_t e = hipLaunchCooperativeKernel((void*)mega<true>, dim3(grid_blocks), dim3(NTHR), args, SMEM_BYTES, stream);
  if (e != hipSuccess) fprintf(stderr, "cooperative launch failed: %s (grid %d)\n", hipGetErrorString(e), grid_blocks);
#else
  hipFuncSetAttribute((const void*)mega<false>, hipFuncAttributeMaxDynamicSharedMemorySize, SMEM_BYTES);
  for (int ph = 0; ph < NPHASE; ++ph) mega<false><<<256, NTHR, SMEM_BYTES, stream>>>(p, ph, ph + 1);
#endif
}
```

```cpp
#include <hip/hip_runtime.h>
#include <hip/hip_cooperative_groups.h>
#include <cstdio>
namespace cg = cooperative_groups;

typedef unsigned short u16;
typedef __attribute__((ext_vector_type(8))) short bf16x8;
typedef __attribute__((ext_vector_type(16))) float f32x16;
#define DI __device__ __forceinline__
#define MFMA(a, b, c) __builtin_amdgcn_mfma_f32_32x32x16_bf16((a), (b), (c), 0, 0, 0)

constexpr int T = 32928, TP = 33024, LPR = 8208, LSM = 2064, NMT = 129;
constexpr int NTHR = 512;
constexpr float RMS_EPS = 1e-6f, LNX_EPS = 64e-5f;
constexpr float QSCALE = 0.10206207261596575f * 1.4426950408889634f;
constexpr int OFF_IN = 0, OFF_UQ = 2621440, OFF_UKV = 2818048, OFF_DEC = 2949120, OFF_A = 3014656, OFF_G = 3080192, OFF_OUT = 3178496, WM_ELEMS = 4227072;
constexpr int OFF_WD = 5767168, WF_ELEMS = 8650752;
constexpr int SMEM_BYTES = 149504;

__constant__ double ROPE_INV[16] = {1.0, 0.5623413251903491, 0.31622776601683794, 0.1778279410038923, 0.1, 0.05623413251903491,
  0.031622776601683794, 0.01778279410038923, 0.01, 0.005623413251903491, 0.0031622776601683794, 0.001778279410038923,
  0.001, 0.0005623413251903491, 0.00031622776601683794, 0.0001778279410038923};

struct Params {
  const float *x_prompt, *x_sample, *meta, *ffn1_norm, *ffn1_wg, *ffn1_wu, *ffn1_wd, *mix_norm, *w_in, *shift_mu, *q_norm, *w_uq,
      *kv_norm, *w_ukv, *decay_w0, *decay_w2, *iclr_a0, *iclr_a2, *gate_g2, *key_k_k, *key_k_a, *bonus_r_k, *lnx_w, *lnx_b, *w_out,
      *ffn2_norm, *ffn2_wg, *ffn2_wu, *ffn2_wd, *final_norm;
  float* out;
  u16 *hb, *regB, *kn, *vt, *wF, *wM;
  float *ssq, *ssqq, *bsc, *ropec, *ropes;
  unsigned* ctr;
  unsigned* bar;
};

typedef const __attribute__((address_space(4))) Params& CP;
DI int tidx() { int t = __builtin_amdgcn_workitem_id_x(); asm volatile("" : "+v"(t)); return t; }
DI u16 f2bf(float x) { unsigned u = __float_as_uint(x); u += 0x7fffu + ((u >> 16) & 1u); return (u16)(u >> 16); }
DI float bf2f(u16 b) { return __uint_as_float(((unsigned)b) << 16); }
typedef __bf16 bf16x2_t __attribute__((ext_vector_type(2)));
typedef float fl2_t __attribute__((ext_vector_type(2)));
DI unsigned pack2(float a, float b) { fl2_t f; f.x = a; f.y = b; bf16x2_t r = __builtin_convertvector(f, bf16x2_t); return __builtin_bit_cast(unsigned, r); }
DI float bflo(unsigned u) { return __uint_as_float(u << 16); }
DI float bfhi(unsigned u) { return __uint_as_float(u & 0xffff0000u); }
DI float sigmoidf_(float x) { return __builtin_amdgcn_rcpf(1.f + __expf(-x)); }
DI int crow(int reg, int h) { return (reg & 3) + 8 * (reg >> 2) + 4 * h; }
DI void row2seq(int r, int& s, int& pos, int& L) {
  if (r < 2 * LPR) { s = r >= LPR ? 1 : 0; pos = r - s * LPR; L = LPR; }
  else { int q = (r - 2 * LPR) / LSM; s = 2 + q; pos = r - 2 * LPR - q * LSM; L = LSM; }
}
DI int seq_start(int s) { return s < 2 ? s * LPR : 2 * LPR + (s - 2) * LSM; }
DI int seq_len(int s) { return s < 2 ? LPR : LSM; }
DI float dpp_sum8(float x) {
  x += __int_as_float(__builtin_amdgcn_update_dpp(0, __float_as_int(x), 0xB1, 0xf, 0xf, false));
  x += __int_as_float(__builtin_amdgcn_update_dpp(0, __float_as_int(x), 0x4E, 0xf, 0xf, false));
  x += __int_as_float(__builtin_amdgcn_update_dpp(0, __float_as_int(x), 0x141, 0xf, 0xf, false));
  return x;
}
DI float sum16(float x) {
  x += __int_as_float(__builtin_amdgcn_update_dpp(0, __float_as_int(x), 0x128, 0xf, 0xf, false));
  x += __int_as_float(__builtin_amdgcn_update_dpp(0, __float_as_int(x), 0x124, 0xf, 0xf, false));
  x += __int_as_float(__builtin_amdgcn_update_dpp(0, __float_as_int(x), 0x122, 0xf, 0xf, false));
  x += __int_as_float(__builtin_amdgcn_update_dpp(0, __float_as_int(x), 0x121, 0xf, 0xf, false));
  return x;
}
DI float rstd16(const float* ssq, int m) {
  float s = 0.f;
#pragma unroll
  for (int c = 0; c < 16; ++c) s += ssq[(size_t)c * TP + m];
  return rsqrtf(s * (1.f / 1024.f) + RMS_EPS);
}

struct CJob { const float* src; const float* gain; u16* dst; int K, N, ld, map, nkt; };
DI int rowmap(int map, int n) {
  if (map == 1) return (n >> 5) * 64 + (n & 31);
  if (map == 2) return (n >> 5) * 64 + 32 + (n & 31);
  if (map == 3) return n < 416 ? n : n + 96;
  return n;
}
DI void conv_tile(const CJob& jb, int t, char* smem) {
  const int tid = tidx();
  const int kt = t % jb.nkt, ntile = t / jb.nkt;
  const int ny = tid >> 3, kx = tid & 7;
  const int n = ntile * 64 + ny, kb = kt * 64 + kx * 8;
  float v[8];
#pragma unroll
  for (int j = 0; j < 8; ++j) {
    const int k = kb + j, kc = min(k, jb.K - 1);
    float x = jb.src[(size_t)kc * jb.N + n];
    if (jb.gain) x *= jb.gain[kc];
    v[j] = k < jb.K ? x : 0.f;
  }
  uint4 o;
  o.x = pack2(v[0], v[1]); o.y = pack2(v[2], v[3]); o.z = pack2(v[4], v[5]); o.w = pack2(v[6], v[7]);
  *(uint4*)(jb.dst + (size_t)rowmap(jb.map, n) * jb.ld + kb) = o;
}
constexpr int NCONV_FFN = 2112, NCONV_MIX = 1032;
DI void conv_ffn(CP p, int l, int f, int t, char* smem) {
  CJob jb;
  u16* slot = (l == 1 && f == 0) ? p.kn : p.wF;
  const float* wg = f ? p.ffn2_wg : p.ffn1_wg; const float* wu = f ? p.ffn2_wu : p.ffn1_wu; const float* wd = f ? p.ffn2_wd : p.ffn1_wd;
  const float* nr = f ? p.ffn2_norm : p.ffn1_norm;
  if (t < 704) { jb = CJob{wg + (size_t)l * 1024 * 2816, nr + l * 1024, slot, 1024, 2816, 1024, 1, 16}; }
  else if (t < 1408) { t -= 704; jb = CJob{wu + (size_t)l * 1024 * 2816, nr + l * 1024, slot, 1024, 2816, 1024, 2, 16}; }
  else { t -= 1408; jb = CJob{wd + (size_t)l * 2816 * 1024, nullptr, slot + OFF_WD, 2816, 1024, 2816, 0, 44}; }
  conv_tile(jb, t, smem);
}
DI void conv_mix(CP p, int l, int t, char* smem) {
  CJob jb;
  if (t < 592) jb = CJob{p.w_in + (size_t)l * 1024 * 2368, p.mix_norm + l * 1024, p.wM + OFF_IN, 1024, 2368, 1024, 3, 16};
  else if (t < 640) { t -= 592; jb = CJob{p.w_uq + (size_t)l * 256 * 768, p.q_norm + l * 256, p.wM + OFF_UQ, 256, 768, 256, 0, 4}; }
  else if (t < 672) { t -= 640; jb = CJob{p.w_ukv + (size_t)l * 128 * 1024, p.kv_norm + l * 128, p.wM + OFF_UKV, 128, 1024, 128, 0, 2}; }
  else if (t < 688) { t -= 672; int d = t >> 3; t &= 7; jb = CJob{p.decay_w2 + (size_t)(l * 2 + d) * 64 * 512, nullptr, p.wM + OFF_DEC + d * 32768, 64, 512, 64, 0, 1}; }
  else if (t < 704) { t -= 688; int d = t >> 3; t &= 7; jb = CJob{p.iclr_a2 + (size_t)(l * 2 + d) * 64 * 512, nullptr, p.wM + OFF_A + d * 32768, 64, 512, 64, 0, 1}; }
  else if (t < 728) { t -= 704; jb = CJob{p.gate_g2 + (size_t)l * 160 * 512, nullptr, p.wM + OFF_G, 160, 512, 192, 0, 3}; }
  else if (t < 984) { t -= 728; jb = CJob{p.w_out + (size_t)l * 1024 * 1024, nullptr, p.wM + OFF_OUT, 1024, 1024, 1024, 0, 16}; }
  else {
    t -= 984;
    size_t base = (t < 24) ? (size_t)416 * 1024 + (size_t)t * 4096 : (size_t)2464 * 1024 + (size_t)(t - 24) * 4096;
    *(uint4*)(p.wM + OFF_IN + base + tidx() * 8) = make_uint4(0, 0, 0, 0);
    return;
  }
  conv_tile(jb, t, smem);
}

struct GArgs { const u16 *a0, *a1; int ld0, ld1, split, ks0; const u16* W; int K; int layer; float scale; };
enum { EPI_UP = 0, EPI_RES = 1, EPI_INPROJ = 2, EPI_Q = 3, EPI_KV = 4, EPI_POST = 5 };

DI uint4 load_gate(CP p, int layer, int m, int k) {
  uint4 z = make_uint4(0, 0, 0, 0);
  if (m >= T || k >= 160) return z;
  int s, pos, L; row2seq(m, s, pos, L);
  const u16* pb = p.regB + (size_t)m * 1952 + 1792 + k;
  uint4 c = *(const uint4*)pb;
  uint4 pm = pos > 0 ? *(const uint4*)(pb - 1952) : z;
  uint4 pp = pos + 1 < L ? *(const uint4*)(pb + 1952) : z;
  const float* mu0 = p.shift_mu + (size_t)(layer * 2 + 0) * 1952 + 1792 + k;
  const float* mu1 = p.shift_mu + (size_t)(layer * 2 + 1) * 1952 + 1792 + k;
  unsigned cc[4] = {c.x, c.y, c.z, c.w}, mm[4] = {pm.x, pm.y, pm.z, pm.w}, nn[4] = {pp.x, pp.y, pp.z, pp.w};
  unsigned o[4];
#pragma unroll
  for (int e = 0; e < 4; ++e) {
    float c0 = bflo(cc[e]), c1 = bfhi(cc[e]);
    float x0 = c0 + mu0[2 * e] * (bflo(mm[e]) - c0) + mu1[2 * e] * (bflo(nn[e]) - c0);
    float x1 = c1 + mu0[2 * e + 1] * (bfhi(mm[e]) - c1) + mu1[2 * e + 1] * (bfhi(nn[e]) - c1);
    o[e] = pack2(sigmoidf_(x0), sigmoidf_(x1));
  }
  return make_uint4(o[0], o[1], o[2], o[3]);
}

template <int MODE>
DI uint4 load_a(CP p, const GArgs& g, int row, int kt, int kc) {
  if (MODE == 1) return load_gate(p, g.layer, row, kt * 64 + kc * 8);
  const u16* ap = (kt < g.split) ? g.a0 + (size_t)row * g.ld0 + kt * g.ks0 : g.a1 + (size_t)row * g.ld1 + (kt - g.split) * 64;
  return *(const uint4*)(ap + kc * 8);
}

DI u16* halo_ptr(CP p) { return (u16*)p.out + (size_t)TP * 1024 + (size_t)TP * 768 + (size_t)TP * 32; }
DI uint4 ldg16(const u16* p) { uint4 v = *(const uint4*)p; return v; }
DI void sts16(u16* p, uint4 v) { *(uint4*)p = v; }
DI void store4(u16* dst, float a, float b, float c, float d) { *(uint2*)dst = make_uint2(pack2(a, b), pack2(c, d)); }

template <int MODE, int EPI, int BN>
DI void gemm_tile(CP p, const GArgs& g, int mt, int nt, char* smem) {
  constexpr int WN = BN / 64, WM = 8 / WN, MI = 256 / WM / 32, NWC = BN / 64;
  u16* As = (u16*)smem;
  u16* Ws = As + 2 * 256 * 72;
  const int tid = tidx(), lane = tid & 63, wv = tid >> 6, wm = wv / WN, wn = wv % WN, l32 = lane & 31, hh = lane >> 5;
  const int m0 = mt * 256, n0 = nt * BN;
  const int nk = g.K >> 6;
  f32x16 acc[MI][2];
#pragma unroll
  for (int i = 0; i < MI; ++i)
#pragma unroll
    for (int j = 0; j < 2; ++j)
#pragma unroll
      for (int r = 0; r < 16; ++r) acc[i][j][r] = 0.f;
  uint4 ra0[4], ra1[4], rw0[4], rw1[4];
#define GLA(KT, DA, I) { const int c_ = tid + (I) * 512; DA[I] = load_a<MODE>(p, g, m0 + (c_ >> 3), (KT), c_ & 7); }
#define GLW(KT, DW, I) if ((I) < NWC) { const int c_ = tid + (I) * 512; DW[I] = ldg16(g.W + (size_t)(n0 + (c_ >> 3)) * g.K + (KT) * 64 + (c_ & 7) * 8); }
#define GLOAD(KT, DA, DW) do { GLA(KT, DA, 0) GLA(KT, DA, 1) GLA(KT, DA, 2) GLA(KT, DA, 3) GLW(KT, DW, 0) GLW(KT, DW, 1) GLW(KT, DW, 2) GLW(KT, DW, 3) } while (0)
#define LSA(BUF, DA, I) { const int c_ = tid + (I) * 512; sts16(As + ((BUF) * 256 + (c_ >> 3)) * 72 + (c_ & 7) * 8, DA[I]); }
#define LSW(BUF, DW, I) if ((I) < NWC) { const int c_ = tid + (I) * 512; sts16(Ws + ((BUF) * BN + (c_ >> 3)) * 72 + (c_ & 7) * 8, DW[I]); }
#define LSTORE(BUF, DA, DW) do { LSA(BUF, DA, 0) LSA(BUF, DA, 1) LSA(BUF, DA, 2) LSA(BUF, DA, 3) LSW(BUF, DW, 0) LSW(BUF, DW, 1) LSW(BUF, DW, 2) LSW(BUF, DW, 3) } while (0)
  auto compute = [&](int buf) {
    const u16* Ab = As + buf * 256 * 72 + (wm * (MI * 32) + l32) * 72 + hh * 8;
    const u16* Wb = Ws + buf * BN * 72 + (wn * 64 + l32) * 72 + hh * 8;
#pragma unroll
    for (int ks = 0; ks < 4; ++ks) {
      bf16x8 wf0 = *(const bf16x8*)(Wb + ks * 16);
      bf16x8 wf1 = *(const bf16x8*)(Wb + 32 * 72 + ks * 16);
#pragma unroll
      for (int i = 0; i < MI; ++i) {
        bf16x8 xf = *(const bf16x8*)(Ab + i * 32 * 72 + ks * 16);
        acc[i][0] = MFMA(wf0, xf, acc[i][0]);
        acc[i][1] = MFMA(wf1, xf, acc[i][1]);
      }
    }
  };
  if (true) {
    char* L0 = smem;
    constexpr int BUFB = (256 + BN) * 128;
    constexpr int NBUF = BN <= 128 ? 3 : 2;
    constexpr int NGL = 4 + BN / 64;
    const int gl_row = lane >> 3;
    auto issue = [&](int kt, int buf) {
      char* lb = L0 + buf * BUFB;
#pragma unroll
      for (int i = 0; i < 4; ++i) {
        const int seg = wv * 4 + i, row = seg * 8 + gl_row;
        const int c = (lane & 7) ^ ((row >> 1) & 7);
        const u16* ap = (kt < g.split) ? g.a0 + (size_t)(m0 + row) * g.ld0 + kt * g.ks0 : g.a1 + (size_t)(m0 + row) * g.ld1 + (kt - g.split) * 64;
        __builtin_amdgcn_global_load_lds((const unsigned*)(ap + c * 8), (__attribute__((address_space(3))) unsigned*)(lb + seg * 1024 + lane * 16), 16, 0, 0);
      }
#pragma unroll
      for (int i = 0; i < BN / 64; ++i) {
        const int seg = wv * (BN / 64) + i, row = seg * 8 + gl_row;
        const int c = (lane & 7) ^ ((row >> 1) & 7);
        __builtin_amdgcn_global_load_lds((const unsigned*)(g.W + (size_t)(n0 + row) * g.K + kt * 64 + c * 8),
                                         (__attribute__((address_space(3))) unsigned*)(lb + 256 * 128 + seg * 1024 + lane * 16), 16, 0, 0);
      }
    };
    auto compute2 = [&](int buf) {
      const char* lb = L0 + buf * BUFB;
#pragma unroll
      for (int ks = 0; ks < 4; ++ks) {
        const int c = ks * 2 + hh;
        bf16x8 wf[2], xf[MI];
#pragma unroll
        for (int j = 0; j < 2; ++j) { const int r = wn * 64 + j * 32 + l32; wf[j] = *(const bf16x8*)(lb + 256 * 128 + r * 128 + ((c ^ ((r >> 1) & 7)) << 4)); }
#pragma unroll
        for (int i = 0; i < MI; ++i) { const int r = wm * (MI * 32) + i * 32 + l32; xf[i] = *(const bf16x8*)(lb + r * 128 + ((c ^ ((r >> 1) & 7)) << 4)); }
#pragma unroll
        for (int i = 0; i < MI; ++i) {
          acc[i][0] = MFMA(wf[0], xf[i], acc[i][0]);
          acc[i][1] = MFMA(wf[1], xf[i], acc[i][1]);
        }
      }
    };
    if (NBUF == 3) {
      issue(0, 0);
      if (nk > 1) { issue(1, 1); if (BN == 128) asm volatile("s_waitcnt vmcnt(6)" ::: "memory"); else asm volatile("s_waitcnt vmcnt(5)" ::: "memory"); }
      else asm volatile("s_waitcnt vmcnt(0)" ::: "memory");
      asm volatile("s_waitcnt lgkmcnt(0)" ::: "memory");
      __builtin_amdgcn_s_barrier();
      int buf = 0;
      for (int kt = 0; kt < nk; ++kt) {
        const int b2 = buf == 0 ? 2 : buf - 1;
        if (kt + 2 < nk) issue(kt + 2, b2);
        compute2(buf);
        if (kt + 2 < nk) { if (BN == 128) asm volatile("s_waitcnt vmcnt(6)" ::: "memory"); else asm volatile("s_waitcnt vmcnt(5)" ::: "memory"); }
        else asm volatile("s_waitcnt vmcnt(0)" ::: "memory");
        asm volatile("s_waitcnt lgkmcnt(0)" ::: "memory");
        __builtin_amdgcn_s_barrier();
        buf = buf == 2 ? 0 : buf + 1;
      }
    } else {
      issue(0, 0);
      asm volatile("s_waitcnt vmcnt(0)" ::: "memory");
      __syncthreads();
      for (int kt = 0; kt < nk; ++kt) {
        const int buf = kt & 1;
        if (kt + 1 < nk) issue(kt + 1, buf ^ 1);
        compute2(buf);
        asm volatile("s_waitcnt vmcnt(0)" ::: "memory");
        __syncthreads();
      }
    }
    __syncthreads();
  } else {
    GLOAD(0, ra0, rw0);
    LSTORE(0, ra0, rw0);
    __syncthreads();
    for (int kt = 0; kt < nk; ++kt) {
      const int buf = kt & 1;
      if (kt + 1 < nk) GLOAD(kt + 1, ra0, rw0);
      compute(buf);
      if (kt + 1 < nk) LSTORE(buf ^ 1, ra0, rw0);
      __syncthreads();
    }
  }
#undef GLOAD
#undef LSTORE
  const int nw = n0 + wn * 64;
#pragma unroll
  for (int i = 0; i < MI; ++i) {
    const int m = m0 + wm * (MI * 32) + i * 32 + l32;
    if (EPI == EPI_UP) {
      const float rs = rstd16(p.ssq, m);
      const int hb0 = nw >> 1;
#pragma unroll
      for (int gq = 0; gq < 4; ++gq) {
        float v[4];
#pragma unroll
        for (int r = 0; r < 4; ++r) {
          float gt = acc[i][0][4 * gq + r] * rs, up = acc[i][1][4 * gq + r] * rs;
          v[r] = gt * sigmoidf_(gt) * up;
        }
        int hid = hb0 + 8 * gq + 4 * hh;
        u16* dst = hid < 1408 ? p.regB + (size_t)m * 1408 + hid : (u16*)p.out + (size_t)m * 1408 + (hid - 1408);
        store4(dst, v[0], v[1], v[2], v[3]);
      }
    } else if (EPI == EPI_RES) {
      float ss = 0.f;
#pragma unroll
      for (int j = 0; j < 2; ++j)
#pragma unroll
        for (int gq = 0; gq < 4; ++gq) {
          u16* hp = p.hb + (size_t)m * 1024 + nw + j * 32 + 8 * gq + 4 * hh;
          uint2 old = *(const uint2*)hp;
          float h0 = bflo(old.x) + g.scale * acc[i][j][4 * gq + 0];
          float h1 = bfhi(old.x) + g.scale * acc[i][j][4 * gq + 1];
          float h2 = bflo(old.y) + g.scale * acc[i][j][4 * gq + 2];
          float h3 = bfhi(old.y) + g.scale * acc[i][j][4 * gq + 3];
          unsigned p0 = pack2(h0, h1), p1 = pack2(h2, h3);
          *(uint2*)hp = make_uint2(p0, p1);
          float r0 = bflo(p0), r1 = bfhi(p0), r2 = bflo(p1), r3 = bfhi(p1);
          ss += r0 * r0 + r1 * r1 + r2 * r2 + r3 * r3;
        }
      ss += __shfl_xor(ss, 32);
      if (hh == 0) p.ssq[(size_t)(nw >> 6) * TP + m] = ss;
    } else if (EPI == EPI_INPROJ) {
      const float rs = rstd16(p.ssq, m);
      int s, pos, L; row2seq(m < T ? m : 0, s, pos, L);
      float ss = 0.f;
#pragma unroll
      for (int j = 0; j < 2; ++j) {
        const int nb = nw + j * 32;
        if (nb == 384) {
          u16* kr = (u16*)p.out + (size_t)TP * 1024 + (size_t)TP * 768 + (size_t)m * 32;
#pragma unroll
          for (int gq = 0; gq < 2; ++gq) {
            float o1[4], o2[4];
#pragma unroll
            for (int r = 0; r < 4; ++r) {
              int ii = 8 * gq + 4 * hh + r;
              float c = p.ropec[pos * 16 + ii], sn = p.ropes[pos * 16 + ii];
              float x1 = acc[i][j][4 * gq + r] * rs, x2 = acc[i][j][4 * (gq + 2) + r] * rs;
              o1[r] = x1 * c - x2 * sn; o2[r] = x2 * c + x1 * sn;
            }
            store4(kr + 8 * gq + 4 * hh, o1[0], o1[1], o1[2], o1[3]);
            store4(kr + 16 + 8 * gq + 4 * hh, o2[0], o2[1], o2[2], o2[3]);
          }
        } else {
#pragma unroll
          for (int gq = 0; gq < 4; ++gq) {
            int n = nb + 8 * gq + 4 * hh;
            unsigned p0 = pack2(acc[i][j][4 * gq] * rs, acc[i][j][4 * gq + 1] * rs);
            unsigned p1 = pack2(acc[i][j][4 * gq + 2] * rs, acc[i][j][4 * gq + 3] * rs);
            if (n < 512) {
              *(uint2*)((u16*)p.out + (size_t)m * 512 + n) = make_uint2(p0, p1);
              float r0 = bflo(p0), r1 = bfhi(p0), r2 = bflo(p1), r3 = bfhi(p1);
              ss += r0 * r0 + r1 * r1 + r2 * r2 + r3 * r3;
            } else if (n - 512 < 1952) {
              *(uint2*)(p.regB + (size_t)m * 1952 + (n - 512)) = make_uint2(p0, p1);
              if (m < T && ((pos & 63) == 0 || (pos & 63) == 63)) {
                const int ch = (s < 2 ? s * 129 : 258 + (s - 2) * 33) + (pos >> 6);
                *(uint2*)(halo_ptr(p) + ((size_t)ch * 2 + ((pos & 63) ? 1 : 0)) * 1952 + (n - 512)) = make_uint2(p0, p1);
              }
            }
          }
        }
      }
      if (nw < 384) {
        ss += __shfl_xor(ss, 32);
        if (hh == 0) p.ssqq[(size_t)(nw >> 6) * TP + m] = ss;
      }
    } else if (EPI == EPI_Q) {
      float sq = p.ssqq[m] + p.ssqq[(size_t)TP + m] + p.ssqq[(size_t)2 * TP + m] + p.ssqq[(size_t)3 * TP + m];
      const float rs = rsqrtf(sq * (1.f / 256.f) + RMS_EPS) * QSCALE;
      int s, pos, L; row2seq(m < T ? m : 0, s, pos, L);
      u16* qrow = (u16*)p.out + (size_t)TP * 1024 + (size_t)m * 768;
#pragma unroll
      for (int j = 0; j < 2; ++j) {
        const int nb = nw + j * 32;
        if (((nb >> 5) % 3) == 2) {
#pragma unroll
          for (int gq = 0; gq < 2; ++gq) {
            float o1[4], o2[4];
#pragma unroll
            for (int r = 0; r < 4; ++r) {
              int ii = 8 * gq + 4 * hh + r;
              float c = p.ropec[pos * 16 + ii], sn = p.ropes[pos * 16 + ii];
              float x1 = acc[i][j][4 * gq + r] * rs, x2 = acc[i][j][4 * (gq + 2) + r] * rs;
              o1[r] = x1 * c - x2 * sn; o2[r] = x2 * c + x1 * sn;
            }
            store4(qrow + nb + 8 * gq + 4 * hh, o1[0], o1[1], o1[2], o1[3]);
            store4(qrow + nb + 16 + 8 * gq + 4 * hh, o2[0], o2[1], o2[2], o2[3]);
          }
        } else {
#pragma unroll
          for (int gq = 0; gq < 4; ++gq)
            store4(qrow + nb + 8 * gq + 4 * hh, acc[i][j][4 * gq] * rs, acc[i][j][4 * gq + 1] * rs, acc[i][j][4 * gq + 2] * rs, acc[i][j][4 * gq + 3] * rs);
        }
      }
    } else if (EPI == EPI_KV) {
      if (m < T) {
        float sq = p.ssqq[(size_t)4 * TP + m] + p.ssqq[(size_t)5 * TP + m];
        const float rs = rsqrtf(sq * (1.f / 128.f) + RMS_EPS);
        int s, pos, L; row2seq(m, s, pos, L);
        const int head = nw >> 7;
        const int ppos = (pos & ~15) | (pos & 3) | (((pos >> 3) & 1) << 2) | (((pos >> 2) & 1) << 3);
#pragma unroll
        for (int j = 0; j < 2; ++j) {
          const int jj = (nw & 127) + j * 32;
#pragma unroll
          for (int gq = 0; gq < 4; ++gq) {
            int c = jj + 8 * gq + 4 * hh;
            if (jj < 64) {
              store4(p.kn + (size_t)m * 512 + head * 64 + c, acc[i][j][4 * gq] * rs, acc[i][j][4 * gq + 1] * rs, acc[i][j][4 * gq + 2] * rs, acc[i][j][4 * gq + 3] * rs);
            } else {
#pragma unroll
              for (int r = 0; r < 4; ++r) {
                int dv = c - 64 + r;
                p.vt[(size_t)seq_start(s) * 512 + (size_t)(head * 64 + dv) * L + ppos] = f2bf(acc[i][j][4 * gq + r] * rs);
              }
            }
          }
        }
      }
    } else if (EPI == EPI_POST) {
      if (m < T) {
        int s, pos, L; row2seq(m, s, pos, L);
        const int hd = nw >> 6;
        u16* yb = (u16*)p.out + (size_t)m * 1024;
        float y[2][16];
        float sum = 0.f;
#pragma unroll
        for (int j = 0; j < 2; ++j)
#pragma unroll
          for (int gq = 0; gq < 4; ++gq) {
            int n = nw + j * 32 + 8 * gq + 4 * hh;
            uint2 a = *(const uint2*)(yb + n), b = *(const uint2*)(yb + 512 + n);
            y[j][4 * gq + 0] = bflo(a.x) + bflo(b.x); y[j][4 * gq + 1] = bfhi(a.x) + bfhi(b.x);
            y[j][4 * gq + 2] = bflo(a.y) + bflo(b.y); y[j][4 * gq + 3] = bfhi(a.y) + bfhi(b.y);
            sum += y[j][4 * gq] + y[j][4 * gq + 1] + y[j][4 * gq + 2] + y[j][4 * gq + 3];
          }
        sum += __shfl_xor(sum, 32);
        const float mu = sum * (1.f / 64.f);
        float vs = 0.f;
#pragma unroll
        for (int j = 0; j < 2; ++j)
#pragma unroll
          for (int r = 0; r < 16; ++r) { float dlt = y[j][r] - mu; vs += dlt * dlt; }
        vs += __shfl_xor(vs, 32);
        const float rstd = rsqrtf(vs * (1.f / 64.f) + LNX_EPS);
        const float bsum = p.bsc[(size_t)m * 8 + hd] + p.bsc[((size_t)TP + m) * 8 + hd];
        const u16* vb = p.regB + (size_t)m * 1952 + 1024;
#pragma unroll
        for (int j = 0; j < 2; ++j)
#pragma unroll
          for (int gq = 0; gq < 4; ++gq) {
            int n = nw + j * 32 + 8 * gq + 4 * hh;
            uint2 c = *(const uint2*)(vb + n);
            float cv[4] = {bflo(c.x), bfhi(c.x), bflo(c.y), bfhi(c.y)};
            float o[4];
#pragma unroll
            for (int r = 0; r < 4; ++r) {
              float vsh = cv[r];
              float yn = (y[j][4 * gq + r] - mu) * rstd * p.lnx_w[g.layer * 512 + n + r] + p.lnx_b[g.layer * 512 + n + r];
              o[r] = (yn + bsum * vsh) * acc[i][j][4 * gq + r];
            }
            store4(yb + n, o[0], o[1], o[2], o[3]);
          }
      }
    }
  }
}

template <int MODE, int EPI, int BN = 128>
DI void gemm_phase_item(CP p, const GArgs& g, int item, int NT, char* smem) {
  const int grp = item / (8 * NT);
  const int gsz = min(8, NMT - grp * 8);
  const int idx = item - grp * 8 * NT;
  gemm_tile<MODE, EPI, BN>(p, g, grp * 8 + idx % gsz, idx / gsz, smem);
}

template <int MODE, int EPI, int BN>
DI void gemm_phase(CP p, const GArgs& g, int NT, char* smem) {
  const int x = blockIdx.x & 7, j = blockIdx.x >> 3, nj = gridDim.x >> 3;
  const int total = 16 * NT;
  for (int e = j; e < total; e += nj) {
    const int grp = e / (8 * NT);
    const int rem = e - grp * 8 * NT;
    gemm_tile<MODE, EPI, BN>(p, g, x + 8 * (grp * 8 + (rem & 7)), rem >> 3, smem);
  }
  const int ntail = NT * (BN / 64);
  for (int e = (int)gridDim.x - 1 - (int)blockIdx.x; e < ntail; e += gridDim.x) gemm_tile<MODE, EPI, 64>(p, g, NMT - 1, e, smem);
}

DI void attn_item(CP p, int s, int hd, int qb, char* smem, bool dostore = true) {
  u16* Ks = (u16*)smem;
  u16* Vs = Ks + 2 * 64 * 104;
  const int tid = tidx(), lane = tid & 63, wv = tid >> 6, l32 = lane & 31, hh = lane >> 5;
  const int L = seq_len(s), r0 = seq_start(s);
  const u16* Qb = (const u16*)p.out + (size_t)TP * 1024;
  const u16* KR = Qb + (size_t)TP * 768;
  const int qpos = qb * 256 + wv * 32 + l32;
  const bool wvalid = (qb * 256 + wv * 32) < L;
  const int qrow = r0 + min(qpos, L - 1);
  bf16x8 qf[6];
#pragma unroll
  for (int ks = 0; ks < 6; ++ks) qf[ks] = *(const bf16x8*)(Qb + (size_t)qrow * 768 + hd * 96 + ks * 16 + hh * 8);
  f32x16 o[2];
#pragma unroll
  for (int u = 0; u < 2; ++u)
#pragma unroll
    for (int r = 0; r < 16; ++r) o[u][r] = 0.f;
  float mrun = -1e30f, lrun = 0.f;
  const int nt = (L + 63) >> 6;
  const u16* vtb = p.vt + (size_t)r0 * 512 + (size_t)hd * 64 * L;
  uint4 rg[3];
  auto ldc = [&](int kt, int c) -> uint4 {
    uint4 z = make_uint4(0, 0, 0, 0);
    if (c < 768) {
      int key = c / 12, cc = c - key * 12, kpos = kt * 64 + key;
      if (kpos >= L) return z;
      const u16* src = cc < 8 ? p.kn + (size_t)(r0 + kpos) * 512 + hd * 64 + cc * 8 : KR + (size_t)(r0 + kpos) * 32 + (cc - 8) * 8;
      return *(const uint4*)src;
    } else {
      int c2 = c - 768, dv = c2 >> 3, kc = c2 & 7, kp0 = kt * 64 + kc * 8;
      if (kp0 >= L) return z;
      return *(const uint4*)(vtb + (size_t)dv * L + kp0);
    }
  };
  auto stc = [&](int buf, int c, uint4 v) {
    if (c < 768) { int key = c / 12, cc = c - key * 12; *(uint4*)(Ks + (buf * 64 + key) * 104 + cc * 8) = v; }
    else { int c2 = c - 768, dv = c2 >> 3, kc = c2 & 7; *(uint4*)(Vs + (buf * 64 + dv) * 72 + kc * 8) = v; }
  };
  rg[0] = ldc(0, tid); rg[1] = ldc(0, tid + 512); if (tid < 256) rg[2] = ldc(0, tid + 1024);
  stc(0, tid, rg[0]); stc(0, tid + 512, rg[1]); if (tid < 256) stc(0, tid + 1024, rg[2]);
  __syncthreads();
  for (int kt = 0; kt < nt; ++kt) {
    const int buf = kt & 1;
    if (kt + 1 < nt) { rg[0] = ldc(kt + 1, tid); rg[1] = ldc(kt + 1, tid + 512); if (tid < 256) rg[2] = ldc(kt + 1, tid + 1024); }
    if (wvalid) {
      f32x16 st[2];
#pragma unroll
      for (int t = 0; t < 2; ++t) {
#pragma unroll
        for (int r = 0; r < 16; ++r) st[t][r] = 0.f;
        const u16* kb = Ks + (buf * 64 + t * 32 + l32) * 104 + hh * 8;
#pragma unroll
        for (int ks = 0; ks < 6; ++ks) st[t] = MFMA(*(const bf16x8*)(kb + ks * 16), qf[ks], st[t]);
      }
      if (kt == nt - 1) {
#pragma unroll
        for (int t = 0; t < 2; ++t)
#pragma unroll
          for (int r = 0; r < 16; ++r) if (kt * 64 + t * 32 + crow(r, hh) >= L) st[t][r] = -1e30f;
      }
      float mx = -1e30f;
#pragma unroll
      for (int t = 0; t < 2; ++t)
#pragma unroll
        for (int r = 0; r < 16; ++r) mx = fmaxf(mx, st[t][r]);
      mx = fmaxf(mx, __shfl_xor(mx, 32));
      const float mnew = fmaxf(mrun, mx);
      const float alpha = __builtin_amdgcn_exp2f(mrun - mnew);
      float ls = 0.f;
#pragma unroll
      for (int t = 0; t < 2; ++t)
#pragma unroll
        for (int r = 0; r < 16; ++r) { float pv = __builtin_amdgcn_exp2f(st[t][r] - mnew); st[t][r] = pv; ls += pv; }
      lrun = lrun * alpha + ls; mrun = mnew;
#pragma unroll
      for (int u = 0; u < 2; ++u)
#pragma unroll
        for (int r = 0; r < 16; ++r) o[u][r] *= alpha;
#pragma unroll
      for (int t = 0; t < 2; ++t)
#pragma unroll
        for (int s2 = 0; s2 < 2; ++s2) {
          uint4 pk;
          pk.x = pack2(st[t][8 * s2 + 0], st[t][8 * s2 + 1]); pk.y = pack2(st[t][8 * s2 + 2], st[t][8 * s2 + 3]);
          pk.z = pack2(st[t][8 * s2 + 4], st[t][8 * s2 + 5]); pk.w = pack2(st[t][8 * s2 + 6], st[t][8 * s2 + 7]);
          bf16x8 pf = __builtin_bit_cast(bf16x8, pk);
#pragma unroll
          for (int u = 0; u < 2; ++u) {
            bf16x8 vf = *(const bf16x8*)(Vs + (buf * 64 + u * 32 + l32) * 72 + t * 32 + s2 * 16 + hh * 8);
            o[u] = MFMA(vf, pf, o[u]);
          }
        }
    }
    if (kt + 1 < nt) { stc(buf ^ 1, tid, rg[0]); stc(buf ^ 1, tid + 512, rg[1]); if (tid < 256) stc(buf ^ 1, tid + 1024, rg[2]); }
    __syncthreads();
  }
  if (wvalid) {
    float lt = lrun + __shfl_xor(lrun, 32);
    const float inv = 1.f / lt;
    if (qpos < L && dostore) {
      u16* dst = (u16*)p.out + (size_t)TP * 1024 + (size_t)(r0 + qpos) * 768 + hd * 96;
#pragma unroll
      for (int u = 0; u < 2; ++u)
#pragma unroll
        for (int gq = 0; gq < 4; ++gq)
          store4(dst + u * 32 + 8 * gq + 4 * hh, o[u][4 * gq] * inv, o[u][4 * gq + 1] * inv, o[u][4 * gq + 2] * inv, o[u][4 * gq + 3] * inv);
    }
  }
}

DI void scan_block(CP p, int layer, int s, int d, int hd, char* smem) {
  float* OP = (float*)smem;
  float* WA = OP + 32 * 392;
  float* YB = WA + 2 * 32 * 64;
  u16* XL = (u16*)(YB + 32 * 64);
  float* MU = (float*)(XL + 2 * 32 * 72);
  float* CS = MU + 5 * 2 * 64;
  const int tid = tidx(), lane = tid & 63, wv = tid >> 6, l32 = lane & 31, hh = lane >> 5;
  const int L = seq_len(s), r0 = seq_start(s);
  const int sj = tid >> 4, q = tid & 15;
  const int rloc = lane >> 3, cg8 = lane & 7, row = wv * 8 + rloc;
  const int aoff[5] = {hd * 64, 512 + hd * 64, 1024 + hd * 64, 1536 + d * 64, 1664 + d * 64};
  __syncthreads();
  for (int i = tid; i < 640; i += NTHR) {
    int a = i >> 7, w = (i >> 6) & 1, c = i & 63;
    int off = a == 0 ? aoff[0] : a == 1 ? aoff[1] : a == 2 ? aoff[2] : a == 3 ? aoff[3] : aoff[4];
    MU[i] = p.shift_mu[(size_t)(layer * 2 + w) * 1952 + off + c];
  }
  if (tid < 64) {
    CS[tid] = p.key_k_k[layer * 512 + hd * 64 + tid];
    CS[64 + tid] = p.key_k_a[layer * 512 + hd * 64 + tid];
    CS[128 + tid] = p.bonus_r_k[layer * 512 + hd * 64 + tid];
  }
  const int mat = (wv >> 1) & 1, ntile = wv & 1;
  bf16x8 wfr[4];
  {
    const u16* wb = p.wM + (mat ? OFF_A : OFF_DEC) + (size_t)(d * 512 + hd * 64 + ntile * 32 + l32) * 64 + hh * 8;
#pragma unroll
    for (int ks = 0; ks < 4; ++ks) wfr[ks] = *(const bf16x8*)(wb + ks * 16);
  }
  const float bias = mat ? p.iclr_a0[(size_t)(layer * 2 + d) * 512 + hd * 64 + ntile * 32 + l32]
                         : p.decay_w0[(size_t)(layer * 2 + d) * 512 + hd * 64 + ntile * 32 + l32];
  __syncthreads();
  float S[8];
#pragma unroll
  for (int i = 0; i < 8; ++i) S[i] = 0.f;
  const int nch = (L + 31) >> 5;
  uint2 raw[15];
  float r4[4], k4[4], kk4[4], v4[4];

  auto prefetch = [&](int c) {
    const int sidx = c * 32 + sj;
    const bool valid = sidx < L;
    const int tok = d == 0 ? sidx : L - 1 - sidx;
    const u16* base = p.regB + (size_t)(r0 + tok) * 1952 + 4 * q;
#pragma unroll
    for (int a = 0; a < 5; ++a) {
      const int off = a == 0 ? aoff[0] : a == 1 ? aoff[1] : a == 2 ? aoff[2] : a == 3 ? aoff[3] : aoff[4];
      raw[a * 3 + 0] = (valid && tok > 0) ? *(const uint2*)(base - 1952 + off) : make_uint2(0, 0);
      raw[a * 3 + 1] = valid ? *(const uint2*)(base + off) : make_uint2(0, 0);
      raw[a * 3 + 2] = (valid && tok + 1 < L) ? *(const uint2*)(base + 1952 + off) : make_uint2(0, 0);
    }
  };
  auto shift4 = [&](int a, float* x) {
    const float4 m0 = *(const float4*)(MU + (a * 2 + 0) * 64 + 4 * q);
    const float4 m1 = *(const float4*)(MU + (a * 2 + 1) * 64 + 4 * q);
    const uint2 pm = raw[a * 3], c = raw[a * 3 + 1], pp = raw[a * 3 + 2];
    float c0 = bflo(c.x), c1 = bfhi(c.x), c2 = bflo(c.y), c3 = bfhi(c.y);
    x[0] = c0 + m0.x * (bflo(pm.x) - c0) + m1.x * (bflo(pp.x) - c0);
    x[1] = c1 + m0.y * (bfhi(pm.x) - c1) + m1.y * (bfhi(pp.x) - c1);
    x[2] = c2 + m0.z * (bflo(pm.y) - c2) + m1.z * (bflo(pp.y) - c2);
    x[3] = c3 + m0.w * (bfhi(pm.y) - c3) + m1.w * (bfhi(pp.y) - c3);
  };
  auto stage = [&](int c) {
    shift4(0, r4); shift4(1, k4); shift4(2, v4);
    float xw[4], xa[4];
    shift4(3, xw); shift4(4, xa);
#pragma unroll
    for (int e = 0; e < 4; ++e) xw[e] = 1.f - 2.f / (__expf(2.f * xw[e]) + 1.f);
    store4(XL + sj * 72 + 4 * q, xw[0], xw[1], xw[2], xw[3]);
    store4(XL + 32 * 72 + sj * 72 + 4 * q, xa[0], xa[1], xa[2], xa[3]);
    {
      const float4 kkw = *(const float4*)(CS + 4 * q);
      float x0 = k4[0] * kkw.x, x1 = k4[1] * kkw.y, x2 = k4[2] * kkw.z, x3 = k4[3] * kkw.w;
      float ss = sum16(x0 * x0 + x1 * x1 + x2 * x2 + x3 * x3);
      float inv = 1.f / fmaxf(sqrtf(ss), 1e-12f);
      kk4[0] = x0 * inv; kk4[1] = x1 * inv; kk4[2] = x2 * inv; kk4[3] = x3 * inv;
    }
    __syncthreads();
    if (wv < 4) {
      f32x16 acc;
#pragma unroll
      for (int r = 0; r < 16; ++r) acc[r] = 0.f;
      const u16* xb = XL + mat * 32 * 72 + l32 * 72 + hh * 8;
#pragma unroll
      for (int ks = 0; ks < 4; ++ks) acc = MFMA(*(const bf16x8*)(xb + ks * 16), wfr[ks], acc);
#pragma unroll
      for (int r = 0; r < 16; ++r) {
        float x = acc[r] + bias;
        float sg = sigmoidf_(x);
        float val = mat ? sg : __expf(-0.6065306597126334f * sg);
        WA[(mat * 32 + crow(r, hh)) * 64 + ntile * 32 + l32] = val;
      }
    }
    __syncthreads();
    {
      const float4 w4 = *(const float4*)(WA + sj * 64 + 4 * q);
      const float4 a4 = *(const float4*)(WA + (32 + sj) * 64 + 4 * q);
      const float4 ka = *(const float4*)(CS + 64 + 4 * q);
      const float4 brk = *(const float4*)(CS + 128 + 4 * q);
      const float wv4[4] = {w4.x, w4.y, w4.z, w4.w}, av4[4] = {a4.x, a4.y, a4.z, a4.w};
      const float kav[4] = {ka.x, ka.y, ka.z, ka.w}, bkv[4] = {brk.x, brk.y, brk.z, brk.w};
      float aa[4], wr[4], bb[4], kd[4];
      float br = 0.f, kr = 0.f, bs = 0.f;
#pragma unroll
      for (int e = 0; e < 4; ++e) {
        aa[e] = -kk4[e]; wr[e] = wv4[e] * r4[e]; bb[e] = kk4[e] * av4[e];
        kd[e] = k4[e] * (1.f + (av4[e] - 1.f) * kav[e]);
        br += bb[e] * r4[e]; kr += kd[e] * r4[e]; bs += r4[e] * kd[e] * bkv[e];
      }
      br = sum16(br); kr = sum16(kr); bs = sum16(bs);
      float* o = OP + sj * 392 + 4 * q;
      *(float4*)(o) = make_float4(aa[0], aa[1], aa[2], aa[3]);
      *(float4*)(o + 64) = make_float4(wr[0], wr[1], wr[2], wr[3]);
      *(float4*)(o + 128) = w4;
      *(float4*)(o + 192) = make_float4(bb[0], bb[1], bb[2], bb[3]);
      *(float4*)(o + 256) = make_float4(kd[0], kd[1], kd[2], kd[3]);
      *(float4*)(o + 320) = make_float4(v4[0], v4[1], v4[2], v4[3]);
      if (q == 0) {
        OP[sj * 392 + 384] = br; OP[sj * 392 + 385] = kr;
        const int sidx = c * 32 + sj;
        if (sidx < L) { const int tok = d == 0 ? sidx : L - 1 - sidx; p.bsc[((size_t)d * TP + r0 + tok) * 8 + hd] = bs; }
      }
    }
    __syncthreads();
  };

  prefetch(0);
  stage(0);
  for (int c = 0; c < nch; ++c) {
    if (c + 1 < nch) prefetch(c + 1);
    const int nst = min(32, L - c * 32);
    for (int jj = 0; jj < nst; ++jj) {
      const float* o = OP + jj * 392;
      const float4 a0 = *(const float4*)(o + cg8 * 8), a1 = *(const float4*)(o + cg8 * 8 + 4);
      const float4 y0 = *(const float4*)(o + 64 + cg8 * 8), y1 = *(const float4*)(o + 64 + cg8 * 8 + 4);
      const float4 w0 = *(const float4*)(o + 128 + cg8 * 8), w1 = *(const float4*)(o + 128 + cg8 * 8 + 4);
      const float4 b0 = *(const float4*)(o + 192 + cg8 * 8), b1 = *(const float4*)(o + 192 + cg8 * 8 + 4);
      const float4 k0 = *(const float4*)(o + 256 + cg8 * 8), k1 = *(const float4*)(o + 256 + cg8 * 8 + 4);
      const float vv = o[320 + row];
      const float2 sc = *(const float2*)(o + 384);
      float da = S[0] * a0.x + S[1] * a0.y + S[2] * a0.z + S[3] * a0.w + S[4] * a1.x + S[5] * a1.y + S[6] * a1.z + S[7] * a1.w;
      float dy = S[0] * y0.x + S[1] * y0.y + S[2] * y0.z + S[3] * y0.w + S[4] * y1.x + S[5] * y1.y + S[6] * y1.z + S[7] * y1.w;
      da = dpp_sum8(da); dy = dpp_sum8(dy);
      const float yv = dy + da * sc.x + vv * sc.y;
      S[0] = S[0] * w0.x + da * b0.x + vv * k0.x; S[1] = S[1] * w0.y + da * b0.y + vv * k0.y;
      S[2] = S[2] * w0.z + da * b0.z + vv * k0.z; S[3] = S[3] * w0.w + da * b0.w + vv * k0.w;
      S[4] = S[4] * w1.x + da * b1.x + vv * k1.x; S[5] = S[5] * w1.y + da * b1.y + vv * k1.y;
      S[6] = S[6] * w1.z + da * b1.z + vv * k1.z; S[7] = S[7] * w1.w + da * b1.w + vv * k1.w;
      if (cg8 == 0) YB[jj * 64 + row] = yv;
    }
    __syncthreads();
    {
      const int sidx = c * 32 + sj;
      if (sidx < L) {
        const int tok = d == 0 ? sidx : L - 1 - sidx;
        const float4 yv = *(const float4*)(YB + sj * 64 + 4 * q);
        store4((u16*)p.out + (size_t)(r0 + tok) * 1024 + d * 512 + hd * 64 + 4 * q, yv.x, yv.y, yv.z, yv.w);
      }
    }
    if (c + 1 < nch) stage(c + 1);
  }
  __syncthreads();
}

typedef float f2 __attribute__((ext_vector_type(2)));
DI f2 mk2(float a, float b) { f2 r; r.x = a; r.y = b; return r; }
#define LDS_FENCE() asm volatile("s_waitcnt lgkmcnt(0)" ::: "memory")

template <int CPL>
DI void scan_block2(CP p, int layer, int s, int d, int hd, int rowhalf, char* smem) {
  float* OP = (float*)smem;
  float* YB = OP + 2 * 32 * 392;
  u16* XL = (u16*)(YB + 2 * 32 * 64);
  float* MU = (float*)(XL + 2 * 32 * 72);
  float* CS = MU + 640;
  u16* WL = (u16*)(CS + 192);
  const int tid = tidx(), lane = tid & 63, wv = tid >> 6, l32 = lane & 31, hh = lane >> 5;
  const int L = seq_len(s), r0 = seq_start(s);
  const int aoff0 = hd * 64, aoff1 = 512 + hd * 64, aoff2 = 1024 + hd * 64, aoff3 = 1536 + d * 64, aoff4 = 1664 + d * 64;
  __syncthreads();
  for (int i = tid; i < 640; i += NTHR) {
    int a = i >> 7, w = (i >> 6) & 1, c = i & 63;
    int off = a == 0 ? aoff0 : a == 1 ? aoff1 : a == 2 ? aoff2 : a == 3 ? aoff3 : aoff4;
    MU[i] = p.shift_mu[(size_t)(layer * 2 + w) * 1952 + off + c];
  }
#pragma unroll
  for (int i = 0; i < 2; ++i) {
    const int idx = tid + i * NTHR, mat = idx >> 9, col = (idx >> 3) & 63, kc = idx & 7;
    *(uint4*)(WL + (mat * 64 + col) * 72 + kc * 8) = *(const uint4*)(p.wM + (mat ? OFF_A : OFF_DEC) + (size_t)(d * 512 + hd * 64 + col) * 64 + kc * 8);
  }
  if (tid < 64) {
    CS[tid] = p.key_k_k[layer * 512 + hd * 64 + tid];
    CS[64 + tid] = p.key_k_a[layer * 512 + hd * 64 + tid];
    CS[128 + tid] = p.bonus_r_k[layer * 512 + hd * 64 + tid];
  }
  __syncthreads();
  const int nch = (L + 31) >> 5;

  if (wv >= 4) {
    const int sw = wv - 4;
    const int q = lane & 15;
    float bias[2][2];
#pragma unroll
    for (int mat = 0; mat < 2; ++mat)
#pragma unroll
      for (int nt2 = 0; nt2 < 2; ++nt2)
        bias[mat][nt2] = mat ? p.iclr_a0[(size_t)(layer * 2 + d) * 512 + hd * 64 + nt2 * 32 + l32]
                             : p.decay_w0[(size_t)(layer * 2 + d) * 512 + hd * 64 + nt2 * 32 + l32];
    uint2 raw[2][5];
    auto load_raw = [&](int c) {
#pragma unroll
      for (int u = 0; u < 2; ++u) {
        const int sj = 8 * sw + 4 * u + (lane >> 4);
        const int sidc = min(c * 32 + sj, L - 1);
        const int tok = d == 0 ? sidc : L - 1 - sidc;
        const u16* base = p.regB + (size_t)(r0 + tok) * 1952 + 4 * q;
        raw[u][0] = *(const uint2*)(base + aoff0); raw[u][1] = *(const uint2*)(base + aoff1); raw[u][2] = *(const uint2*)(base + aoff2);
        raw[u][3] = *(const uint2*)(base + aoff3); raw[u][4] = *(const uint2*)(base + aoff4);
      }
    };
    auto stage = [&](int c) {
      float r4[2][4], k4[2][4], kk4[2][4], v4[2][4];
#pragma unroll
      for (int u = 0; u < 2; ++u) {
        const int sj = 8 * sw + 4 * u + (lane >> 4);
        r4[u][0] = bflo(raw[u][0].x); r4[u][1] = bfhi(raw[u][0].x); r4[u][2] = bflo(raw[u][0].y); r4[u][3] = bfhi(raw[u][0].y);
        k4[u][0] = bflo(raw[u][1].x); k4[u][1] = bfhi(raw[u][1].x); k4[u][2] = bflo(raw[u][1].y); k4[u][3] = bfhi(raw[u][1].y);
        v4[u][0] = bflo(raw[u][2].x); v4[u][1] = bfhi(raw[u][2].x); v4[u][2] = bflo(raw[u][2].y); v4[u][3] = bfhi(raw[u][2].y);
        *(uint2*)(XL + sj * 72 + 4 * q) = raw[u][3];
        *(uint2*)(XL + 32 * 72 + sj * 72 + 4 * q) = raw[u][4];
        const float4 kkw = *(const float4*)(CS + 4 * q);
        float x0 = k4[u][0] * kkw.x, x1 = k4[u][1] * kkw.y, x2 = k4[u][2] * kkw.z, x3 = k4[u][3] * kkw.w;
        float ss = sum16(x0 * x0 + x1 * x1 + x2 * x2 + x3 * x3);
        float inv = __builtin_amdgcn_rsqf(fmaxf(ss, 1e-24f));
        kk4[u][0] = x0 * inv; kk4[u][1] = x1 * inv; kk4[u][2] = x2 * inv; kk4[u][3] = x3 * inv;
      }
      LDS_FENCE();
      float* OPn = OP + (c & 1) * 32 * 392;
#pragma unroll
      for (int mat = 0; mat < 2; ++mat)
#pragma unroll
        for (int nt2 = 0; nt2 < 2; ++nt2) {
          f32x16 acc;
#pragma unroll
          for (int r = 0; r < 16; ++r) acc[r] = 0.f;
          const u16* xb = XL + mat * 32 * 72 + (8 * sw + (l32 & 7)) * 72 + hh * 8;
#pragma unroll
          for (int ks = 0; ks < 4; ++ks) acc = MFMA(*(const bf16x8*)(xb + ks * 16), *(const bf16x8*)(WL + (mat * 64 + nt2 * 32 + l32) * 72 + ks * 16 + hh * 8), acc);
#pragma unroll
          for (int r = 0; r < 4; ++r) {
            float x = acc[r] + bias[mat][nt2];
            float sg = sigmoidf_(x);
            float val = mat ? sg : __expf(-0.6065306597126334f * sg);
            OPn[(8 * sw + 4 * hh + r) * 392 + (mat ? 0 : 128) + nt2 * 32 + l32] = val;
          }
        }
      LDS_FENCE();
#pragma unroll
      for (int u = 0; u < 2; ++u) {
        const int sj = 8 * sw + 4 * u + (lane >> 4);
        const float4 w4 = *(const float4*)(OPn + sj * 392 + 128 + 4 * q);
        const float4 a4 = *(const float4*)(OPn + sj * 392 + 4 * q);
        const float4 ka = *(const float4*)(CS + 64 + 4 * q);
        const float4 brk = *(const float4*)(CS + 128 + 4 * q);
        const float wv4[4] = {w4.x, w4.y, w4.z, w4.w}, av4[4] = {a4.x, a4.y, a4.z, a4.w};
        const float kav[4] = {ka.x, ka.y, ka.z, ka.w}, bkv[4] = {brk.x, brk.y, brk.z, brk.w};
        float aa[4], wr[4], bb[4], kd[4];
        float br = 0.f, kr = 0.f, bs = 0.f;
#pragma unroll
        for (int e = 0; e < 4; ++e) {
          aa[e] = -kk4[u][e]; wr[e] = wv4[e] * r4[u][e]; bb[e] = kk4[u][e] * av4[e];
          kd[e] = k4[u][e] * (1.f + (av4[e] - 1.f) * kav[e]);
          br += bb[e] * r4[u][e]; kr += kd[e] * r4[u][e]; bs += r4[u][e] * kd[e] * bkv[e];
        }
        br = sum16(br); kr = sum16(kr); bs = sum16(bs);
        float* o = OPn + sj * 392 + 4 * q;
        *(float4*)(o) = make_float4(aa[0], aa[1], aa[2], aa[3]);
        *(float4*)(o + 64) = make_float4(wr[0], wr[1], wr[2], wr[3]);
        *(float4*)(o + 128) = w4;
        *(float4*)(o + 192) = make_float4(bb[0], bb[1], bb[2], bb[3]);
        *(float4*)(o + 256) = make_float4(kd[0], kd[1], kd[2], kd[3]);
        *(float4*)(o + 320) = make_float4(v4[u][0], v4[u][1], v4[u][2], v4[u][3]);
        if (q == 0) {
          OPn[sj * 392 + 384] = br; OPn[sj * 392 + 385] = kr;
          const int sidx = c * 32 + sj;
          if (sidx < L && rowhalf == 0) { const int tok = d == 0 ? sidx : L - 1 - sidx; p.bsc[((size_t)d * TP + r0 + tok) * 8 + hd] = bs; }
        }
      }
    };
    auto writeout = [&](int c) {
      const float* yb = YB + (c & 1) * 2048;
#pragma unroll
      for (int u = 0; u < 2; ++u) {
        const int sj = 8 * sw + 4 * u + (lane >> 4);
        const int sidx = c * 32 + sj;
        const bool mine = CPL == 16 ? true : ((q >> 3) == rowhalf);
        if (sidx < L && mine) {
          const int tok = d == 0 ? sidx : L - 1 - sidx;
          const float4 yv = *(const float4*)(yb + sj * 64 + 4 * q);
          store4((u16*)p.out + (size_t)(r0 + tok) * 1024 + d * 512 + hd * 64 + 4 * q, yv.x, yv.y, yv.z, yv.w);
        }
      }
    };
    load_raw(0);
    stage(0);
    if (nch > 1) load_raw(1);
    __syncthreads();
    for (int c = 0; c < nch; ++c) {
      if (c + 1 < nch) { stage(c + 1); if (c + 2 < nch) load_raw(c + 2); }
      if (c >= 1) writeout(c - 1);
      __syncthreads();
    }
    writeout(nch - 1);
  } else {
    constexpr int LPRW = 64 / CPL;
    constexpr int NV = CPL / 2;
    const int cg = lane % LPRW;
    const int row = (CPL == 8 ? rowhalf * 32 + wv * 8 : wv * 16) + lane / LPRW;
    f2 S[NV];
#pragma unroll
    for (int i = 0; i < NV; ++i) S[i] = mk2(0.f, 0.f);
    __builtin_amdgcn_s_setprio(3);
    __syncthreads();
    for (int c = 0; c < nch; ++c) {
      const int nst = min(32, L - c * 32);
      const float* ob = OP + (c & 1) * 32 * 392;
      float* yb = YB + (c & 1) * 2048;
      float* ydst = cg == 0 ? yb + row : (float*)(smem + 147712) + lane;
      const int ystride = cg == 0 ? 64 : 0;
      float4 ca[CPL / 4], cy[CPL / 4], cw[CPL / 4], cb[CPL / 4], ck[CPL / 4];
      float cvv; float2 csc;
      {
        const float* o = ob + cg * CPL;
#pragma unroll
        for (int i = 0; i < CPL / 4; ++i) {
          ca[i] = *(const float4*)(o + 4 * i); cy[i] = *(const float4*)(o + 64 + 4 * i); cw[i] = *(const float4*)(o + 128 + 4 * i);
          cb[i] = *(const float4*)(o + 192 + 4 * i); ck[i] = *(const float4*)(o + 256 + 4 * i);
        }
        cvv = ob[320 + row]; csc = *(const float2*)(ob + 384);
      }
#pragma unroll 4
      for (int jj = 0; jj < nst; ++jj) {
        float4 na[CPL / 4], ny[CPL / 4], nw[CPL / 4], nb[CPL / 4], nk[CPL / 4];
        float nvv; float2 nsc;
        {
          const int jn = jj + 1;
          const float* o = ob + jn * 392 + cg * CPL;
#pragma unroll
          for (int i = 0; i < CPL / 4; ++i) {
            na[i] = *(const float4*)(o + 4 * i); ny[i] = *(const float4*)(o + 64 + 4 * i); nw[i] = *(const float4*)(o + 128 + 4 * i);
            nb[i] = *(const float4*)(o + 192 + 4 * i); nk[i] = *(const float4*)(o + 256 + 4 * i);
          }
          nvv = ob[jn * 392 + 320 + row]; nsc = *(const float2*)(ob + jn * 392 + 384);
        }
        f2 A[NV], Y[NV], W[NV], B[NV], K[NV];
#pragma unroll
        for (int i = 0; i < CPL / 4; ++i) {
          A[2 * i] = mk2(ca[i].x, ca[i].y); A[2 * i + 1] = mk2(ca[i].z, ca[i].w);
          Y[2 * i] = mk2(cy[i].x, cy[i].y); Y[2 * i + 1] = mk2(cy[i].z, cy[i].w);
          W[2 * i] = mk2(cw[i].x, cw[i].y); W[2 * i + 1] = mk2(cw[i].z, cw[i].w);
          B[2 * i] = mk2(cb[i].x, cb[i].y); B[2 * i + 1] = mk2(cb[i].z, cb[i].w);
          K[2 * i] = mk2(ck[i].x, ck[i].y); K[2 * i + 1] = mk2(ck[i].z, ck[i].w);
        }
        const float vv = cvv;
        f2 pa0 = S[0] * A[0], pa1 = S[1] * A[1], py0 = S[0] * Y[0], py1 = S[1] * Y[1];
#pragma unroll
        for (int i = 2; i < NV; i += 2) {
          pa0 = S[i] * A[i] + pa0; pa1 = S[i + 1] * A[i + 1] + pa1;
          py0 = S[i] * Y[i] + py0; py1 = S[i + 1] * Y[i + 1] + py1;
        }
        pa0 = pa0 + pa1; py0 = py0 + py1;
        float da = pa0.x + pa0.y, dy = py0.x + py0.y;
        const f2 vvv = mk2(vv, vv);
        f2 SW[NV];
#pragma unroll
        for (int i = 0; i < NV; ++i) SW[i] = S[i] * W[i] + vvv * K[i];
        da += __int_as_float(__builtin_amdgcn_update_dpp(0, __float_as_int(da), 0xB1, 0xf, 0xf, false));
        dy += __int_as_float(__builtin_amdgcn_update_dpp(0, __float_as_int(dy), 0xB1, 0xf, 0xf, false));
        da += __int_as_float(__builtin_amdgcn_update_dpp(0, __float_as_int(da), 0x4E, 0xf, 0xf, false));
        dy += __int_as_float(__builtin_amdgcn_update_dpp(0, __float_as_int(dy), 0x4E, 0xf, 0xf, false));
        if (CPL == 8) {
          da += __int_as_float(__builtin_amdgcn_update_dpp(0, __float_as_int(da), 0x141, 0xf, 0xf, false));
          dy += __int_as_float(__builtin_amdgcn_update_dpp(0, __float_as_int(dy), 0x141, 0xf, 0xf, false));
        }
        const f2 dav = mk2(da, da);
#pragma unroll
        for (int i = 0; i < NV; ++i) S[i] = dav * B[i] + SW[i];
        const float yv = dy + da * csc.x + vv * csc.y;
        ydst[jj * ystride] = yv;
#pragma unroll
        for (int i = 0; i < CPL / 4; ++i) { ca[i] = na[i]; cy[i] = ny[i]; cw[i] = nw[i]; cb[i] = nb[i]; ck[i] = nk[i]; }
        cvv = nvv; csc = nsc;
      }
      __syncthreads();
    }
    __builtin_amdgcn_s_setprio(0);
  }
  __syncthreads();
}

DI void shift_item(CP p, int layer, int ch, char* smem) {
  const int tid = tidx();
  int s, c;
  if (ch < 258) { s = ch / 129; c = ch - s * 129; } else { int x = ch - 258; s = 2 + x / 33; c = x - (s - 2) * 33; }
  const int L = seq_len(s), r0 = seq_start(s) + c * 64;
  const int nrows = min(64, L - c * 64);
  const int cgp = tid & 255, rg = tid >> 8;
  const int col = cgp * 8;
  const int rlo = rg * 32, rhi = min(rlo + 32, nrows);
  const bool act = cgp < 244 && rlo < nrows;
  typedef unsigned u32x4 __attribute__((ext_vector_type(4)));
  u32x4 prev = {0u, 0u, 0u, 0u}, cur = prev, lastn = prev;
  float mu0[8], mu1[8];
  u16* base = p.regB + (size_t)r0 * 1952 + col;
  if (act) {
#pragma unroll
    for (int e = 0; e < 8; ++e) { mu0[e] = p.shift_mu[(size_t)(layer * 2) * 1952 + col + e]; mu1[e] = p.shift_mu[(size_t)(layer * 2 + 1) * 1952 + col + e]; }
    if (rlo > 0) prev = *(const u32x4*)(base + (size_t)(rlo - 1) * 1952);
    else if (c > 0) prev = *(const u32x4*)(halo_ptr(p) + ((size_t)(ch - 1) * 2 + 1) * 1952 + col);
    cur = *(const u32x4*)(base + (size_t)rlo * 1952);
    if (rhi < nrows) lastn = *(const u32x4*)(base + (size_t)rhi * 1952);
    else if (c * 64 + nrows < L) lastn = *(const u32x4*)(halo_ptr(p) + ((size_t)(ch + 1) * 2) * 1952 + col);
  }
  __syncthreads();
  if (act) {
    const int kind = col < 1536 ? 0 : col < 1664 ? 1 : col < 1792 ? 0 : 2;
    for (int rb = rlo; rb < rhi; rb += 8) {
      u32x4 rw[9];
      rw[0] = cur;
#pragma unroll
      for (int i = 1; i < 9; ++i) { const int r = rb + i; rw[i] = (r < rhi) ? *(const u32x4*)(base + (size_t)r * 1952) : lastn; }
#pragma unroll
      for (int i = 0; i < 8; ++i) {
        const u32x4 cc = rw[i], nn = rw[i + 1];
        const unsigned pc[4] = {cc.x, cc.y, cc.z, cc.w}, pm[4] = {prev.x, prev.y, prev.z, prev.w}, pn[4] = {nn.x, nn.y, nn.z, nn.w};
        unsigned o[4];
#pragma unroll
        for (int e = 0; e < 4; ++e) {
          float c0 = bflo(pc[e]), c1 = bfhi(pc[e]);
          float x0 = c0 + mu0[2 * e] * (bflo(pm[e]) - c0) + mu1[2 * e] * (bflo(pn[e]) - c0);
          float x1 = c1 + mu0[2 * e + 1] * (bfhi(pm[e]) - c1) + mu1[2 * e + 1] * (bfhi(pn[e]) - c1);
          if (kind == 1) { x0 = 1.f - 2.f * __builtin_amdgcn_rcpf(__expf(2.f * x0) + 1.f); x1 = 1.f - 2.f * __builtin_amdgcn_rcpf(__expf(2.f * x1) + 1.f); }
          else if (kind == 2) { x0 = sigmoidf_(x0); x1 = sigmoidf_(x1); }
          o[e] = pack2(x0, x1);
        }
        { u32x4 ov = {o[0], o[1], o[2], o[3]}; *(u32x4*)(base + (size_t)(rb + i) * 1952) = ov; }
        prev = cc;
      }
      cur = rw[8];
    }
  }
  __syncthreads();
}

DI void init_rows(CP p, int item) {
  const int lane = tidx() & 63, wv = tidx() >> 6;
  const int r = item * 8 + wv;
  if (r >= TP) return;
  u16* dst = p.hb + (size_t)r * 1024 + lane * 16;
  float ss = 0.f;
  if (r < T) {
    int s, pos, L; row2seq(r, s, pos, L);
    const float* src = pos < 16 ? p.meta + pos * 1024
                     : (s < 2 ? p.x_prompt + ((size_t)s * 8192 + pos - 16) * 1024 : p.x_sample + ((size_t)(s - 2) * 2048 + pos - 16) * 1024);
    src += lane * 16;
    unsigned pk[8];
#pragma unroll
    for (int i = 0; i < 4; ++i) {
      float4 v = *(const float4*)(src + 4 * i);
      pk[2 * i] = pack2(v.x, v.y); pk[2 * i + 1] = pack2(v.z, v.w);
      float a = bflo(pk[2 * i]), b = bfhi(pk[2 * i]), c = bflo(pk[2 * i + 1]), dd = bfhi(pk[2 * i + 1]);
      ss += a * a + b * b + c * c + dd * dd;
    }
    *(uint4*)dst = make_uint4(pk[0], pk[1], pk[2], pk[3]);
    *(uint4*)(dst + 8) = make_uint4(pk[4], pk[5], pk[6], pk[7]);
  } else {
    *(uint4*)dst = make_uint4(0, 0, 0, 0);
    *(uint4*)(dst + 8) = make_uint4(0, 0, 0, 0);
  }
#pragma unroll
  for (int o = 32; o > 0; o >>= 1) ss += __shfl_xor(ss, o);
  if (lane < 16) p.ssq[(size_t)lane * TP + r] = lane == 0 ? ss : 0.f;
}
DI void init_rope(CP p, int item) {
  const int idx = item * NTHR + tidx();
  if (idx >= LPR * 16) return;
  const int pos = idx >> 4, i = idx & 15;
  double rev = (double)pos * ROPE_INV[i] * 0.15915494309189535;
  rev -= rint(rev);
  const float fr = (float)rev;
  p.ropec[idx] = __builtin_amdgcn_cosf(fr);
  p.ropes[idx] = __builtin_amdgcn_sinf(fr);
}
DI void final_rows(CP p, int item) {
  const int lane = tidx() & 63, wv = tidx() >> 6;
  const int orow = item * 8 + wv;
  int r;
  if (orow < 16384) { int s = orow >> 13; r = s * LPR + 16 + (orow & 8191); }
  else { int x = orow - 16384; int s = x >> 11; r = 2 * LPR + s * LSM + 16 + (x & 2047); }
  const float rs = rstd16(p.ssq, r);
  const u16* src = p.hb + (size_t)r * 1024 + lane * 16;
  uint4 a = *(const uint4*)src, b = *(const uint4*)(src + 8);
  unsigned w[8] = {a.x, a.y, a.z, a.w, b.x, b.y, b.z, b.w};
  float* dst = p.out + (size_t)orow * 1024 + lane * 16;
  const float* gn = p.final_norm + lane * 16;
#pragma unroll
  for (int i = 0; i < 4; ++i) {
    float4 o;
    o.x = bflo(w[2 * i]) * rs * gn[4 * i]; o.y = bfhi(w[2 * i]) * rs * gn[4 * i + 1];
    o.z = bflo(w[2 * i + 1]) * rs * gn[4 * i + 2]; o.w = bfhi(w[2 * i + 1]) * rs * gn[4 * i + 3];
    *(float4*)(dst + 4 * i) = o;
  }
}

#define XB_TMO      128
#define XB_XCNT(j)  (256  + 64 * (j))
#define XB_XSUB(j)  (1280 + 64 * (j))
#define XB_XGEN(j)  (2304 + 64 * (j))
#define XB_TOP      3328
#define XB_TOPGEN   3392
#define XCD_BAR_WORDS 3456
#define XB_SPIN_CAP (1u << 18)
#define LAS __attribute__((address_space(3)))

__device__ __forceinline__ unsigned xb_ld(unsigned* p)              { return __hip_atomic_load(p, __ATOMIC_RELAXED, __HIP_MEMORY_SCOPE_AGENT); }
__device__ __forceinline__ unsigned xb_add(unsigned* p, unsigned v) { return __hip_atomic_fetch_add(p, v, __ATOMIC_RELAXED, __HIP_MEMORY_SCOPE_AGENT); }
__device__ __forceinline__ unsigned xb_xcc_id() { return (unsigned)__builtin_amdgcn_s_getreg((3 << 11) | 20) & 0xFu; }
#define XB_SPIN(cond, bar) do { unsigned _sp = 0; while (cond) { __builtin_amdgcn_s_sleep(1); \
    if ((++_sp & 255u) == 0u) { if (xb_ld(&(bar)[XB_TMO])) break; if (_sp > XB_SPIN_CAP) { atomicAdd(&(bar)[XB_TMO], 1u); break; } } } } while (0)

struct XcdBarrier {
    unsigned* bar; unsigned x;
    volatile LAS unsigned* st;
};

__device__ __forceinline__ XcdBarrier xcd_barrier_post(unsigned* bar, volatile LAS unsigned* st) {
    XcdBarrier b; b.bar = bar; b.x = xb_xcc_id(); b.st = st;
    if (threadIdx.x == 0) (void)xb_add(&bar[XB_XCNT(b.x)], 1u);
    return b;
}
__device__ __forceinline__ void xcd_barrier_complete(unsigned* bar, unsigned x, unsigned& nloc, unsigned& nx) {
    const unsigned G = gridDim.x * gridDim.y * gridDim.z;
    unsigned sum, cnt, mine, sp = 0u;
    for (;;) {
        sum = 0u; cnt = 0u; mine = 0u;
#pragma unroll
        for (unsigned j = 0; j < 16; ++j) { const unsigned c = xb_ld(&bar[XB_XCNT(j)]); sum += c; cnt += (c > 0u) ? 1u : 0u; mine = (j == x) ? c : mine; }
        if (sum == G) break;
        __builtin_amdgcn_s_sleep(1);
        if ((++sp & 255u) == 0u) { if (xb_ld(&bar[XB_TMO])) break; if (sp > XB_SPIN_CAP) { atomicAdd(&bar[XB_TMO], 1u); break; } }
    }
    nloc = mine > 0u ? mine : 1u; nx = cnt > 0u ? cnt : 1u;
}

__device__ __forceinline__ void xcd_barrier(const XcdBarrier& b) {
    asm volatile("s_waitcnt vmcnt(0)" ::: "memory");
    __syncthreads();
    if (threadIdx.x == 0) {
        unsigned* bar = b.bar;
        __builtin_amdgcn_s_waitcnt(0);
        unsigned nloc = b.st[0], nx = b.st[1];
        if (nloc == 0u) { xcd_barrier_complete(bar, b.x, nloc, nx); b.st[0] = nloc; b.st[1] = nx; }
        const unsigned old = xb_add(&bar[XB_XSUB(b.x)], 1u);
        const unsigned gen = old / nloc;
        if (old + 1u == (gen + 1u) * nloc) {
            __builtin_amdgcn_fence(__ATOMIC_RELEASE, "agent");
            asm volatile("s_waitcnt vmcnt(0)" ::: "memory");
            const unsigned og = xb_add(&bar[XB_TOP], 1u);
            const unsigned tg = og / nx;
            if (og + 1u == (tg + 1u) * nx) xb_add(&bar[XB_TOPGEN], 1u);
            else XB_SPIN(xb_ld(&bar[XB_TOPGEN]) == tg, bar);
            __builtin_amdgcn_fence(__ATOMIC_ACQUIRE, "agent");
            xb_add(&bar[XB_XGEN(b.x)], 1u);
            asm volatile("s_waitcnt vmcnt(0)" ::: "memory");
        } else {
            XB_SPIN(xb_ld(&bar[XB_XGEN(b.x)]) == gen, bar);
            __builtin_amdgcn_fence(__ATOMIC_ACQUIRE, "agent");
            asm volatile("s_waitcnt vmcnt(0)" ::: "memory");
        }
    }
    __syncthreads();
}

constexpr int NPHASE = 21;
#ifndef ONLY
#define EN(x) true
#else
#define EN(x) ((x) == ONLY)
#endif
DI void run_phase(CP p, int ph, char* smem) {
  const int bid = blockIdx.x, nb = gridDim.x;
  const int fidx = (bid & 7) ? (bid >> 3) * 7 + (bid & 7) - 1 : -1, nfill = (nb >> 3) * 7;
  if (EN(100) && ph == 0) {
    const int n0 = NCONV_FFN, n1 = n0, n2 = n1 + TP / 8, n3 = n2 + (LPR * 16 + NTHR - 1) / NTHR;
    for (int it = bid; it < n3; it += nb) {
      if (it < n0) conv_ffn(p, 0, 0, it, smem);
      else if (it < n2) init_rows(p, it - n1);
      else init_rope(p, it - n2);
    }
    if (bid == 0 && tidx() < 4) p.ctr[tidx()] = 0u;
    return;
  }
  if (ph == 10) return;
  if (EN(102) && ph == 20) { for (int it = bid; it < 4096; it += nb) final_rows(p, it); return; }
  const int layer = ph > 10 ? 1 : 0;
  const int k = ph - (layer ? 11 : 1);
  GArgs g{};
  g.layer = layer; g.scale = 1.f;
  u16* outb = (u16*)p.out;
  switch (k) {
    case 0: case 7: if (EN(0)) {
      g.a0 = p.hb; g.ld0 = 1024; g.split = 1 << 30; g.ks0 = 64; g.a1 = p.hb; g.ld1 = 1024; g.W = (layer == 1 && k == 0) ? p.kn : p.wF; g.K = 1024;
      gemm_phase<0, EPI_UP, 256>(p, g, 22, smem);
      if (k == 7 && layer == 0 && fidx >= 0) for (int it = fidx; it < NCONV_FFN; it += nfill) conv_ffn(p, 1, 0, it, smem);
    } break;
    case 1: case 8: if (EN(1)) {
      g.a0 = p.regB; g.ld0 = 1408; g.split = 22; g.ks0 = 64; g.a1 = outb; g.ld1 = 1408; g.W = ((layer == 1 && k == 1) ? p.kn : p.wF) + OFF_WD; g.K = 2816; g.scale = 0.5f;
      gemm_phase<0, EPI_RES, 256>(p, g, 4, smem);
      if (layer == 0 && fidx >= 0) for (int it = fidx; it < NCONV_MIX; it += nfill) conv_mix(p, k == 1 ? 0 : 1, it, smem);
    } break;
    case 2: if (EN(2)) {
      g.a0 = p.hb; g.ld0 = 1024; g.split = 1 << 30; g.ks0 = 64; g.a1 = p.hb; g.ld1 = 1024; g.W = p.wM + OFF_IN; g.K = 1024;
      gemm_phase<0, EPI_INPROJ, 256>(p, g, 10, smem);
    } break;
    case 3: if (EN(3)) {
      const int nq = NMT * 6, nkv = NMT * 8, nsh = 522, ntot = nq + nkv + nsh;
      for (int it = bid; it < ntot; it += nb) {
        if (it < nq) {
          g.a0 = outb; g.ld0 = 512; g.split = 1 << 30; g.ks0 = 64; g.a1 = outb; g.ld1 = 512; g.W = p.wM + OFF_UQ; g.K = 256;
          gemm_phase_item<0, EPI_Q>(p, g, it, 6, smem);
        } else if (it < nq + nkv) {
          g.a0 = outb + 256; g.ld0 = 512; g.split = 1 << 30; g.ks0 = 64; g.a1 = outb; g.ld1 = 512; g.W = p.wM + OFF_UKV; g.K = 128;
          gemm_phase_item<0, EPI_KV>(p, g, it - nq, 8, smem);
        } else shift_item(p, layer, it - nq - nkv, smem);
      }
    } break;
    case 4: if (EN(4)) {
      for (int sc = bid; sc < 192; sc += nb) {
        if (sc < 64) { int x = sc >> 1; scan_block2<8>(p, layer, x >> 4, (x >> 3) & 1, x & 7, sc & 1, smem); }
        else { int x = sc - 64; scan_block2<16>(p, layer, 2 + (x >> 4), (x >> 3) & 1, x & 7, 0, smem); }
      }
      unsigned* bc = (unsigned*)(smem + SMEM_BYTES - 16);
      while (true) {
        __syncthreads();
        if (tidx() == 0) *bc = atomicAdd(p.ctr + layer, 1u);
        __syncthreads();
        const int it = (int)*bc;
        if (it >= 1104 + NCONV_FFN) break;
        if (it >= 1104) { conv_ffn(p, layer, 1, it - 1104, smem); continue; }
        int s, hd, qb;
        if (it < 528) { s = it / 264; int rem = it - s * 264; hd = rem / 33; qb = rem - hd * 33; }
        else { int x = it - 528; s = 2 + x / 72; int rem = x % 72; hd = rem / 9; qb = rem - hd * 9; }
#ifdef PROBE_ATT2
        attn_item(p, s, hd, qb, smem, p.ctr[8] == 12345u);
        __syncthreads();
#endif
        attn_item(p, s, hd, qb, smem);
      }
    } break;
    case 5: if (EN(5)) {
      g.W = p.wM + OFF_G; g.K = 192; g.a0 = p.regB + 1792; g.a1 = g.a0; g.ld0 = g.ld1 = 1952; g.split = 1 << 30; g.ks0 = 64;
      gemm_phase<0, EPI_POST, 256>(p, g, 2, smem);
    } break;
    case 6: if (EN(6)) {
      g.a0 = outb + (size_t)TP * 1024; g.ld0 = 768; g.split = 8; g.ks0 = 96; g.a1 = outb; g.ld1 = 1024; g.W = p.wM + OFF_OUT; g.K = 1024;
      gemm_phase<0, EPI_RES, 256>(p, g, 4, smem);
    } break;
  }
}

template <bool COOP>
__global__ void __launch_bounds__(NTHR) mega(Params pp, int lo, int hi) {
  extern __shared__ __attribute__((aligned(16))) char smem[];
  const __attribute__((address_space(4))) Params* kp = (const __attribute__((address_space(4))) Params*)__builtin_amdgcn_kernarg_segment_ptr();
  volatile LAS unsigned* st = (volatile LAS unsigned*)(smem + SMEM_BYTES - 32);
  if (threadIdx.x == 0) { st[0] = 0u; st[1] = 0u; }
  __syncthreads();
  XcdBarrier xb = xcd_barrier_post(kp->bar, st);
  for (int ph = lo; ph < hi; ++ph) {
    if (ph == 10) continue;
    asm volatile("" : "+s"(kp));
    run_phase(*kp, ph, smem);
    if (COOP && ph + 1 < hi) {
      if (ph == 0) cg::this_grid().sync();
      else xcd_barrier(xb);
    }
  }
}

extern "C" void kernel_launch(void* const* d_in, const int* in_sizes, int n_in, void* d_out, int out_size, void* d_ws, size_t ws_size,
                              hipStream_t stream) {
  Params p{};
  const float** pf = (const float**)&p;
  for (int i = 0; i < 30; ++i) pf[i] = (const float*)d_in[i];
  p.out = (float*)d_out;
  char* w = (char*)d_ws;
  size_t off = 0;
  auto take = [&](size_t bytes) { char* r = w + off; off += (bytes + 255) & ~(size_t)255; return r; };
  p.hb = (u16*)take((size_t)TP * 1024 * 2);
  p.regB = (u16*)take((size_t)TP * 1952 * 2);
  p.kn = (u16*)take((size_t)TP * 512 * 2);
  p.vt = (u16*)take((size_t)TP * 512 * 2);
  p.wF = (u16*)take((size_t)WF_ELEMS * 2);
  p.wM = (u16*)take((size_t)WM_ELEMS * 2);
  p.ssq = (float*)take((size_t)16 * TP * 4);
  p.ssqq = (float*)take((size_t)6 * TP * 4);
  p.bsc = (float*)take((size_t)2 * TP * 8 * 4);
  p.ropec = (float*)take((size_t)LPR * 16 * 4);
  p.ropes = (float*)take((size_t)LPR * 16 * 4);
  p.ctr = (unsigned*)take(256);
  p.bar = (unsigned*)take((size_t)XCD_BAR_WORDS * 4);
  if (off > ws_size) fprintf(stderr, "workspace too small: need %zu have %zu\n", off, ws_size);
#ifndef MULTI_LAUNCH
  static int grid_blocks = 0;
  if (!grid_blocks) {
    hipFuncSetAttribute((const void*)mega<true>, hipFuncAttributeMaxDynamicSharedMemorySize, SMEM_BYTES);
    int dev = 0, cus = 0, per_cu = 0;
    hipGetDevice(&dev);
    hipDeviceGetAttribute(&cus, hipDeviceAttributeMultiprocessorCount, dev);
    hipOccupancyMaxActiveBlocksPerMultiprocessor(&per_cu, mega<true>, NTHR, SMEM_BYTES);
    if (per_cu > 1) per_cu = 1;
    grid_blocks = cus * per_cu;
  }
  hipMemsetAsync(p.bar, 0, (size_t)XCD_BAR_WORDS * 4, stream);
  int lo = 0, hi = NPHASE;
  void* args[] = {&p, &lo, &hi};
  hipError_t e = hipLaunchCooperativeKernel((void*)mega<true>, dim3(grid_blocks), dim3(NTHR), args, SMEM_BYTES, stream);
  if (e != hipSuccess) fprintf(stderr, "cooperative launch failed: %s (grid %d)\n", hipGetErrorString(e), grid_blocks);
#else
  hipFuncSetAttribute((const void*)mega<false>, hipFuncAttributeMaxDynamicSharedMemorySize, SMEM_BYTES);
  for (int ph = 0; ph < NPHASE; ++ph) mega<false><<<256, NTHR, SMEM_BYTES, stream>>>(p, ph, ph + 1);
#endif
}
```

```cpp
#include <hip/hip_runtime.h>
#include <hip/hip_cooperative_groups.h>
#include <cstdio>
namespace cg = cooperative_groups;

typedef unsigned short u16;
typedef __attribute__((ext_vector_type(8))) short bf16x8;
typedef __attribute__((ext_vector_type(16))) float f32x16;
#define DI __device__ __forceinline__
#define MFMA(a, b, c) __builtin_amdgcn_mfma_f32_32x32x16_bf16((a), (b), (c), 0, 0, 0)

constexpr int T = 32928, TP = 33024, LPR = 8208, LSM = 2064, NMT = 129;
constexpr int NTHR = 512;
constexpr float RMS_EPS = 1e-6f, LNX_EPS = 64e-5f;
constexpr float QSCALE = 0.10206207261596575f * 1.4426950408889634f;
constexpr int OFF_IN = 0, OFF_UQ = 2621440, OFF_UKV = 2818048, OFF_DEC = 2949120, OFF_A = 3014656, OFF_G = 3080192, OFF_OUT = 3178496, WM_ELEMS = 4227072;
constexpr int OFF_WD = 5767168, WF_ELEMS = 8650752;
constexpr int SMEM_BYTES = 149504;

__constant__ double ROPE_INV[16] = {1.0, 0.5623413251903491, 0.31622776601683794, 0.1778279410038923, 0.1, 0.05623413251903491,
  0.031622776601683794, 0.01778279410038923, 0.01, 0.005623413251903491, 0.0031622776601683794, 0.001778279410038923,
  0.001, 0.0005623413251903491, 0.00031622776601683794, 0.0001778279410038923};

struct Params {
  const float *x_prompt, *x_sample, *meta, *ffn1_norm, *ffn1_wg, *ffn1_wu, *ffn1_wd, *mix_norm, *w_in, *shift_mu, *q_norm, *w_uq,
      *kv_norm, *w_ukv, *decay_w0, *decay_w2, *iclr_a0, *iclr_a2, *gate_g2, *key_k_k, *key_k_a, *bonus_r_k, *lnx_w, *lnx_b, *w_out,
      *ffn2_norm, *ffn2_wg, *ffn2_wu, *ffn2_wd, *final_norm;
  float* out;
  u16 *hb, *regB, *kn, *vt, *wF, *wM;
  float *ssq, *ssqq, *bsc, *ropec, *ropes;
  unsigned* ctr;
  unsigned* bar;
};

typedef const __attribute__((address_space(4))) Params& CP;
DI int tidx() { int t = __builtin_amdgcn_workitem_id_x(); asm volatile("" : "+v"(t)); return t; }
DI u16 f2bf(float x) { unsigned u = __float_as_uint(x); u += 0x7fffu + ((u >> 16) & 1u); return (u16)(u >> 16); }
DI float bf2f(u16 b) { return __uint_as_float(((unsigned)b) << 16); }
typedef __bf16 bf16x2_t __attribute__((ext_vector_type(2)));
typedef float fl2_t __attribute__((ext_vector_type(2)));
DI unsigned pack2(float a, float b) { fl2_t f; f.x = a; f.y = b; bf16x2_t r = __builtin_convertvector(f, bf16x2_t); return __builtin_bit_cast(unsigned, r); }
DI float bflo(unsigned u) { return __uint_as_float(u << 16); }
DI float bfhi(unsigned u) { return __uint_as_float(u & 0xffff0000u); }
DI float sigmoidf_(float x) { return __builtin_amdgcn_rcpf(1.f + __expf(-x)); }
DI int crow(int reg, int h) { return (reg & 3) + 8 * (reg >> 2) + 4 * h; }
DI void row2seq(int r, int& s, int& pos, int& L) {
  if (r < 2 * LPR) { s = r >= LPR ? 1 : 0; pos = r - s * LPR; L = LPR; }
  else { int q = (r - 2 * LPR) / LSM; s = 2 + q; pos = r - 2 * LPR - q * LSM; L = LSM; }
}
DI int seq_start(int s) { return s < 2 ? s * LPR : 2 * LPR + (s - 2) * LSM; }
DI int seq_len(int s) { return s < 2 ? LPR : LSM; }
DI float dpp_sum8(float x) {
  x += __int_as_float(__builtin_amdgcn_update_dpp(0, __float_as_int(x), 0xB1, 0xf, 0xf, false));
  x += __int_as_float(__builtin_amdgcn_update_dpp(0, __float_as_int(x), 0x4E, 0xf, 0xf, false));
  x += __int_as_float(__builtin_amdgcn_update_dpp(0, __float_as_int(x), 0x141, 0xf, 0xf, false));
  return x;
}
DI float sum16(float x) {
  x += __int_as_float(__builtin_amdgcn_update_dpp(0, __float_as_int(x), 0x128, 0xf, 0xf, false));
  x += __int_as_float(__builtin_amdgcn_update_dpp(0, __float_as_int(x), 0x124, 0xf, 0xf, false));
  x += __int_as_float(__builtin_amdgcn_update_dpp(0, __float_as_int(x), 0x122, 0xf, 0xf, false));
  x += __int_as_float(__builtin_amdgcn_update_dpp(0, __float_as_int(x), 0x121, 0xf, 0xf, false));
  return x;
}
DI float rstd16(const float* ssq, int m) {
  float s = 0.f;
#pragma unroll
  for (int c = 0; c < 16; ++c) s += ssq[(size_t)c * TP + m];
  return rsqrtf(s * (1.f / 1024.f) + RMS_EPS);
}

struct CJob { const float* src; const float* gain; u16* dst; int K, N, ld, map, nkt; };
DI int rowmap(int map, int n) {
  if (map == 1) return (n >> 5) * 64 + (n & 31);
  if (map == 2) return (n >> 5) * 64 + 32 + (n & 31);
  if (map == 3) return n < 416 ? n : n + 96;
  return n;
}
DI void conv_tile(const CJob& jb, int t, char* smem) {
  const int tid = tidx();
  const int kt = t % jb.nkt, ntile = t / jb.nkt;
  const int ny = tid >> 3, kx = tid & 7;
  const int n = ntile * 64 + ny, kb = kt * 64 + kx * 8;
  float v[8];
#pragma unroll
  for (int j = 0; j < 8; ++j) {
    const int k = kb + j, kc = min(k, jb.K - 1);
    float x = jb.src[(size_t)kc * jb.N + n];
    if (jb.gain) x *= jb.gain[kc];
    v[j] = k < jb.K ? x : 0.f;
  }
  uint4 o;
  o.x = pack2(v[0], v[1]); o.y = pack2(v[2], v[3]); o.z = pack2(v[4], v[5]); o.w = pack2(v[6], v[7]);
  *(uint4*)(jb.dst + (size_t)rowmap(jb.map, n) * jb.ld + kb) = o;
}
constexpr int NCONV_FFN = 2112, NCONV_MIX = 1032;
DI void conv_ffn(CP p, int l, int f, int t, char* smem) {
  CJob jb;
  u16* slot = (l == 1 && f == 0) ? p.kn : p.wF;
  const float* wg = f ? p.ffn2_wg : p.ffn1_wg; const float* wu = f ? p.ffn2_wu : p.ffn1_wu; const float* wd = f ? p.ffn2_wd : p.ffn1_wd;
  const float* nr = f ? p.ffn2_norm : p.ffn1_norm;
  if (t < 704) { jb = CJob{wg + (size_t)l * 1024 * 2816, nr + l * 1024, slot, 1024, 2816, 1024, 1, 16}; }
  else if (t < 1408) { t -= 704; jb = CJob{wu + (size_t)l * 1024 * 2816, nr + l * 1024, slot, 1024, 2816, 1024, 2, 16}; }
  else { t -= 1408; jb = CJob{wd + (size_t)l * 2816 * 1024, nullptr, slot + OFF_WD, 2816, 1024, 2816, 0, 44}; }
  conv_tile(jb, t, smem);
}
DI void conv_mix(CP p, int l, int t, char* smem) {
  CJob jb;
  if (t < 592) jb = CJob{p.w_in + (size_t)l * 1024 * 2368, p.mix_norm + l * 1024, p.wM + OFF_IN, 1024, 2368, 1024, 3, 16};
  else if (t < 640) { t -= 592; jb = CJob{p.w_uq + (size_t)l * 256 * 768, p.q_norm + l * 256, p.wM + OFF_UQ, 256, 768, 256, 0, 4}; }
  else if (t < 672) { t -= 640; jb = CJob{p.w_ukv + (size_t)l * 128 * 1024, p.kv_norm + l * 128, p.wM + OFF_UKV, 128, 1024, 128, 0, 2}; }
  else if (t < 688) { t -= 672; int d = t >> 3; t &= 7; jb = CJob{p.decay_w2 + (size_t)(l * 2 + d) * 64 * 512, nullptr, p.wM + OFF_DEC + d * 32768, 64, 512, 64, 0, 1}; }
  else if (t < 704) { t -= 688; int d = t >> 3; t &= 7; jb = CJob{p.iclr_a2 + (size_t)(l * 2 + d) * 64 * 512, nullptr, p.wM + OFF_A + d * 32768, 64, 512, 64, 0, 1}; }
  else if (t < 728) { t -= 704; jb = CJob{p.gate_g2 + (size_t)l * 160 * 512, nullptr, p.wM + OFF_G, 160, 512, 192, 0, 3}; }
  else if (t < 984) { t -= 728; jb = CJob{p.w_out + (size_t)l * 1024 * 1024, nullptr, p.wM + OFF_OUT, 1024, 1024, 1024, 0, 16}; }
  else {
    t -= 984;
    size_t base = (t < 24) ? (size_t)416 * 1024 + (size_t)t * 4096 : (size_t)2464 * 1024 + (size_t)(t - 24) * 4096;
    *(uint4*)(p.wM + OFF_IN + base + tidx() * 8) = make_uint4(0, 0, 0, 0);
    return;
  }
  conv_tile(jb, t, smem);
}

struct GArgs { const u16 *a0, *a1; int ld0, ld1, split, ks0; const u16* W; int K; int layer; float scale; };
enum { EPI_UP = 0, EPI_RES = 1, EPI_INPROJ = 2, EPI_Q = 3, EPI_KV = 4, EPI_POST = 5 };

DI uint4 load_gate(CP p, int layer, int m, int k) {
  uint4 z = make_uint4(0, 0, 0, 0);
  if (m >= T || k >= 160) return z;
  int s, pos, L; row2seq(m, s, pos, L);
  const u16* pb = p.regB + (size_t)m * 1952 + 1792 + k;
  uint4 c = *(const uint4*)pb;
  uint4 pm = pos > 0 ? *(const uint4*)(pb - 1952) : z;
  uint4 pp = pos + 1 < L ? *(const uint4*)(pb + 1952) : z;
  const float* mu0 = p.shift_mu + (size_t)(layer * 2 + 0) * 1952 + 1792 + k;
  const float* mu1 = p.shift_mu + (size_t)(layer * 2 + 1) * 1952 + 1792 + k;
  unsigned cc[4] = {c.x, c.y, c.z, c.w}, mm[4] = {pm.x, pm.y, pm.z, pm.w}, nn[4] = {pp.x, pp.y, pp.z, pp.w};
  unsigned o[4];
#pragma unroll
  for (int e = 0; e < 4; ++e) {
    float c0 = bflo(cc[e]), c1 = bfhi(cc[e]);
    float x0 = c0 + mu0[2 * e] * (bflo(mm[e]) - c0) + mu1[2 * e] * (bflo(nn[e]) - c0);
    float x1 = c1 + mu0[2 * e + 1] * (bfhi(mm[e]) - c1) + mu1[2 * e + 1] * (bfhi(nn[e]) - c1);
    o[e] = pack2(sigmoidf_(x0), sigmoidf_(x1));
  }
  return make_uint4(o[0], o[1], o[2], o[3]);
}

template <int MODE>
DI uint4 load_a(CP p, const GArgs& g, int row, int kt, int kc) {
  if (MODE == 1) return load_gate(p, g.layer, row, kt * 64 + kc * 8);
  const u16* ap = (kt < g.split) ? g.a0 + (size_t)row * g.ld0 + kt * g.ks0 : g.a1 + (size_t)row * g.ld1 + (kt - g.split) * 64;
  return *(const uint4*)(ap + kc * 8);
}

DI u16* halo_ptr(CP p) { return (u16*)p.out + (size_t)TP * 1024 + (size_t)TP * 768 + (size_t)TP * 32; }
DI uint4 ldg16(const u16* p) { uint4 v = *(const uint4*)p; return v; }
DI void sts16(u16* p, uint4 v) { *(uint4*)p = v; }
DI void store4(u16* dst, float a, float b, float c, float d) { *(uint2*)dst = make_uint2(pack2(a, b), pack2(c, d)); }

template <int MODE, int EPI, int BN>
DI void gemm_tile(CP p, const GArgs& g, int mt, int nt, char* smem) {
  constexpr int WN = BN / 64, WM = 8 / WN, MI = 256 / WM / 32, NWC = BN / 64;
  u16* As = (u16*)smem;
  u16* Ws = As + 2 * 256 * 72;
  const int tid = tidx(), lane = tid & 63, wv = tid >> 6, wm = wv / WN, wn = wv % WN, l32 = lane & 31, hh = lane >> 5;
  const int m0 = mt * 256, n0 = nt * BN;
  const int nk = g.K >> 6;
  f32x16 acc[MI][2];
  float rs_early = 0.f;
  if ((EPI == EPI_UP || EPI == EPI_INPROJ) && tid < 256) rs_early = rstd16(p.ssq, m0 + tid);
#pragma unroll
  for (int i = 0; i < MI; ++i)
#pragma unroll
    for (int j = 0; j < 2; ++j)
#pragma unroll
      for (int r = 0; r < 16; ++r) acc[i][j][r] = 0.f;
  uint4 ra0[4], ra1[4], rw0[4], rw1[4];
#define GLA(KT, DA, I) { const int c_ = tid + (I) * 512; DA[I] = load_a<MODE>(p, g, m0 + (c_ >> 3), (KT), c_ & 7); }
#define GLW(KT, DW, I) if ((I) < NWC) { const int c_ = tid + (I) * 512; DW[I] = ldg16(g.W + (size_t)(n0 + (c_ >> 3)) * g.K + (KT) * 64 + (c_ & 7) * 8); }
#define GLOAD(KT, DA, DW) do { GLA(KT, DA, 0) GLA(KT, DA, 1) GLA(KT, DA, 2) GLA(KT, DA, 3) GLW(KT, DW, 0) GLW(KT, DW, 1) GLW(KT, DW, 2) GLW(KT, DW, 3) } while (0)
#define LSA(BUF, DA, I) { const int c_ = tid + (I) * 512; sts16(As + ((BUF) * 256 + (c_ >> 3)) * 72 + (c_ & 7) * 8, DA[I]); }
#define LSW(BUF, DW, I) if ((I) < NWC) { const int c_ = tid + (I) * 512; sts16(Ws + ((BUF) * BN + (c_ >> 3)) * 72 + (c_ & 7) * 8, DW[I]); }
#define LSTORE(BUF, DA, DW) do { LSA(BUF, DA, 0) LSA(BUF, DA, 1) LSA(BUF, DA, 2) LSA(BUF, DA, 3) LSW(BUF, DW, 0) LSW(BUF, DW, 1) LSW(BUF, DW, 2) LSW(BUF, DW, 3) } while (0)
  auto compute = [&](int buf) {
    const u16* Ab = As + buf * 256 * 72 + (wm * (MI * 32) + l32) * 72 + hh * 8;
    const u16* Wb = Ws + buf * BN * 72 + (wn * 64 + l32) * 72 + hh * 8;
#pragma unroll
    for (int ks = 0; ks < 4; ++ks) {
      bf16x8 wf0 = *(const bf16x8*)(Wb + ks * 16);
      bf16x8 wf1 = *(const bf16x8*)(Wb + 32 * 72 + ks * 16);
#pragma unroll
      for (int i = 0; i < MI; ++i) {
        bf16x8 xf = *(const bf16x8*)(Ab + i * 32 * 72 + ks * 16);
        acc[i][0] = MFMA(wf0, xf, acc[i][0]);
        acc[i][1] = MFMA(wf1, xf, acc[i][1]);
      }
    }
  };
  if (true) {
    char* L0 = smem;
    constexpr int BUFB = (256 + BN) * 128;
    constexpr int NBUF = BN <= 128 ? 3 : 2;
    constexpr int NGL = 4 + BN / 64;
    const int gl_row = lane >> 3;
    auto issue = [&](int kt, int buf) {
      char* lb = L0 + buf * BUFB;
#pragma unroll
      for (int i = 0; i < 4; ++i) {
        const int seg = wv * 4 + i, row = seg * 8 + gl_row;
        const int c = (lane & 7) ^ ((row >> 1) & 7);
        const u16* ap = (kt < g.split) ? g.a0 + (size_t)(m0 + row) * g.ld0 + kt * g.ks0 : g.a1 + (size_t)(m0 + row) * g.ld1 + (kt - g.split) * 64;
        __builtin_amdgcn_global_load_lds((const unsigned*)(ap + c * 8), (__attribute__((address_space(3))) unsigned*)(lb + seg * 1024 + lane * 16), 16, 0, 0);
      }
#pragma unroll
      for (int i = 0; i < BN / 64; ++i) {
        const int seg = wv * (BN / 64) + i, row = seg * 8 + gl_row;
        const int c = (lane & 7) ^ ((row >> 1) & 7);
        __builtin_amdgcn_global_load_lds((const unsigned*)(g.W + (size_t)(n0 + row) * g.K + kt * 64 + c * 8),
                                         (__attribute__((address_space(3))) unsigned*)(lb + 256 * 128 + seg * 1024 + lane * 16), 16, 0, 0);
      }
    };
    auto compute2 = [&](int buf) {
      const char* lb = L0 + buf * BUFB;
#pragma unroll
      for (int ks = 0; ks < 4; ++ks) {
        const int c = ks * 2 + hh;
        bf16x8 wf[2], xf[MI];
#pragma unroll
        for (int j = 0; j < 2; ++j) { const int r = wn * 64 + j * 32 + l32; wf[j] = *(const bf16x8*)(lb + 256 * 128 + r * 128 + ((c ^ ((r >> 1) & 7)) << 4)); }
#pragma unroll
        for (int i = 0; i < MI; ++i) { const int r = wm * (MI * 32) + i * 32 + l32; xf[i] = *(const bf16x8*)(lb + r * 128 + ((c ^ ((r >> 1) & 7)) << 4)); }
#pragma unroll
        for (int i = 0; i < MI; ++i) {
          acc[i][0] = MFMA(wf[0], xf[i], acc[i][0]);
          acc[i][1] = MFMA(wf[1], xf[i], acc[i][1]);
        }
      }
    };
    if (NBUF == 3) {
      issue(0, 0);
      if (nk > 1) { issue(1, 1); if (BN == 128) asm volatile("s_waitcnt vmcnt(6)" ::: "memory"); else asm volatile("s_waitcnt vmcnt(5)" ::: "memory"); }
      else asm volatile("s_waitcnt vmcnt(0)" ::: "memory");
      asm volatile("s_waitcnt lgkmcnt(0)" ::: "memory");
      __builtin_amdgcn_s_barrier();
      int buf = 0;
      for (int kt = 0; kt < nk; ++kt) {
        const int b2 = buf == 0 ? 2 : buf - 1;
        if (kt + 2 < nk) issue(kt + 2, b2);
        compute2(buf);
        if (kt + 2 < nk) { if (BN == 128) asm volatile("s_waitcnt vmcnt(6)" ::: "memory"); else asm volatile("s_waitcnt vmcnt(5)" ::: "memory"); }
        else asm volatile("s_waitcnt vmcnt(0)" ::: "memory");
        asm volatile("s_waitcnt lgkmcnt(0)" ::: "memory");
        __builtin_amdgcn_s_barrier();
        buf = buf == 2 ? 0 : buf + 1;
      }
    } else {
      issue(0, 0);
      asm volatile("s_waitcnt vmcnt(0)" ::: "memory");
      __syncthreads();
      for (int kt = 0; kt < nk; ++kt) {
        const int buf = kt & 1;
        if (kt + 1 < nk) issue(kt + 1, buf ^ 1);
        compute2(buf);
        asm volatile("s_waitcnt vmcnt(0)" ::: "memory");
        __syncthreads();
      }
    }
    __syncthreads();
  } else {
    GLOAD(0, ra0, rw0);
    LSTORE(0, ra0, rw0);
    __syncthreads();
    for (int kt = 0; kt < nk; ++kt) {
      const int buf = kt & 1;
      if (kt + 1 < nk) GLOAD(kt + 1, ra0, rw0);
      compute(buf);
      if (kt + 1 < nk) LSTORE(buf ^ 1, ra0, rw0);
      __syncthreads();
    }
  }
#undef GLOAD
#undef LSTORE
  float* rsl = (float*)(smem + 147456);
  if (EPI == EPI_UP || EPI == EPI_INPROJ) {
    if (tid < 256) rsl[tid] = rs_early;
    __syncthreads();
  }
  const int nw = n0 + wn * 64;
#pragma unroll
  for (int i = 0; i < MI; ++i) {
    const int m = m0 + wm * (MI * 32) + i * 32 + l32;
    if (EPI == EPI_UP) {
      const float rs = rsl[m - m0];
      const int hb0 = nw >> 1;
#pragma unroll
      for (int gq = 0; gq < 4; ++gq) {
        float v[4];
#pragma unroll
        for (int r = 0; r < 4; ++r) {
          float gt = acc[i][0][4 * gq + r] * rs, up = acc[i][1][4 * gq + r] * rs;
          v[r] = gt * sigmoidf_(gt) * up;
        }
        int hid = hb0 + 8 * gq + 4 * hh;
        u16* dst = hid < 1408 ? p.regB + (size_t)m * 1408 + hid : (u16*)p.out + (size_t)m * 1408 + (hid - 1408);
        store4(dst, v[0], v[1], v[2], v[3]);
      }
    } else if (EPI == EPI_RES) {
      float ss = 0.f;
#pragma unroll
      for (int j = 0; j < 2; ++j)
#pragma unroll
        for (int gq = 0; gq < 4; ++gq) {
          u16* hp = p.hb + (size_t)m * 1024 + nw + j * 32 + 8 * gq + 4 * hh;
          uint2 old = *(const uint2*)hp;
          float h0 = bflo(old.x) + g.scale * acc[i][j][4 * gq + 0];
          float h1 = bfhi(old.x) + g.scale * acc[i][j][4 * gq + 1];
          float h2 = bflo(old.y) + g.scale * acc[i][j][4 * gq + 2];
          float h3 = bfhi(old.y) + g.scale * acc[i][j][4 * gq + 3];
          unsigned p0 = pack2(h0, h1), p1 = pack2(h2, h3);
          *(uint2*)hp = make_uint2(p0, p1);
          float r0 = bflo(p0), r1 = bfhi(p0), r2 = bflo(p1), r3 = bfhi(p1);
          ss += r0 * r0 + r1 * r1 + r2 * r2 + r3 * r3;
        }
      ss += __shfl_xor(ss, 32);
      if (hh == 0) p.ssq[(size_t)(nw >> 6) * TP + m] = ss;
    } else if (EPI == EPI_INPROJ) {
      const float rs = rsl[m - m0];
      int s, pos, L; row2seq(m < T ? m : 0, s, pos, L);
      float ss = 0.f;
#pragma unroll
      for (int j = 0; j < 2; ++j) {
        const int nb = nw + j * 32;
        if (nb == 384) {
          u16* kr = (u16*)p.out + (size_t)TP * 1024 + (size_t)TP * 768 + (size_t)m * 32;
#pragma unroll
          for (int gq = 0; gq < 2; ++gq) {
            float o1[4], o2[4];
#pragma unroll
            for (int r = 0; r < 4; ++r) {
              int ii = 8 * gq + 4 * hh + r;
              float c = p.ropec[pos * 16 + ii], sn = p.ropes[pos * 16 + ii];
              float x1 = acc[i][j][4 * gq + r] * rs, x2 = acc[i][j][4 * (gq + 2) + r] * rs;
              o1[r] = x1 * c - x2 * sn; o2[r] = x2 * c + x1 * sn;
            }
            store4(kr + 8 * gq + 4 * hh, o1[0], o1[1], o1[2], o1[3]);
            store4(kr + 16 + 8 * gq + 4 * hh, o2[0], o2[1], o2[2], o2[3]);
          }
        } else {
#pragma unroll
          for (int gq = 0; gq < 4; ++gq) {
            int n = nb + 8 * gq + 4 * hh;
            unsigned p0 = pack2(acc[i][j][4 * gq] * rs, acc[i][j][4 * gq + 1] * rs);
            unsigned p1 = pack2(acc[i][j][4 * gq + 2] * rs, acc[i][j][4 * gq + 3] * rs);
            if (n < 512) {
              *(uint2*)((u16*)p.out + (size_t)m * 512 + n) = make_uint2(p0, p1);
              float r0 = bflo(p0), r1 = bfhi(p0), r2 = bflo(p1), r3 = bfhi(p1);
              ss += r0 * r0 + r1 * r1 + r2 * r2 + r3 * r3;
            } else if (n - 512 < 1952) {
              *(uint2*)(p.regB + (size_t)m * 1952 + (n - 512)) = make_uint2(p0, p1);
              if (m < T && ((pos & 63) == 0 || (pos & 63) == 63)) {
                const int ch = (s < 2 ? s * 129 : 258 + (s - 2) * 33) + (pos >> 6);
                *(uint2*)(halo_ptr(p) + ((size_t)ch * 2 + ((pos & 63) ? 1 : 0)) * 1952 + (n - 512)) = make_uint2(p0, p1);
              }
            }
          }
        }
      }
      if (nw < 384) {
        ss += __shfl_xor(ss, 32);
        if (hh == 0) p.ssqq[(size_t)(nw >> 6) * TP + m] = ss;
      }
    } else if (EPI == EPI_Q) {
      float sq = p.ssqq[m] + p.ssqq[(size_t)TP + m] + p.ssqq[(size_t)2 * TP + m] + p.ssqq[(size_t)3 * TP + m];
      const float rs = rsqrtf(sq * (1.f / 256.f) + RMS_EPS) * QSCALE;
      int s, pos, L; row2seq(m < T ? m : 0, s, pos, L);
      u16* qrow = (u16*)p.out + (size_t)TP * 1024 + (size_t)m * 768;
#pragma unroll
      for (int j = 0; j < 2; ++j) {
        const int nb = nw + j * 32;
        if (((nb >> 5) % 3) == 2) {
#pragma unroll
          for (int gq = 0; gq < 2; ++gq) {
            float o1[4], o2[4];
#pragma unroll
            for (int r = 0; r < 4; ++r) {
              int ii = 8 * gq + 4 * hh + r;
              float c = p.ropec[pos * 16 + ii], sn = p.ropes[pos * 16 + ii];
              float x1 = acc[i][j][4 * gq + r] * rs, x2 = acc[i][j][4 * (gq + 2) + r] * rs;
              o1[r] = x1 * c - x2 * sn; o2[r] = x2 * c + x1 * sn;
            }
            store4(qrow + nb + 8 * gq + 4 * hh, o1[0], o1[1], o1[2], o1[3]);
            store4(qrow + nb + 16 + 8 * gq + 4 * hh, o2[0], o2[1], o2[2], o2[3]);
          }
        } else {
#pragma unroll
          for (int gq = 0; gq < 4; ++gq)
            store4(qrow + nb + 8 * gq + 4 * hh, acc[i][j][4 * gq] * rs, acc[i][j][4 * gq + 1] * rs, acc[i][j][4 * gq + 2] * rs, acc[i][j][4 * gq + 3] * rs);
        }
      }
    } else if (EPI == EPI_KV) {
      if (m < T) {
        float sq = p.ssqq[(size_t)4 * TP + m] + p.ssqq[(size_t)5 * TP + m];
        const float rs = rsqrtf(sq * (1.f / 128.f) + RMS_EPS);
        int s, pos, L; row2seq(m, s, pos, L);
        const int head = nw >> 7;
        const int ppos = (pos & ~15) | (pos & 3) | (((pos >> 3) & 1) << 2) | (((pos >> 2) & 1) << 3);
#pragma unroll
        for (int j = 0; j < 2; ++j) {
          const int jj = (nw & 127) + j * 32;
#pragma unroll
          for (int gq = 0; gq < 4; ++gq) {
            int c = jj + 8 * gq + 4 * hh;
            if (jj < 64) {
              store4(p.kn + (size_t)m * 512 + head * 64 + c, acc[i][j][4 * gq] * rs, acc[i][j][4 * gq + 1] * rs, acc[i][j][4 * gq + 2] * rs, acc[i][j][4 * gq + 3] * rs);
            } else {
#pragma unroll
              for (int r = 0; r < 4; ++r) {
                int dv = c - 64 + r;
                p.vt[(size_t)seq_start(s) * 512 + (size_t)(head * 64 + dv) * L + ppos] = f2bf(acc[i][j][4 * gq + r] * rs);
              }
            }
          }
        }
      }
    } else if (EPI == EPI_POST) {
      if (m < T) {
        int s, pos, L; row2seq(m, s, pos, L);
        const int hd = nw >> 6;
        u16* yb = (u16*)p.out + (size_t)m * 1024;
        float y[2][16];
        float sum = 0.f;
#pragma unroll
        for (int j = 0; j < 2; ++j)
#pragma unroll
          for (int gq = 0; gq < 4; ++gq) {
            int n = nw + j * 32 + 8 * gq + 4 * hh;
            uint2 a = *(const uint2*)(yb + n), b = *(const uint2*)(yb + 512 + n);
            y[j][4 * gq + 0] = bflo(a.x) + bflo(b.x); y[j][4 * gq + 1] = bfhi(a.x) + bfhi(b.x);
            y[j][4 * gq + 2] = bflo(a.y) + bflo(b.y); y[j][4 * gq + 3] = bfhi(a.y) + bfhi(b.y);
            sum += y[j][4 * gq] + y[j][4 * gq + 1] + y[j][4 * gq + 2] + y[j][4 * gq + 3];
          }
        sum += __shfl_xor(sum, 32);
        const float mu = sum * (1.f / 64.f);
        float vs = 0.f;
#pragma unroll
        for (int j = 0; j < 2; ++j)
#pragma unroll
          for (int r = 0; r < 16; ++r) { float dlt = y[j][r] - mu; vs += dlt * dlt; }
        vs += __shfl_xor(vs, 32);
        const float rstd = rsqrtf(vs * (1.f / 64.f) + LNX_EPS);
        const float bsum = p.bsc[(size_t)m * 8 + hd] + p.bsc[((size_t)TP + m) * 8 + hd];
        const u16* vb = p.regB + (size_t)m * 1952 + 1024;
#pragma unroll
        for (int j = 0; j < 2; ++j)
#pragma unroll
          for (int gq = 0; gq < 4; ++gq) {
            int n = nw + j * 32 + 8 * gq + 4 * hh;
            uint2 c = *(const uint2*)(vb + n);
            float cv[4] = {bflo(c.x), bfhi(c.x), bflo(c.y), bfhi(c.y)};
            float o[4];
#pragma unroll
            for (int r = 0; r < 4; ++r) {
              float vsh = cv[r];
              float yn = (y[j][4 * gq + r] - mu) * rstd * p.lnx_w[g.layer * 512 + n + r] + p.lnx_b[g.layer * 512 + n + r];
              o[r] = (yn + bsum * vsh) * acc[i][j][4 * gq + r];
            }
            store4(yb + n, o[0], o[1], o[2], o[3]);
          }
      }
    }
  }
}

template <int MODE, int EPI, int BN = 128>
DI void gemm_phase_item(CP p, const GArgs& g, int item, int NT, char* smem) {
  const int grp = item / (8 * NT);
  const int gsz = min(8, NMT - grp * 8);
  const int idx = item - grp * 8 * NT;
  gemm_tile<MODE, EPI, BN>(p, g, grp * 8 + idx % gsz, idx / gsz, smem);
}

template <int MODE, int EPI, int BN>
DI void gemm_phase(CP p, const GArgs& g, int NT, char* smem) {
  const int x = blockIdx.x & 7, j = blockIdx.x >> 3, nj = gridDim.x >> 3;
  const int total = 16 * NT;
  for (int e = j; e < total; e += nj) {
    const int grp = e / (8 * NT);
    const int rem = e - grp * 8 * NT;
    gemm_tile<MODE, EPI, BN>(p, g, x + 8 * (grp * 8 + (rem & 7)), rem >> 3, smem);
  }
  const int ntail = NT * (BN / 64);
  for (int e = (int)gridDim.x - 1 - (int)blockIdx.x; e < ntail; e += gridDim.x) gemm_tile<MODE, EPI, 64>(p, g, NMT - 1, e, smem);
}

DI void attn_item(CP p, int s, int hd, int qb, char* smem, bool dostore = true) {
  u16* Ks = (u16*)smem;
  u16* Vs = Ks + 2 * 64 * 104;
  const int tid = tidx(), lane = tid & 63, wv = tid >> 6, l32 = lane & 31, hh = lane >> 5;
  const int L = seq_len(s), r0 = seq_start(s);
  const u16* Qb = (const u16*)p.out + (size_t)TP * 1024;
  const u16* KR = Qb + (size_t)TP * 768;
  const int qpos = qb * 256 + wv * 32 + l32;
  const bool wvalid = (qb * 256 + wv * 32) < L;
  const int qrow = r0 + min(qpos, L - 1);
  bf16x8 qf[6];
#pragma unroll
  for (int ks = 0; ks < 6; ++ks) qf[ks] = *(const bf16x8*)(Qb + (size_t)qrow * 768 + hd * 96 + ks * 16 + hh * 8);
  f32x16 o[2];
#pragma unroll
  for (int u = 0; u < 2; ++u)
#pragma unroll
    for (int r = 0; r < 16; ++r) o[u][r] = 0.f;
  float mrun = -1e30f, lrun = 0.f;
  const int nt = (L + 63) >> 6;
  const u16* vtb = p.vt + (size_t)r0 * 512 + (size_t)hd * 64 * L;
  uint4 rg[3];
  auto ldc = [&](int kt, int c) -> uint4 {
    uint4 z = make_uint4(0, 0, 0, 0);
    if (c < 768) {
      int key = c / 12, cc = c - key * 12, kpos = kt * 64 + key;
      if (kpos >= L) return z;
      const u16* src = cc < 8 ? p.kn + (size_t)(r0 + kpos) * 512 + hd * 64 + cc * 8 : KR + (size_t)(r0 + kpos) * 32 + (cc - 8) * 8;
      return *(const uint4*)src;
    } else {
      int c2 = c - 768, dv = c2 >> 3, kc = c2 & 7, kp0 = kt * 64 + kc * 8;
      if (kp0 >= L) return z;
      return *(const uint4*)(vtb + (size_t)dv * L + kp0);
    }
  };
  auto stc = [&](int buf, int c, uint4 v) {
    if (c < 768) { int key = c / 12, cc = c - key * 12; *(uint4*)(Ks + (buf * 64 + key) * 104 + cc * 8) = v; }
    else { int c2 = c - 768, dv = c2 >> 3, kc = c2 & 7; *(uint4*)(Vs + (buf * 64 + dv) * 72 + kc * 8) = v; }
  };
  rg[0] = ldc(0, tid); rg[1] = ldc(0, tid + 512); if (tid < 256) rg[2] = ldc(0, tid + 1024);
  stc(0, tid, rg[0]); stc(0, tid + 512, rg[1]); if (tid < 256) stc(0, tid + 1024, rg[2]);
  __syncthreads();
  for (int kt = 0; kt < nt; ++kt) {
    const int buf = kt & 1;
    if (kt + 1 < nt) { rg[0] = ldc(kt + 1, tid); rg[1] = ldc(kt + 1, tid + 512); if (tid < 256) rg[2] = ldc(kt + 1, tid + 1024); }
    if (wvalid) {
      f32x16 st[2];
#pragma unroll
      for (int t = 0; t < 2; ++t) {
#pragma unroll
        for (int r = 0; r < 16; ++r) st[t][r] = 0.f;
        const u16* kb = Ks + (buf * 64 + t * 32 + l32) * 104 + hh * 8;
#pragma unroll
        for (int ks = 0; ks < 6; ++ks) st[t] = MFMA(*(const bf16x8*)(kb + ks * 16), qf[ks], st[t]);
      }
      if (kt == nt - 1) {
#pragma unroll
        for (int t = 0; t < 2; ++t)
#pragma unroll
          for (int r = 0; r < 16; ++r) if (kt * 64 + t * 32 + crow(r, hh) >= L) st[t][r] = -1e30f;
      }
      float mx = -1e30f;
#pragma unroll
      for (int t = 0; t < 2; ++t)
#pragma unroll
        for (int r = 0; r < 16; ++r) mx = fmaxf(mx, st[t][r]);
      mx = fmaxf(mx, __shfl_xor(mx, 32));
      const float mnew = fmaxf(mrun, mx);
      const float alpha = __builtin_amdgcn_exp2f(mrun - mnew);
      float ls = 0.f;
#pragma unroll
      for (int t = 0; t < 2; ++t)
#pragma unroll
        for (int r = 0; r < 16; ++r) { float pv = __builtin_amdgcn_exp2f(st[t][r] - mnew); st[t][r] = pv; ls += pv; }
      lrun = lrun * alpha + ls; mrun = mnew;
#pragma unroll
      for (int u = 0; u < 2; ++u)
#pragma unroll
        for (int r = 0; r < 16; ++r) o[u][r] *= alpha;
#pragma unroll
      for (int t = 0; t < 2; ++t)
#pragma unroll
        for (int s2 = 0; s2 < 2; ++s2) {
          uint4 pk;
          pk.x = pack2(st[t][8 * s2 + 0], st[t][8 * s2 + 1]); pk.y = pack2(st[t][8 * s2 + 2], st[t][8 * s2 + 3]);
          pk.z = pack2(st[t][8 * s2 + 4], st[t][8 * s2 + 5]); pk.w = pack2(st[t][8 * s2 + 6], st[t][8 * s2 + 7]);
          bf16x8 pf = __builtin_bit_cast(bf16x8, pk);
#pragma unroll
          for (int u = 0; u < 2; ++u) {
            bf16x8 vf = *(const bf16x8*)(Vs + (buf * 64 + u * 32 + l32) * 72 + t * 32 + s2 * 16 + hh * 8);
            o[u] = MFMA(vf, pf, o[u]);
          }
        }
    }
    if (kt + 1 < nt) { stc(buf ^ 1, tid, rg[0]); stc(buf ^ 1, tid + 512, rg[1]); if (tid < 256) stc(buf ^ 1, tid + 1024, rg[2]); }
    __syncthreads();
  }
  if (wvalid) {
    float lt = lrun + __shfl_xor(lrun, 32);
    const float inv = 1.f / lt;
    if (qpos < L && dostore) {
      u16* dst = (u16*)p.out + (size_t)TP * 1024 + (size_t)(r0 + qpos) * 768 + hd * 96;
#pragma unroll
      for (int u = 0; u < 2; ++u)
#pragma unroll
        for (int gq = 0; gq < 4; ++gq)
          store4(dst + u * 32 + 8 * gq + 4 * hh, o[u][4 * gq] * inv, o[u][4 * gq + 1] * inv, o[u][4 * gq + 2] * inv, o[u][4 * gq + 3] * inv);
    }
  }
}

DI void scan_block(CP p, int layer, int s, int d, int hd, char* smem) {
  float* OP = (float*)smem;
  float* WA = OP + 32 * 392;
  float* YB = WA + 2 * 32 * 64;
  u16* XL = (u16*)(YB + 32 * 64);
  float* MU = (float*)(XL + 2 * 32 * 72);
  float* CS = MU + 5 * 2 * 64;
  const int tid = tidx(), lane = tid & 63, wv = tid >> 6, l32 = lane & 31, hh = lane >> 5;
  const int L = seq_len(s), r0 = seq_start(s);
  const int sj = tid >> 4, q = tid & 15;
  const int rloc = lane >> 3, cg8 = lane & 7, row = wv * 8 + rloc;
  const int aoff[5] = {hd * 64, 512 + hd * 64, 1024 + hd * 64, 1536 + d * 64, 1664 + d * 64};
  __syncthreads();
  for (int i = tid; i < 640; i += NTHR) {
    int a = i >> 7, w = (i >> 6) & 1, c = i & 63;
    int off = a == 0 ? aoff[0] : a == 1 ? aoff[1] : a == 2 ? aoff[2] : a == 3 ? aoff[3] : aoff[4];
    MU[i] = p.shift_mu[(size_t)(layer * 2 + w) * 1952 + off + c];
  }
  if (tid < 64) {
    CS[tid] = p.key_k_k[layer * 512 + hd * 64 + tid];
    CS[64 + tid] = p.key_k_a[layer * 512 + hd * 64 + tid];
    CS[128 + tid] = p.bonus_r_k[layer * 512 + hd * 64 + tid];
  }
  const int mat = (wv >> 1) & 1, ntile = wv & 1;
  bf16x8 wfr[4];
  {
    const u16* wb = p.wM + (mat ? OFF_A : OFF_DEC) + (size_t)(d * 512 + hd * 64 + ntile * 32 + l32) * 64 + hh * 8;
#pragma unroll
    for (int ks = 0; ks < 4; ++ks) wfr[ks] = *(const bf16x8*)(wb + ks * 16);
  }
  const float bias = mat ? p.iclr_a0[(size_t)(layer * 2 + d) * 512 + hd * 64 + ntile * 32 + l32]
                         : p.decay_w0[(size_t)(layer * 2 + d) * 512 + hd * 64 + ntile * 32 + l32];
  __syncthreads();
  float S[8];
#pragma unroll
  for (int i = 0; i < 8; ++i) S[i] = 0.f;
  const int nch = (L + 31) >> 5;
  uint2 raw[15];
  float r4[4], k4[4], kk4[4], v4[4];

  auto prefetch = [&](int c) {
    const int sidx = c * 32 + sj;
    const bool valid = sidx < L;
    const int tok = d == 0 ? sidx : L - 1 - sidx;
    const u16* base = p.regB + (size_t)(r0 + tok) * 1952 + 4 * q;
#pragma unroll
    for (int a = 0; a < 5; ++a) {
      const int off = a == 0 ? aoff[0] : a == 1 ? aoff[1] : a == 2 ? aoff[2] : a == 3 ? aoff[3] : aoff[4];
      raw[a * 3 + 0] = (valid && tok > 0) ? *(const uint2*)(base - 1952 + off) : make_uint2(0, 0);
      raw[a * 3 + 1] = valid ? *(const uint2*)(base + off) : make_uint2(0, 0);
      raw[a * 3 + 2] = (valid && tok + 1 < L) ? *(const uint2*)(base + 1952 + off) : make_uint2(0, 0);
    }
  };
  auto shift4 = [&](int a, float* x) {
    const float4 m0 = *(const float4*)(MU + (a * 2 + 0) * 64 + 4 * q);
    const float4 m1 = *(const float4*)(MU + (a * 2 + 1) * 64 + 4 * q);
    const uint2 pm = raw[a * 3], c = raw[a * 3 + 1], pp = raw[a * 3 + 2];
    float c0 = bflo(c.x), c1 = bfhi(c.x), c2 = bflo(c.y), c3 = bfhi(c.y);
    x[0] = c0 + m0.x * (bflo(pm.x) - c0) + m1.x * (bflo(pp.x) - c0);
    x[1] = c1 + m0.y * (bfhi(pm.x) - c1) + m1.y * (bfhi(pp.x) - c1);
    x[2] = c2 + m0.z * (bflo(pm.y) - c2) + m1.z * (bflo(pp.y) - c2);
    x[3] = c3 + m0.w * (bfhi(pm.y) - c3) + m1.w * (bfhi(pp.y) - c3);
  };
  auto stage = [&](int c) {
    shift4(0, r4); shift4(1, k4); shift4(2, v4);
    float xw[4], xa[4];
    shift4(3, xw); shift4(4, xa);
#pragma unroll
    for (int e = 0; e < 4; ++e) xw[e] = 1.f - 2.f / (__expf(2.f * xw[e]) + 1.f);
    store4(XL + sj * 72 + 4 * q, xw[0], xw[1], xw[2], xw[3]);
    store4(XL + 32 * 72 + sj * 72 + 4 * q, xa[0], xa[1], xa[2], xa[3]);
    {
      const float4 kkw = *(const float4*)(CS + 4 * q);
      float x0 = k4[0] * kkw.x, x1 = k4[1] * kkw.y, x2 = k4[2] * kkw.z, x3 = k4[3] * kkw.w;
      float ss = sum16(x0 * x0 + x1 * x1 + x2 * x2 + x3 * x3);
      float inv = 1.f / fmaxf(sqrtf(ss), 1e-12f);
      kk4[0] = x0 * inv; kk4[1] = x1 * inv; kk4[2] = x2 * inv; kk4[3] = x3 * inv;
    }
    __syncthreads();
    if (wv < 4) {
      f32x16 acc;
#pragma unroll
      for (int r = 0; r < 16; ++r) acc[r] = 0.f;
      const u16* xb = XL + mat * 32 * 72 + l32 * 72 + hh * 8;
#pragma unroll
      for (int ks = 0; ks < 4; ++ks) acc = MFMA(*(const bf16x8*)(xb + ks * 16), wfr[ks], acc);
#pragma unroll
      for (int r = 0; r < 16; ++r) {
        float x = acc[r] + bias;
        float sg = sigmoidf_(x);
        float val = mat ? sg : __expf(-0.6065306597126334f * sg);
        WA[(mat * 32 + crow(r, hh)) * 64 + ntile * 32 + l32] = val;
      }
    }
    __syncthreads();
    {
      const float4 w4 = *(const float4*)(WA + sj * 64 + 4 * q);
      const float4 a4 = *(const float4*)(WA + (32 + sj) * 64 + 4 * q);
      const float4 ka = *(const float4*)(CS + 64 + 4 * q);
      const float4 brk = *(const float4*)(CS + 128 + 4 * q);
      const float wv4[4] = {w4.x, w4.y, w4.z, w4.w}, av4[4] = {a4.x, a4.y, a4.z, a4.w};
      const float kav[4] = {ka.x, ka.y, ka.z, ka.w}, bkv[4] = {brk.x, brk.y, brk.z, brk.w};
      float aa[4], wr[4], bb[4], kd[4];
      float br = 0.f, kr = 0.f, bs = 0.f;
#pragma unroll
      for (int e = 0; e < 4; ++e) {
        aa[e] = -kk4[e]; wr[e] = wv4[e] * r4[e]; bb[e] = kk4[e] * av4[e];
        kd[e] = k4[e] * (1.f + (av4[e] - 1.f) * kav[e]);
        br += bb[e] * r4[e]; kr += kd[e] * r4[e]; bs += r4[e] * kd[e] * bkv[e];
      }
      br = sum16(br); kr = sum16(kr); bs = sum16(bs);
      float* o = OP + sj * 392 + 4 * q;
      *(float4*)(o) = make_float4(aa[0], aa[1], aa[2], aa[3]);
      *(float4*)(o + 64) = make_float4(wr[0], wr[1], wr[2], wr[3]);
      *(float4*)(o + 128) = w4;
      *(float4*)(o + 192) = make_float4(bb[0], bb[1], bb[2], bb[3]);
      *(float4*)(o + 256) = make_float4(kd[0], kd[1], kd[2], kd[3]);
      *(float4*)(o + 320) = make_float4(v4[0], v4[1], v4[2], v4[3]);
      if (q == 0) {
        OP[sj * 392 + 384] = br; OP[sj * 392 + 385] = kr;
        const int sidx = c * 32 + sj;
        if (sidx < L) { const int tok = d == 0 ? sidx : L - 1 - sidx; p.bsc[((size_t)d * TP + r0 + tok) * 8 + hd] = bs; }
      }
    }
    __syncthreads();
  };

  prefetch(0);
  stage(0);
  for (int c = 0; c < nch; ++c) {
    if (c + 1 < nch) prefetch(c + 1);
    const int nst = min(32, L - c * 32);
    for (int jj = 0; jj < nst; ++jj) {
      const float* o = OP + jj * 392;
      const float4 a0 = *(const float4*)(o + cg8 * 8), a1 = *(const float4*)(o + cg8 * 8 + 4);
      const float4 y0 = *(const float4*)(o + 64 + cg8 * 8), y1 = *(const float4*)(o + 64 + cg8 * 8 + 4);
      const float4 w0 = *(const float4*)(o + 128 + cg8 * 8), w1 = *(const float4*)(o + 128 + cg8 * 8 + 4);
      const float4 b0 = *(const float4*)(o + 192 + cg8 * 8), b1 = *(const float4*)(o + 192 + cg8 * 8 + 4);
      const float4 k0 = *(const float4*)(o + 256 + cg8 * 8), k1 = *(const float4*)(o + 256 + cg8 * 8 + 4);
      const float vv = o[320 + row];
      const float2 sc = *(const float2*)(o + 384);
      float da = S[0] * a0.x + S[1] * a0.y + S[2] * a0.z + S[3] * a0.w + S[4] * a1.x + S[5] * a1.y + S[6] * a1.z + S[7] * a1.w;
      float dy = S[0] * y0.x + S[1] * y0.y + S[2] * y0.z + S[3] * y0.w + S[4] * y1.x + S[5] * y1.y + S[6] * y1.z + S[7] * y1.w;
      da = dpp_sum8(da); dy = dpp_sum8(dy);
      const float yv = dy + da * sc.x + vv * sc.y;
      S[0] = S[0] * w0.x + da * b0.x + vv * k0.x; S[1] = S[1] * w0.y + da * b0.y + vv * k0.y;
      S[2] = S[2] * w0.z + da * b0.z + vv * k0.z; S[3] = S[3] * w0.w + da * b0.w + vv * k0.w;
      S[4] = S[4] * w1.x + da * b1.x + vv * k1.x; S[5] = S[5] * w1.y + da * b1.y + vv * k1.y;
      S[6] = S[6] * w1.z + da * b1.z + vv * k1.z; S[7] = S[7] * w1.w + da * b1.w + vv * k1.w;
      if (cg8 == 0) YB[jj * 64 + row] = yv;
    }
    __syncthreads();
    {
      const int sidx = c * 32 + sj;
      if (sidx < L) {
        const int tok = d == 0 ? sidx : L - 1 - sidx;
        const float4 yv = *(const float4*)(YB + sj * 64 + 4 * q);
        store4((u16*)p.out + (size_t)(r0 + tok) * 1024 + d * 512 + hd * 64 + 4 * q, yv.x, yv.y, yv.z, yv.w);
      }
    }
    if (c + 1 < nch) stage(c + 1);
  }
  __syncthreads();
}

typedef float f2 __attribute__((ext_vector_type(2)));
DI f2 mk2(float a, float b) { f2 r; r.x = a; r.y = b; return r; }
#define LDS_FENCE() asm volatile("s_waitcnt lgkmcnt(0)" ::: "memory")

template <int CPL>
DI void scan_block2(CP p, int layer, int s, int d, int hd, int rowhalf, char* smem) {
  float* OP = (float*)smem;
  float* YB = OP + 2 * 32 * 392;
  u16* XL = (u16*)(YB + 2 * 32 * 64);
  float* MU = (float*)(XL + 2 * 32 * 72);
  float* CS = MU + 640;
  u16* WL = (u16*)(CS + 192);
  const int tid = tidx(), lane = tid & 63, wv = tid >> 6, l32 = lane & 31, hh = lane >> 5;
  const int L = seq_len(s), r0 = seq_start(s);
  const int aoff0 = hd * 64, aoff1 = 512 + hd * 64, aoff2 = 1024 + hd * 64, aoff3 = 1536 + d * 64, aoff4 = 1664 + d * 64;
  __syncthreads();
  for (int i = tid; i < 640; i += NTHR) {
    int a = i >> 7, w = (i >> 6) & 1, c = i & 63;
    int off = a == 0 ? aoff0 : a == 1 ? aoff1 : a == 2 ? aoff2 : a == 3 ? aoff3 : aoff4;
    MU[i] = p.shift_mu[(size_t)(layer * 2 + w) * 1952 + off + c];
  }
#pragma unroll
  for (int i = 0; i < 2; ++i) {
    const int idx = tid + i * NTHR, mat = idx >> 9, col = (idx >> 3) & 63, kc = idx & 7;
    *(uint4*)(WL + (mat * 64 + col) * 72 + kc * 8) = *(const uint4*)(p.wM + (mat ? OFF_A : OFF_DEC) + (size_t)(d * 512 + hd * 64 + col) * 64 + kc * 8);
  }
  if (tid < 64) {
    CS[tid] = p.key_k_k[layer * 512 + hd * 64 + tid];
    CS[64 + tid] = p.key_k_a[layer * 512 + hd * 64 + tid];
    CS[128 + tid] = p.bonus_r_k[layer * 512 + hd * 64 + tid];
  }
  __syncthreads();
  const int nch = (L + 31) >> 5;

  if (wv >= 4) {
    const int sw = wv - 4;
    const int q = lane & 15;
    float bias[2][2];
#pragma unroll
    for (int mat = 0; mat < 2; ++mat)
#pragma unroll
      for (int nt2 = 0; nt2 < 2; ++nt2)
        bias[mat][nt2] = mat ? p.iclr_a0[(size_t)(layer * 2 + d) * 512 + hd * 64 + nt2 * 32 + l32]
                             : p.decay_w0[(size_t)(layer * 2 + d) * 512 + hd * 64 + nt2 * 32 + l32];
    uint2 raw[2][5];
    auto load_raw = [&](int c) {
#pragma unroll
      for (int u = 0; u < 2; ++u) {
        const int sj = 8 * sw + 4 * u + (lane >> 4);
        const int sidc = min(c * 32 + sj, L - 1);
        const int tok = d == 0 ? sidc : L - 1 - sidc;
        const u16* base = p.regB + (size_t)(r0 + tok) * 1952 + 4 * q;
        raw[u][0] = *(const uint2*)(base + aoff0); raw[u][1] = *(const uint2*)(base + aoff1); raw[u][2] = *(const uint2*)(base + aoff2);
        raw[u][3] = *(const uint2*)(base + aoff3); raw[u][4] = *(const uint2*)(base + aoff4);
      }
    };
    auto stage = [&](int c) {
      float r4[2][4], k4[2][4], kk4[2][4], v4[2][4];
#pragma unroll
      for (int u = 0; u < 2; ++u) {
        const int sj = 8 * sw + 4 * u + (lane >> 4);
        r4[u][0] = bflo(raw[u][0].x); r4[u][1] = bfhi(raw[u][0].x); r4[u][2] = bflo(raw[u][0].y); r4[u][3] = bfhi(raw[u][0].y);
        k4[u][0] = bflo(raw[u][1].x); k4[u][1] = bfhi(raw[u][1].x); k4[u][2] = bflo(raw[u][1].y); k4[u][3] = bfhi(raw[u][1].y);
        v4[u][0] = bflo(raw[u][2].x); v4[u][1] = bfhi(raw[u][2].x); v4[u][2] = bflo(raw[u][2].y); v4[u][3] = bfhi(raw[u][2].y);
        *(uint2*)(XL + sj * 72 + 4 * q) = raw[u][3];
        *(uint2*)(XL + 32 * 72 + sj * 72 + 4 * q) = raw[u][4];
        const float4 kkw = *(const float4*)(CS + 4 * q);
        float x0 = k4[u][0] * kkw.x, x1 = k4[u][1] * kkw.y, x2 = k4[u][2] * kkw.z, x3 = k4[u][3] * kkw.w;
        float ss = sum16(x0 * x0 + x1 * x1 + x2 * x2 + x3 * x3);
        float inv = __builtin_amdgcn_rsqf(fmaxf(ss, 1e-24f));
        kk4[u][0] = x0 * inv; kk4[u][1] = x1 * inv; kk4[u][2] = x2 * inv; kk4[u][3] = x3 * inv;
      }
      LDS_FENCE();
      float* OPn = OP + (c & 1) * 32 * 392;
#pragma unroll
      for (int mat = 0; mat < 2; ++mat)
#pragma unroll
        for (int nt2 = 0; nt2 < 2; ++nt2) {
          f32x16 acc;
#pragma unroll
          for (int r = 0; r < 16; ++r) acc[r] = 0.f;
          const u16* xb = XL + mat * 32 * 72 + (8 * sw + (l32 & 7)) * 72 + hh * 8;
#pragma unroll
          for (int ks = 0; ks < 4; ++ks) acc = MFMA(*(const bf16x8*)(xb + ks * 16), *(const bf16x8*)(WL + (mat * 64 + nt2 * 32 + l32) * 72 + ks * 16 + hh * 8), acc);
#pragma unroll
          for (int r = 0; r < 4; ++r) {
            float x = acc[r] + bias[mat][nt2];
            float sg = sigmoidf_(x);
            float val = mat ? sg : __expf(-0.6065306597126334f * sg);
            OPn[(8 * sw + 4 * hh + r) * 392 + (mat ? 0 : 128) + nt2 * 32 + l32] = val;
          }
        }
      LDS_FENCE();
#pragma unroll
      for (int u = 0; u < 2; ++u) {
        const int sj = 8 * sw + 4 * u + (lane >> 4);
        const float4 w4 = *(const float4*)(OPn + sj * 392 + 128 + 4 * q);
        const float4 a4 = *(const float4*)(OPn + sj * 392 + 4 * q);
        const float4 ka = *(const float4*)(CS + 64 + 4 * q);
        const float4 brk = *(const float4*)(CS + 128 + 4 * q);
        const float wv4[4] = {w4.x, w4.y, w4.z, w4.w}, av4[4] = {a4.x, a4.y, a4.z, a4.w};
        const float kav[4] = {ka.x, ka.y, ka.z, ka.w}, bkv[4] = {brk.x, brk.y, brk.z, brk.w};
        float aa[4], wr[4], bb[4], kd[4];
        float br = 0.f, kr = 0.f, bs = 0.f;
#pragma unroll
        for (int e = 0; e < 4; ++e) {
          aa[e] = -kk4[u][e]; wr[e] = wv4[e] * r4[u][e]; bb[e] = kk4[u][e] * av4[e];
          kd[e] = k4[u][e] * (1.f + (av4[e] - 1.f) * kav[e]);
          br += bb[e] * r4[u][e]; kr += kd[e] * r4[u][e]; bs += r4[u][e] * kd[e] * bkv[e];
        }
        br = sum16(br); kr = sum16(kr); bs = sum16(bs);
        float* o = OPn + sj * 392 + 4 * q;
        *(float4*)(o) = make_float4(aa[0], aa[1], aa[2], aa[3]);
        *(float4*)(o + 64) = make_float4(wr[0], wr[1], wr[2], wr[3]);
        *(float4*)(o + 128) = w4;
        *(float4*)(o + 192) = make_float4(bb[0], bb[1], bb[2], bb[3]);
        *(float4*)(o + 256) = make_float4(kd[0], kd[1], kd[2], kd[3]);
        *(float4*)(o + 320) = make_float4(v4[u][0], v4[u][1], v4[u][2], v4[u][3]);
        if (q == 0) {
          OPn[sj * 392 + 384] = br; OPn[sj * 392 + 385] = kr;
          const int sidx = c * 32 + sj;
          if (sidx < L && rowhalf == 0) { const int tok = d == 0 ? sidx : L - 1 - sidx; p.bsc[((size_t)d * TP + r0 + tok) * 8 + hd] = bs; }
        }
      }
    };
    auto writeout = [&](int c) {
      const float* yb = YB + (c & 1) * 2048;
#pragma unroll
      for (int u = 0; u < 2; ++u) {
        const int sj = 8 * sw + 4 * u + (lane >> 4);
        const int sidx = c * 32 + sj;
        const bool mine = CPL == 16 ? true : ((q >> 3) == rowhalf);
        if (sidx < L && mine) {
          const int tok = d == 0 ? sidx : L - 1 - sidx;
          const float4 yv = *(const float4*)(yb + sj * 64 + 4 * q);
          store4((u16*)p.out + (size_t)(r0 + tok) * 1024 + d * 512 + hd * 64 + 4 * q, yv.x, yv.y, yv.z, yv.w);
        }
      }
    };
    load_raw(0);
    stage(0);
    if (nch > 1) load_raw(1);
    __syncthreads();
    for (int c = 0; c < nch; ++c) {
      if (c + 1 < nch) { stage(c + 1); if (c + 2 < nch) load_raw(c + 2); }
      if (c >= 1) writeout(c - 1);
      __syncthreads();
    }
    writeout(nch - 1);
  } else {
    constexpr int LPRW = 64 / CPL;
    constexpr int NV = CPL / 2;
    const int cg = lane % LPRW;
    const int row = (CPL == 8 ? rowhalf * 32 + wv * 8 : wv * 16) + lane / LPRW;
    f2 S[NV];
#pragma unroll
    for (int i = 0; i < NV; ++i) S[i] = mk2(0.f, 0.f);
    __builtin_amdgcn_s_setprio(3);
    __syncthreads();
    for (int c = 0; c < nch; ++c) {
      const int nst = min(32, L - c * 32);
      const float* ob = OP + (c & 1) * 32 * 392;
      float* yb = YB + (c & 1) * 2048;
      float* ydst = cg == 0 ? yb + row : (float*)(smem + 147712) + lane;
      const int ystride = cg == 0 ? 64 : 0;
      float4 ca[CPL / 4], cy[CPL / 4], cw[CPL / 4], cb[CPL / 4], ck[CPL / 4];
      float cvv; float2 csc;
      {
        const float* o = ob + cg * CPL;
#pragma unroll
        for (int i = 0; i < CPL / 4; ++i) {
          ca[i] = *(const float4*)(o + 4 * i); cy[i] = *(const float4*)(o + 64 + 4 * i); cw[i] = *(const float4*)(o + 128 + 4 * i);
          cb[i] = *(const float4*)(o + 192 + 4 * i); ck[i] = *(const float4*)(o + 256 + 4 * i);
        }
        cvv = ob[320 + row]; csc = *(const float2*)(ob + 384);
      }
#pragma unroll 4
      for (int jj = 0; jj < nst; ++jj) {
        float4 na[CPL / 4], ny[CPL / 4], nw[CPL / 4], nb[CPL / 4], nk[CPL / 4];
        float nvv; float2 nsc;
        {
          const int jn = jj + 1;
          const float* o = ob + jn * 392 + cg * CPL;
#pragma unroll
          for (int i = 0; i < CPL / 4; ++i) {
            na[i] = *(const float4*)(o + 4 * i); ny[i] = *(const float4*)(o + 64 + 4 * i); nw[i] = *(const float4*)(o + 128 + 4 * i);
            nb[i] = *(const float4*)(o + 192 + 4 * i); nk[i] = *(const float4*)(o + 256 + 4 * i);
          }
          nvv = ob[jn * 392 + 320 + row]; nsc = *(const float2*)(ob + jn * 392 + 384);
        }
        f2 A[NV], Y[NV], W[NV], B[NV], K[NV];
#pragma unroll
        for (int i = 0; i < CPL / 4; ++i) {
          A[2 * i] = mk2(ca[i].x, ca[i].y); A[2 * i + 1] = mk2(ca[i].z, ca[i].w);
          Y[2 * i] = mk2(cy[i].x, cy[i].y); Y[2 * i + 1] = mk2(cy[i].z, cy[i].w);
          W[2 * i] = mk2(cw[i].x, cw[i].y); W[2 * i + 1] = mk2(cw[i].z, cw[i].w);
          B[2 * i] = mk2(cb[i].x, cb[i].y); B[2 * i + 1] = mk2(cb[i].z, cb[i].w);
          K[2 * i] = mk2(ck[i].x, ck[i].y); K[2 * i + 1] = mk2(ck[i].z, ck[i].w);
        }
        const float vv = cvv;
        f2 pa0 = S[0] * A[0], pa1 = S[1] * A[1], py0 = S[0] * Y[0], py1 = S[1] * Y[1];
#pragma unroll
        for (int i = 2; i < NV; i += 2) {
          pa0 = S[i] * A[i] + pa0; pa1 = S[i + 1] * A[i + 1] + pa1;
          py0 = S[i] * Y[i] + py0; py1 = S[i + 1] * Y[i + 1] + py1;
        }
        pa0 = pa0 + pa1; py0 = py0 + py1;
        float da = pa0.x + pa0.y, dy = py0.x + py0.y;
        const f2 vvv = mk2(vv, vv);
        f2 SW[NV];
#pragma unroll
        for (int i = 0; i < NV; ++i) SW[i] = S[i] * W[i] + vvv * K[i];
        da += __int_as_float(__builtin_amdgcn_update_dpp(0, __float_as_int(da), 0xB1, 0xf, 0xf, false));
        dy += __int_as_float(__builtin_amdgcn_update_dpp(0, __float_as_int(dy), 0xB1, 0xf, 0xf, false));
        da += __int_as_float(__builtin_amdgcn_update_dpp(0, __float_as_int(da), 0x4E, 0xf, 0xf, false));
        dy += __int_as_float(__builtin_amdgcn_update_dpp(0, __float_as_int(dy), 0x4E, 0xf, 0xf, false));
        if (CPL == 8) {
          da += __int_as_float(__builtin_amdgcn_update_dpp(0, __float_as_int(da), 0x141, 0xf, 0xf, false));
          dy += __int_as_float(__builtin_amdgcn_update_dpp(0, __float_as_int(dy), 0x141, 0xf, 0xf, false));
        }
        const f2 dav = mk2(da, da);
#pragma unroll
        for (int i = 0; i < NV; ++i) S[i] = dav * B[i] + SW[i];
        const float yv = dy + da * csc.x + vv * csc.y;
        ydst[jj * ystride] = yv;
#pragma unroll
        for (int i = 0; i < CPL / 4; ++i) { ca[i] = na[i]; cy[i] = ny[i]; cw[i] = nw[i]; cb[i] = nb[i]; ck[i] = nk[i]; }
        cvv = nvv; csc = nsc;
      }
      __syncthreads();
    }
    __builtin_amdgcn_s_setprio(0);
  }
  __syncthreads();
}

DI void shift_item(CP p, int layer, int ch, char* smem) {
  const int tid = tidx();
  int s, c;
  if (ch < 258) { s = ch / 129; c = ch - s * 129; } else { int x = ch - 258; s = 2 + x / 33; c = x - (s - 2) * 33; }
  const int L = seq_len(s), r0 = seq_start(s) + c * 64;
  const int nrows = min(64, L - c * 64);
  const int cgp = tid & 255, rg = tid >> 8;
  const int col = cgp * 8;
  const int rlo = rg * 32, rhi = min(rlo + 32, nrows);
  const bool act = cgp < 244 && rlo < nrows;
  typedef unsigned u32x4 __attribute__((ext_vector_type(4)));
  u32x4 prev = {0u, 0u, 0u, 0u}, cur = prev, lastn = prev;
  float mu0[8], mu1[8];
  u16* base = p.regB + (size_t)r0 * 1952 + col;
  if (act) {
#pragma unroll
    for (int e = 0; e < 8; ++e) { mu0[e] = p.shift_mu[(size_t)(layer * 2) * 1952 + col + e]; mu1[e] = p.shift_mu[(size_t)(layer * 2 + 1) * 1952 + col + e]; }
    if (rlo > 0) prev = *(const u32x4*)(base + (size_t)(rlo - 1) * 1952);
    else if (c > 0) prev = *(const u32x4*)(halo_ptr(p) + ((size_t)(ch - 1) * 2 + 1) * 1952 + col);
    cur = *(const u32x4*)(base + (size_t)rlo * 1952);
    if (rhi < nrows) lastn = *(const u32x4*)(base + (size_t)rhi * 1952);
    else if (c * 64 + nrows < L) lastn = *(const u32x4*)(halo_ptr(p) + ((size_t)(ch + 1) * 2) * 1952 + col);
  }
  __syncthreads();
  if (act) {
    const int kind = col < 1536 ? 0 : col < 1664 ? 1 : col < 1792 ? 0 : 2;
    for (int rb = rlo; rb < rhi; rb += 8) {
      u32x4 rw[9];
      rw[0] = cur;
#pragma unroll
      for (int i = 1; i < 9; ++i) { const int r = rb + i; rw[i] = (r < rhi) ? *(const u32x4*)(base + (size_t)r * 1952) : lastn; }
#pragma unroll
      for (int i = 0; i < 8; ++i) {
        const u32x4 cc = rw[i], nn = rw[i + 1];
        const unsigned pc[4] = {cc.x, cc.y, cc.z, cc.w}, pm[4] = {prev.x, prev.y, prev.z, prev.w}, pn[4] = {nn.x, nn.y, nn.z, nn.w};
        unsigned o[4];
#pragma unroll
        for (int e = 0; e < 4; ++e) {
          float c0 = bflo(pc[e]), c1 = bfhi(pc[e]);
          float x0 = c0 + mu0[2 * e] * (bflo(pm[e]) - c0) + mu1[2 * e] * (bflo(pn[e]) - c0);
          float x1 = c1 + mu0[2 * e + 1] * (bfhi(pm[e]) - c1) + mu1[2 * e + 1] * (bfhi(pn[e]) - c1);
          if (kind == 1) { x0 = 1.f - 2.f * __builtin_amdgcn_rcpf(__expf(2.f * x0) + 1.f); x1 = 1.f - 2.f * __builtin_amdgcn_rcpf(__expf(2.f * x1) + 1.f); }
          else if (kind == 2) { x0 = sigmoidf_(x0); x1 = sigmoidf_(x1); }
          o[e] = pack2(x0, x1);
        }
        { u32x4 ov = {o[0], o[1], o[2], o[3]}; *(u32x4*)(base + (size_t)(rb + i) * 1952) = ov; }
        prev = cc;
      }
      cur = rw[8];
    }
  }
  __syncthreads();
}

DI void init_rows(CP p, int item) {
  const int lane = tidx() & 63, wv = tidx() >> 6;
  const int r = item * 8 + wv;
  if (r >= TP) return;
  u16* dst = p.hb + (size_t)r * 1024 + lane * 16;
  float ss = 0.f;
  if (r < T) {
    int s, pos, L; row2seq(r, s, pos, L);
    const float* src = pos < 16 ? p.meta + pos * 1024
                     : (s < 2 ? p.x_prompt + ((size_t)s * 8192 + pos - 16) * 1024 : p.x_sample + ((size_t)(s - 2) * 2048 + pos - 16) * 1024);
    src += lane * 16;
    unsigned pk[8];
#pragma unroll
    for (int i = 0; i < 4; ++i) {
      float4 v = *(const float4*)(src + 4 * i);
      pk[2 * i] = pack2(v.x, v.y); pk[2 * i + 1] = pack2(v.z, v.w);
      float a = bflo(pk[2 * i]), b = bfhi(pk[2 * i]), c = bflo(pk[2 * i + 1]), dd = bfhi(pk[2 * i + 1]);
      ss += a * a + b * b + c * c + dd * dd;
    }
    *(uint4*)dst = make_uint4(pk[0], pk[1], pk[2], pk[3]);
    *(uint4*)(dst + 8) = make_uint4(pk[4], pk[5], pk[6], pk[7]);
  } else {
    *(uint4*)dst = make_uint4(0, 0, 0, 0);
    *(uint4*)(dst + 8) = make_uint4(0, 0, 0, 0);
  }
#pragma unroll
  for (int o = 32; o > 0; o >>= 1) ss += __shfl_xor(ss, o);
  if (lane < 16) p.ssq[(size_t)lane * TP + r] = lane == 0 ? ss : 0.f;
}
DI void init_rope(CP p, int item) {
  const int idx = item * NTHR + tidx();
  if (idx >= LPR * 16) return;
  const int pos = idx >> 4, i = idx & 15;
  double rev = (double)pos * ROPE_INV[i] * 0.15915494309189535;
  rev -= rint(rev);
  const float fr = (float)rev;
  p.ropec[idx] = __builtin_amdgcn_cosf(fr);
  p.ropes[idx] = __builtin_amdgcn_sinf(fr);
}
DI void final_rows(CP p, int item) {
  const int lane = tidx() & 63, wv = tidx() >> 6;
  const int orow = item * 8 + wv;
  int r;
  if (orow < 16384) { int s = orow >> 13; r = s * LPR + 16 + (orow & 8191); }
  else { int x = orow - 16384; int s = x >> 11; r = 2 * LPR + s * LSM + 16 + (x & 2047); }
  const float rs = rstd16(p.ssq, r);
  const u16* src = p.hb + (size_t)r * 1024 + lane * 16;
  uint4 a = *(const uint4*)src, b = *(const uint4*)(src + 8);
  unsigned w[8] = {a.x, a.y, a.z, a.w, b.x, b.y, b.z, b.w};
  float* dst = p.out + (size_t)orow * 1024 + lane * 16;
  const float* gn = p.final_norm + lane * 16;
#pragma unroll
  for (int i = 0; i < 4; ++i) {
    float4 o;
    o.x = bflo(w[2 * i]) * rs * gn[4 * i]; o.y = bfhi(w[2 * i]) * rs * gn[4 * i + 1];
    o.z = bflo(w[2 * i + 1]) * rs * gn[4 * i + 2]; o.w = bfhi(w[2 * i + 1]) * rs * gn[4 * i + 3];
    *(float4*)(dst + 4 * i) = o;
  }
}

#define XB_TMO      128
#define XB_XCNT(j)  (256  + 64 * (j))
#define XB_XSUB(j)  (1280 + 64 * (j))
#define XB_XGEN(j)  (2304 + 64 * (j))
#define XB_TOP      3328
#define XB_TOPGEN   3392
#define XCD_BAR_WORDS 3456
#define XB_SPIN_CAP (1u << 18)
#define LAS __attribute__((address_space(3)))

__device__ __forceinline__ unsigned xb_ld(unsigned* p)              { return __hip_atomic_load(p, __ATOMIC_RELAXED, __HIP_MEMORY_SCOPE_AGENT); }
__device__ __forceinline__ unsigned xb_add(unsigned* p, unsigned v) { return __hip_atomic_fetch_add(p, v, __ATOMIC_RELAXED, __HIP_MEMORY_SCOPE_AGENT); }
__device__ __forceinline__ unsigned xb_xcc_id() { return (unsigned)__builtin_amdgcn_s_getreg((3 << 11) | 20) & 0xFu; }
#define XB_SPIN(cond, bar) do { unsigned _sp = 0; while (cond) { __builtin_amdgcn_s_sleep(1); \
    if ((++_sp & 255u) == 0u) { if (xb_ld(&(bar)[XB_TMO])) break; if (_sp > XB_SPIN_CAP) { atomicAdd(&(bar)[XB_TMO], 1u); break; } } } } while (0)

struct XcdBarrier {
    unsigned* bar; unsigned x;
    volatile LAS unsigned* st;
};

__device__ __forceinline__ XcdBarrier xcd_barrier_post(unsigned* bar, volatile LAS unsigned* st) {
    XcdBarrier b; b.bar = bar; b.x = xb_xcc_id(); b.st = st;
    if (threadIdx.x == 0) (void)xb_add(&bar[XB_XCNT(b.x)], 1u);
    return b;
}
__device__ __forceinline__ void xcd_barrier_complete(unsigned* bar, unsigned x, unsigned& nloc, unsigned& nx) {
    const unsigned G = gridDim.x * gridDim.y * gridDim.z;
    unsigned sum, cnt, mine, sp = 0u;
    for (;;) {
        sum = 0u; cnt = 0u; mine = 0u;
#pragma unroll
        for (unsigned j = 0; j < 16; ++j) { const unsigned c = xb_ld(&bar[XB_XCNT(j)]); sum += c; cnt += (c > 0u) ? 1u : 0u; mine = (j == x) ? c : mine; }
        if (sum == G) break;
        __builtin_amdgcn_s_sleep(1);
        if ((++sp & 255u) == 0u) { if (xb_ld(&bar[XB_TMO])) break; if (sp > XB_SPIN_CAP) { atomicAdd(&bar[XB_TMO], 1u); break; } }
    }
    nloc = mine > 0u ? mine : 1u; nx = cnt > 0u ? cnt : 1u;
}

__device__ __forceinline__ void xcd_barrier(const XcdBarrier& b) {
    asm volatile("s_waitcnt vmcnt(0)" ::: "memory");
    __syncthreads();
    if (threadIdx.x == 0) {
        unsigned* bar = b.bar;
        __builtin_amdgcn_s_waitcnt(0);
        unsigned nloc = b.st[0], nx = b.st[1];
        if (nloc == 0u) { xcd_barrier_complete(bar, b.x, nloc, nx); b.st[0] = nloc; b.st[1] = nx; }
        const unsigned old = xb_add(&bar[XB_XSUB(b.x)], 1u);
        const unsigned gen = old / nloc;
        if (old + 1u == (gen + 1u) * nloc) {
            __builtin_amdgcn_fence(__ATOMIC_RELEASE, "agent");
            asm volatile("s_waitcnt vmcnt(0)" ::: "memory");
            const unsigned og = xb_add(&bar[XB_TOP], 1u);
            const unsigned tg = og / nx;
            if (og + 1u == (tg + 1u) * nx) xb_add(&bar[XB_TOPGEN], 1u);
            else XB_SPIN(xb_ld(&bar[XB_TOPGEN]) == tg, bar);
            __builtin_amdgcn_fence(__ATOMIC_ACQUIRE, "agent");
            xb_add(&bar[XB_XGEN(b.x)], 1u);
            asm volatile("s_waitcnt vmcnt(0)" ::: "memory");
        } else {
            XB_SPIN(xb_ld(&bar[XB_XGEN(b.x)]) == gen, bar);
            __builtin_amdgcn_fence(__ATOMIC_ACQUIRE, "agent");
            asm volatile("s_waitcnt vmcnt(0)" ::: "memory");
        }
    }
    __syncthreads();
}

constexpr int NPHASE = 21;
#ifndef ONLY
#define EN(x) true
#else
#define EN(x) ((x) == ONLY)
#endif
DI void run_phase(CP p, int ph, char* smem) {
  const int bid = blockIdx.x, nb = gridDim.x;
  const int fidx = (bid & 7) ? (bid >> 3) * 7 + (bid & 7) - 1 : -1, nfill = (nb >> 3) * 7;
  if (EN(100) && ph == 0) {
    const int n0 = NCONV_FFN, n1 = n0, n2 = n1 + TP / 8, n3 = n2 + (LPR * 16 + NTHR - 1) / NTHR;
    for (int it = bid; it < n3; it += nb) {
      if (it < n0) conv_ffn(p, 0, 0, it, smem);
      else if (it < n2) init_rows(p, it - n1);
      else init_rope(p, it - n2);
    }
    if (bid == 0 && tidx() < 4) p.ctr[tidx()] = 0u;
    return;
  }
  if (ph == 10) return;
  if (EN(102) && ph == 20) { for (int it = bid; it < 4096; it += nb) final_rows(p, it); return; }
  const int layer = ph > 10 ? 1 : 0;
  const int k = ph - (layer ? 11 : 1);
  GArgs g{};
  g.layer = layer; g.scale = 1.f;
  u16* outb = (u16*)p.out;
  switch (k) {
    case 0: case 7: if (EN(0)) {
      g.a0 = p.hb; g.ld0 = 1024; g.split = 1 << 30; g.ks0 = 64; g.a1 = p.hb; g.ld1 = 1024; g.W = (layer == 1 && k == 0) ? p.kn : p.wF; g.K = 1024;
      gemm_phase<0, EPI_UP, 256>(p, g, 22, smem);
      if (k == 7 && layer == 0 && fidx >= 0) for (int it = fidx; it < NCONV_FFN; it += nfill) conv_ffn(p, 1, 0, it, smem);
    } break;
    case 1: case 8: if (EN(1)) {
      g.a0 = p.regB; g.ld0 = 1408; g.split = 22; g.ks0 = 64; g.a1 = outb; g.ld1 = 1408; g.W = ((layer == 1 && k == 1) ? p.kn : p.wF) + OFF_WD; g.K = 2816; g.scale = 0.5f;
      gemm_phase<0, EPI_RES, 256>(p, g, 4, smem);
      if (layer == 0 && fidx >= 0) for (int it = fidx; it < NCONV_MIX; it += nfill) conv_mix(p, k == 1 ? 0 : 1, it, smem);
    } break;
    case 2: if (EN(2)) {
      g.a0 = p.hb; g.ld0 = 1024; g.split = 1 << 30; g.ks0 = 64; g.a1 = p.hb; g.ld1 = 1024; g.W = p.wM + OFF_IN; g.K = 1024;
      gemm_phase<0, EPI_INPROJ, 256>(p, g, 10, smem);
    } break;
    case 3: if (EN(3)) {
      const int nq = NMT * 6, nkv = NMT * 8, nsh = 522, ntot = nq + nkv + nsh;
      for (int it = bid; it < ntot; it += nb) {
        if (it < nq) {
          g.a0 = outb; g.ld0 = 512; g.split = 1 << 30; g.ks0 = 64; g.a1 = outb; g.ld1 = 512; g.W = p.wM + OFF_UQ; g.K = 256;
          gemm_phase_item<0, EPI_Q>(p, g, it, 6, smem);
        } else if (it < nq + nkv) {
          g.a0 = outb + 256; g.ld0 = 512; g.split = 1 << 30; g.ks0 = 64; g.a1 = outb; g.ld1 = 512; g.W = p.wM + OFF_UKV; g.K = 128;
          gemm_phase_item<0, EPI_KV>(p, g, it - nq, 8, smem);
        } else shift_item(p, layer, it - nq - nkv, smem);
      }
    } break;
    case 4: if (EN(4)) {
      for (int sc = bid; sc < 192; sc += nb) {
        if (sc < 64) { int x = sc >> 1; scan_block2<8>(p, layer, x >> 4, (x >> 3) & 1, x & 7, sc & 1, smem); }
        else { int x = sc - 64; scan_block2<16>(p, layer, 2 + (x >> 4), (x >> 3) & 1, x & 7, 0, smem); }
      }
      unsigned* bc = (unsigned*)(smem + SMEM_BYTES - 16);
      while (true) {
        __syncthreads();
        if (tidx() == 0) *bc = atomicAdd(p.ctr + layer, 1u);
        __syncthreads();
        const int it = (int)*bc;
        if (it >= 1104 + NCONV_FFN) break;
        if (it >= 1104) { conv_ffn(p, layer, 1, it - 1104, smem); continue; }
        int s, hd, qb;
        if (it < 528) { s = it / 264; int rem = it - s * 264; hd = rem / 33; qb = rem - hd * 33; }
        else { int x = it - 528; s = 2 + x / 72; int rem = x % 72; hd = rem / 9; qb = rem - hd * 9; }
#ifdef PROBE_ATT2
        attn_item(p, s, hd, qb, smem, p.ctr[8] == 12345u);
        __syncthreads();
#endif
        attn_item(p, s, hd, qb, smem);
      }
    } break;
    case 5: if (EN(5)) {
      g.W = p.wM + OFF_G; g.K = 192; g.a0 = p.regB + 1792; g.a1 = g.a0; g.ld0 = g.ld1 = 1952; g.split = 1 << 30; g.ks0 = 64;
      gemm_phase<0, EPI_POST, 256>(p, g, 2, smem);
    } break;
    case 6: if (EN(6)) {
      g.a0 = outb + (size_t)TP * 1024; g.ld0 = 768; g.split = 8; g.ks0 = 96; g.a1 = outb; g.ld1 = 1024; g.W = p.wM + OFF_OUT; g.K = 1024;
      gemm_phase<0, EPI_RES, 256>(p, g, 4, smem);
    } break;
  }
}

template <bool COOP>
__global__ void __launch_bounds__(NTHR) mega(Params pp, int lo, int hi) {
  extern __shared__ __attribute__((aligned(16))) char smem[];
  const __attribute__((address_space(4))) Params* kp = (const __attribute__((address_space(4))) Params*)__builtin_amdgcn_kernarg_segment_ptr();
  volatile LAS unsigned* st = (volatile LAS unsigned*)(smem + SMEM_BYTES - 32);
  if (threadIdx.x == 0) { st[0] = 0u; st[1] = 0u; }
  __syncthreads();
  XcdBarrier xb = xcd_barrier_post(kp->bar, st);
  for (int ph = lo; ph < hi; ++ph) {
    if (ph == 10) continue;
    asm volatile("" : "+s"(kp));
    run_phase(*kp, ph, smem);
    if (COOP && ph + 1 < hi) {
      if (ph == 0) cg::this_grid().sync();
      else xcd_barrier(xb);
    }
  }
}

extern "C" void kernel_launch(void* const* d_in, const int* in_sizes, int n_in, void* d_out, int out_size, void* d_ws, size_t ws_size,
                              hipStream_t stream) {
  Params p{};
  const float** pf = (const float**)&p;
  for (int i = 0; i < 30; ++i) pf[i] = (const float*)d_in[i];
  p.out = (float*)d_out;
  char* w = (char*)d_ws;
  size_t off = 0;
  auto take = [&](size_t bytes) { char* r = w + off; off += (bytes + 255) & ~(size_t)255; return r; };
  p.hb = (u16*)take((size_t)TP * 1024 * 2);
  p.regB = (u16*)take((size_t)TP * 1952 * 2);
  p.kn = (u16*)take((size_t)TP * 512 * 2);
  p.vt = (u16*)take((size_t)TP * 512 * 2);
  p.wF = (u16*)take((size_t)WF_ELEMS * 2);
  p.wM = (u16*)take((size_t)WM_ELEMS * 2);
  p.ssq = (float*)take((size_t)16 * TP * 4);
  p.ssqq = (float*)take((size_t)6 * TP * 4);
  p.bsc = (float*)take((size_t)2 * TP * 8 * 4);
  p.ropec = (float*)take((size_t)LPR * 16 * 4);
  p.ropes = (float*)take((size_t)LPR * 16 * 4);
  p.ctr = (unsigned*)take(256);
  p.bar = (unsigned*)take((size_t)XCD_BAR_WORDS * 4);
  if (off > ws_size) fprintf(stderr, "workspace too small: need %zu have %zu\n", off, ws_size);
#ifndef MULTI_LAUNCH
  static int grid_blocks = 0;
  if (!grid_blocks) {
    hipFuncSetAttribute((const void*)mega<true>, hipFuncAttributeMaxDynamicSharedMemorySize, SMEM_BYTES);
    int dev = 0, cus = 0, per_cu = 0;
    hipGetDevice(&dev);
    hipDeviceGetAttribute(&cus, hipDeviceAttributeMultiprocessorCount, dev);
    hipOccupancyMaxActiveBlocksPerMultiprocessor(&per_cu, mega<true>, NTHR, SMEM_BYTES);
    if (per_cu > 1) per_cu = 1;
    grid_blocks = cus * per_cu;
  }
  hipMemsetAsync(p.bar, 0, (size_t)XCD_BAR_WORDS * 4, stream);
  int lo = 0, hi = NPHASE;
  void* args[] = {&p, &lo, &hi};
  hipError_t e = hipLaunchCooperativeKernel((void*)mega<true>, dim3(grid_blocks), dim3(NTHR), args, SMEM_BYTES, stream);
  if (e != hipSuccess) fprintf(stderr, "cooperative launch failed: %s (grid %d)\n", hipGetErrorString(e), grid_blocks);
#else
  hipFuncSetAttribute((const void*)mega<false>, hipFuncAttributeMaxDynamicSharedMemorySize, SMEM_BYTES);
  for (int ph = 0; ph < NPHASE; ++ph) mega<false><<<256, NTHR, SMEM_BYTES, stream>>>(p, ph, ph + 1);
#endif
}
```

```cpp
#include <hip/hip_runtime.h>
#include <hip/hip_cooperative_groups.h>
#include <cstdio>
namespace cg = cooperative_groups;

typedef unsigned short u16;
typedef __attribute__((ext_vector_type(8))) short bf16x8;
typedef __attribute__((ext_vector_type(16))) float f32x16;
#define DI __device__ __forceinline__
#define MFMA(a, b, c) __builtin_amdgcn_mfma_f32_32x32x16_bf16((a), (b), (c), 0, 0, 0)

constexpr int T = 32928, TP = 33024, LPR = 8208, LSM = 2064, NMT = 129;
constexpr int NTHR = 512;
constexpr float RMS_EPS = 1e-6f, LNX_EPS = 64e-5f;
constexpr float QSCALE = 0.10206207261596575f * 1.4426950408889634f;
constexpr int OFF_IN = 0, OFF_UQ = 2621440, OFF_UKV = 2818048, OFF_DEC = 2949120, OFF_A = 3014656, OFF_G = 3080192, OFF_OUT = 3178496, WM_ELEMS = 4227072;
constexpr int OFF_WD = 5767168, WF_ELEMS = 8650752;
constexpr int SMEM_BYTES = 149504;

__constant__ double ROPE_INV[16] = {1.0, 0.5623413251903491, 0.31622776601683794, 0.1778279410038923, 0.1, 0.05623413251903491,
  0.031622776601683794, 0.01778279410038923, 0.01, 0.005623413251903491, 0.0031622776601683794, 0.001778279410038923,
  0.001, 0.0005623413251903491, 0.00031622776601683794, 0.0001778279410038923};

struct Params {
  const float *x_prompt, *x_sample, *meta, *ffn1_norm, *ffn1_wg, *ffn1_wu, *ffn1_wd, *mix_norm, *w_in, *shift_mu, *q_norm, *w_uq,
      *kv_norm, *w_ukv, *decay_w0, *decay_w2, *iclr_a0, *iclr_a2, *gate_g2, *key_k_k, *key_k_a, *bonus_r_k, *lnx_w, *lnx_b, *w_out,
      *ffn2_norm, *ffn2_wg, *ffn2_wu, *ffn2_wd, *final_norm;
  float* out;
  u16 *hb, *regB, *kn, *vt, *wF, *wM;
  float *ssq, *ssqq, *bsc, *ropec, *ropes;
  unsigned* ctr;
  unsigned* bar;
};

typedef const __attribute__((address_space(4))) Params& CP;
DI int tidx() { int t = __builtin_amdgcn_workitem_id_x(); asm volatile("" : "+v"(t)); return t; }
DI u16 f2bf(float x) { unsigned u = __float_as_uint(x); u += 0x7fffu + ((u >> 16) & 1u); return (u16)(u >> 16); }
DI float bf2f(u16 b) { return __uint_as_float(((unsigned)b) << 16); }
typedef __bf16 bf16x2_t __attribute__((ext_vector_type(2)));
typedef float fl2_t __attribute__((ext_vector_type(2)));
DI unsigned pack2(float a, float b) { fl2_t f; f.x = a; f.y = b; bf16x2_t r = __builtin_convertvector(f, bf16x2_t); return __builtin_bit_cast(unsigned, r); }
DI float bflo(unsigned u) { return __uint_as_float(u << 16); }
DI float bfhi(unsigned u) { return __uint_as_float(u & 0xffff0000u); }
DI float sigmoidf_(float x) { return __builtin_amdgcn_rcpf(1.f + __expf(-x)); }
DI int crow(int reg, int h) { return (reg & 3) + 8 * (reg >> 2) + 4 * h; }
DI void row2seq(int r, int& s, int& pos, int& L) {
  if (r < 2 * LPR) { s = r >= LPR ? 1 : 0; pos = r - s * LPR; L = LPR; }
  else { int q = (r - 2 * LPR) / LSM; s = 2 + q; pos = r - 2 * LPR - q * LSM; L = LSM; }
}
DI int seq_start(int s) { return s < 2 ? s * LPR : 2 * LPR + (s - 2) * LSM; }
DI int seq_len(int s) { return s < 2 ? LPR : LSM; }
DI float dpp_sum8(float x) {
  x += __int_as_float(__builtin_amdgcn_update_dpp(0, __float_as_int(x), 0xB1, 0xf, 0xf, false));
  x += __int_as_float(__builtin_amdgcn_update_dpp(0, __float_as_int(x), 0x4E, 0xf, 0xf, false));
  x += __int_as_float(__builtin_amdgcn_update_dpp(0, __float_as_int(x), 0x141, 0xf, 0xf, false));
  return x;
}
DI float sum16(float x) {
  x += __int_as_float(__builtin_amdgcn_update_dpp(0, __float_as_int(x), 0x128, 0xf, 0xf, false));
  x += __int_as_float(__builtin_amdgcn_update_dpp(0, __float_as_int(x), 0x124, 0xf, 0xf, false));
  x += __int_as_float(__builtin_amdgcn_update_dpp(0, __float_as_int(x), 0x122, 0xf, 0xf, false));
  x += __int_as_float(__builtin_amdgcn_update_dpp(0, __float_as_int(x), 0x121, 0xf, 0xf, false));
  return x;
}
DI float rstd16(const float* ssq, int m) {
  float s = 0.f;
#pragma unroll
  for (int c = 0; c < 16; ++c) s += ssq[(size_t)c * TP + m];
  return rsqrtf(s * (1.f / 1024.f) + RMS_EPS);
}

struct CJob { const float* src; const float* gain; u16* dst; int K, N, ld, map, nkt; };
DI int rowmap(int map, int n) {
  if (map == 1) return (n >> 5) * 64 + (n & 31);
  if (map == 2) return (n >> 5) * 64 + 32 + (n & 31);
  if (map == 3) return n < 416 ? n : n + 96;
  return n;
}
DI void conv_tile(const CJob& jb, int t, char* smem) {
  const int tid = tidx();
  const int kt = t % jb.nkt, ntile = t / jb.nkt;
  const int ny = tid >> 3, kx = tid & 7;
  const int n = ntile * 64 + ny, kb = kt * 64 + kx * 8;
  float v[8];
#pragma unroll
  for (int j = 0; j < 8; ++j) {
    const int k = kb + j, kc = min(k, jb.K - 1);
    float x = jb.src[(size_t)kc * jb.N + n];
    if (jb.gain) x *= jb.gain[kc];
    v[j] = k < jb.K ? x : 0.f;
  }
  uint4 o;
  o.x = pack2(v[0], v[1]); o.y = pack2(v[2], v[3]); o.z = pack2(v[4], v[5]); o.w = pack2(v[6], v[7]);
  *(uint4*)(jb.dst + (size_t)rowmap(jb.map, n) * jb.ld + kb) = o;
}
constexpr int NCONV_FFN = 2112, NCONV_MIX = 1032;
DI void conv_ffn(CP p, int l, int f, int t, char* smem) {
  CJob jb;
  u16* slot = (l == 1 && f == 0) ? p.kn : p.wF;
  const float* wg = f ? p.ffn2_wg : p.ffn1_wg; const float* wu = f ? p.ffn2_wu : p.ffn1_wu; const float* wd = f ? p.ffn2_wd : p.ffn1_wd;
  const float* nr = f ? p.ffn2_norm : p.ffn1_norm;
  if (t < 704) { jb = CJob{wg + (size_t)l * 1024 * 2816, nr + l * 1024, slot, 1024, 2816, 1024, 1, 16}; }
  else if (t < 1408) { t -= 704; jb = CJob{wu + (size_t)l * 1024 * 2816, nr + l * 1024, slot, 1024, 2816, 1024, 2, 16}; }
  else { t -= 1408; jb = CJob{wd + (size_t)l * 2816 * 1024, nullptr, slot + OFF_WD, 2816, 1024, 2816, 0, 44}; }
  conv_tile(jb, t, smem);
}
DI void conv_mix(CP p, int l, int t, char* smem) {
  CJob jb;
  if (t < 592) jb = CJob{p.w_in + (size_t)l * 1024 * 2368, p.mix_norm + l * 1024, p.wM + OFF_IN, 1024, 2368, 1024, 3, 16};
  else if (t < 640) { t -= 592; jb = CJob{p.w_uq + (size_t)l * 256 * 768, p.q_norm + l * 256, p.wM + OFF_UQ, 256, 768, 256, 0, 4}; }
  else if (t < 672) { t -= 640; jb = CJob{p.w_ukv + (size_t)l * 128 * 1024, p.kv_norm + l * 128, p.wM + OFF_UKV, 128, 1024, 128, 0, 2}; }
  else if (t < 688) { t -= 672; int d = t >> 3; t &= 7; jb = CJob{p.decay_w2 + (size_t)(l * 2 + d) * 64 * 512, nullptr, p.wM + OFF_DEC + d * 32768, 64, 512, 64, 0, 1}; }
  else if (t < 704) { t -= 688; int d = t >> 3; t &= 7; jb = CJob{p.iclr_a2 + (size_t)(l * 2 + d) * 64 * 512, nullptr, p.wM + OFF_A + d * 32768, 64, 512, 64, 0, 1}; }
  else if (t < 728) { t -= 704; jb = CJob{p.gate_g2 + (size_t)l * 160 * 512, nullptr, p.wM + OFF_G, 160, 512, 192, 0, 3}; }
  else if (t < 984) { t -= 728; jb = CJob{p.w_out + (size_t)l * 1024 * 1024, nullptr, p.wM + OFF_OUT, 1024, 1024, 1024, 0, 16}; }
  else {
    t -= 984;
    size_t base = (t < 24) ? (size_t)416 * 1024 + (size_t)t * 4096 : (size_t)2464 * 1024 + (size_t)(t - 24) * 4096;
    *(uint4*)(p.wM + OFF_IN + base + tidx() * 8) = make_uint4(0, 0, 0, 0);
    return;
  }
  conv_tile(jb, t, smem);
}

struct GArgs { const u16 *a0, *a1; int ld0, ld1, split, ks0; const u16* W; int K; int layer; float scale; };
enum { EPI_UP = 0, EPI_RES = 1, EPI_INPROJ = 2, EPI_Q = 3, EPI_KV = 4, EPI_POST = 5 };

DI uint4 load_gate(CP p, int layer, int m, int k) {
  uint4 z = make_uint4(0, 0, 0, 0);
  if (m >= T || k >= 160) return z;
  int s, pos, L; row2seq(m, s, pos, L);
  const u16* pb = p.regB + (size_t)m * 1952 + 1792 + k;
  uint4 c = *(const uint4*)pb;
  uint4 pm = pos > 0 ? *(const uint4*)(pb - 1952) : z;
  uint4 pp = pos + 1 < L ? *(const uint4*)(pb + 1952) : z;
  const float* mu0 = p.shift_mu + (size_t)(layer * 2 + 0) * 1952 + 1792 + k;
  const float* mu1 = p.shift_mu + (size_t)(layer * 2 + 1) * 1952 + 1792 + k;
  unsigned cc[4] = {c.x, c.y, c.z, c.w}, mm[4] = {pm.x, pm.y, pm.z, pm.w}, nn[4] = {pp.x, pp.y, pp.z, pp.w};
  unsigned o[4];
#pragma unroll
  for (int e = 0; e < 4; ++e) {
    float c0 = bflo(cc[e]), c1 = bfhi(cc[e]);
    float x0 = c0 + mu0[2 * e] * (bflo(mm[e]) - c0) + mu1[2 * e] * (bflo(nn[e]) - c0);
    float x1 = c1 + mu0[2 * e + 1] * (bfhi(mm[e]) - c1) + mu1[2 * e + 1] * (bfhi(nn[e]) - c1);
    o[e] = pack2(sigmoidf_(x0), sigmoidf_(x1));
  }
  return make_uint4(o[0], o[1], o[2], o[3]);
}

template <int MODE>
DI uint4 load_a(CP p, const GArgs& g, int row, int kt, int kc) {
  if (MODE == 1) return load_gate(p, g.layer, row, kt * 64 + kc * 8);
  const u16* ap = (kt < g.split) ? g.a0 + (size_t)row * g.ld0 + kt * g.ks0 : g.a1 + (size_t)row * g.ld1 + (kt - g.split) * 64;
  return *(const uint4*)(ap + kc * 8);
}

DI u16* halo_ptr(CP p) { return (u16*)p.out + (size_t)TP * 1024 + (size_t)TP * 768 + (size_t)TP * 32; }
DI uint4 ldg16(const u16* p) { uint4 v = *(const uint4*)p; return v; }
DI void sts16(u16* p, uint4 v) { *(uint4*)p = v; }
DI void store4(u16* dst, float a, float b, float c, float d) { *(uint2*)dst = make_uint2(pack2(a, b), pack2(c, d)); }

template <int MODE, int EPI, int BN>
DI void gemm_tile(CP p, const GArgs& g, int mt, int nt, char* smem, int chain = 0, int nmt = 0, int nnt = 0) {
  constexpr int WN = BN / 64, WM = 8 / WN, MI = 256 / WM / 32, NWC = BN / 64;
  u16* As = (u16*)smem;
  u16* Ws = As + 2 * 256 * 72;
  const int tid = tidx(), lane = tid & 63, wv = tid >> 6, wm = wv / WN, wn = wv % WN, l32 = lane & 31, hh = lane >> 5;
  const int m0 = mt * 256, n0 = nt * BN;
  const int nk = g.K >> 6;
  f32x16 acc[MI][2];
  float rs_early = 0.f;
  if ((EPI == EPI_UP || EPI == EPI_INPROJ) && tid < 256) rs_early = rstd16(p.ssq, m0 + tid);
#pragma unroll
  for (int i = 0; i < MI; ++i)
#pragma unroll
    for (int j = 0; j < 2; ++j)
#pragma unroll
      for (int r = 0; r < 16; ++r) acc[i][j][r] = 0.f;
  uint4 ra0[4], ra1[4], rw0[4], rw1[4];
#define GLA(KT, DA, I) { const int c_ = tid + (I) * 512; DA[I] = load_a<MODE>(p, g, m0 + (c_ >> 3), (KT), c_ & 7); }
#define GLW(KT, DW, I) if ((I) < NWC) { const int c_ = tid + (I) * 512; DW[I] = ldg16(g.W + (size_t)(n0 + (c_ >> 3)) * g.K + (KT) * 64 + (c_ & 7) * 8); }
#define GLOAD(KT, DA, DW) do { GLA(KT, DA, 0) GLA(KT, DA, 1) GLA(KT, DA, 2) GLA(KT, DA, 3) GLW(KT, DW, 0) GLW(KT, DW, 1) GLW(KT, DW, 2) GLW(KT, DW, 3) } while (0)
#define LSA(BUF, DA, I) { const int c_ = tid + (I) * 512; sts16(As + ((BUF) * 256 + (c_ >> 3)) * 72 + (c_ & 7) * 8, DA[I]); }
#define LSW(BUF, DW, I) if ((I) < NWC) { const int c_ = tid + (I) * 512; sts16(Ws + ((BUF) * BN + (c_ >> 3)) * 72 + (c_ & 7) * 8, DW[I]); }
#define LSTORE(BUF, DA, DW) do { LSA(BUF, DA, 0) LSA(BUF, DA, 1) LSA(BUF, DA, 2) LSA(BUF, DA, 3) LSW(BUF, DW, 0) LSW(BUF, DW, 1) LSW(BUF, DW, 2) LSW(BUF, DW, 3) } while (0)
  auto compute = [&](int buf) {
    const u16* Ab = As + buf * 256 * 72 + (wm * (MI * 32) + l32) * 72 + hh * 8;
    const u16* Wb = Ws + buf * BN * 72 + (wn * 64 + l32) * 72 + hh * 8;
#pragma unroll
    for (int ks = 0; ks < 4; ++ks) {
      bf16x8 wf0 = *(const bf16x8*)(Wb + ks * 16);
      bf16x8 wf1 = *(const bf16x8*)(Wb + 32 * 72 + ks * 16);
#pragma unroll
      for (int i = 0; i < MI; ++i) {
        bf16x8 xf = *(const bf16x8*)(Ab + i * 32 * 72 + ks * 16);
        acc[i][0] = MFMA(wf0, xf, acc[i][0]);
        acc[i][1] = MFMA(wf1, xf, acc[i][1]);
      }
    }
  };
  if (true) {
    char* L0 = smem;
    constexpr int BUFB = (256 + BN) * 128;
    constexpr int NBUF = BN <= 128 ? 3 : 2;
    constexpr int NGL = 4 + BN / 64;
    const int gl_row = lane >> 3;
    auto issue_at = [&](int mm0, int nn0, int kt, int buf) {
      char* lb = L0 + buf * BUFB;
#pragma unroll
      for (int i = 0; i < 4; ++i) {
        const int seg = wv * 4 + i, row = seg * 8 + gl_row;
        const int c = (lane & 7) ^ ((row >> 1) & 7);
        const u16* ap = (kt < g.split) ? g.a0 + (size_t)(mm0 + row) * g.ld0 + kt * g.ks0 : g.a1 + (size_t)(mm0 + row) * g.ld1 + (kt - g.split) * 64;
        __builtin_amdgcn_global_load_lds((const unsigned*)(ap + c * 8), (__attribute__((address_space(3))) unsigned*)(lb + seg * 1024 + lane * 16), 16, 0, 0);
      }
#pragma unroll
      for (int i = 0; i < BN / 64; ++i) {
        const int seg = wv * (BN / 64) + i, row = seg * 8 + gl_row;
        const int c = (lane & 7) ^ ((row >> 1) & 7);
        __builtin_amdgcn_global_load_lds((const unsigned*)(g.W + (size_t)(nn0 + row) * g.K + kt * 64 + c * 8),
                                         (__attribute__((address_space(3))) unsigned*)(lb + 256 * 128 + seg * 1024 + lane * 16), 16, 0, 0);
      }
    };
    auto issue = [&](int kt, int buf) { issue_at(m0, n0, kt, buf); };
    auto compute2 = [&](int buf) {
      const char* lb = L0 + buf * BUFB;
#pragma unroll
      for (int ks = 0; ks < 4; ++ks) {
        const int c = ks * 2 + hh;
        bf16x8 wf[2], xf[MI];
#pragma unroll
        for (int j = 0; j < 2; ++j) { const int r = wn * 64 + j * 32 + l32; wf[j] = *(const bf16x8*)(lb + 256 * 128 + r * 128 + ((c ^ ((r >> 1) & 7)) << 4)); }
#pragma unroll
        for (int i = 0; i < MI; ++i) { const int r = wm * (MI * 32) + i * 32 + l32; xf[i] = *(const bf16x8*)(lb + r * 128 + ((c ^ ((r >> 1) & 7)) << 4)); }
#pragma unroll
        for (int i = 0; i < MI; ++i) {
          acc[i][0] = MFMA(wf[0], xf[i], acc[i][0]);
          acc[i][1] = MFMA(wf[1], xf[i], acc[i][1]);
        }
      }
    };
    if (NBUF == 3) {
      issue(0, 0);
      if (nk > 1) { issue(1, 1); if (BN == 128) asm volatile("s_waitcnt vmcnt(6)" ::: "memory"); else asm volatile("s_waitcnt vmcnt(5)" ::: "memory"); }
      else asm volatile("s_waitcnt vmcnt(0)" ::: "memory");
      asm volatile("s_waitcnt lgkmcnt(0)" ::: "memory");
      __builtin_amdgcn_s_barrier();
      int buf = 0;
      for (int kt = 0; kt < nk; ++kt) {
        const int b2 = buf == 0 ? 2 : buf - 1;
        if (kt + 2 < nk) issue(kt + 2, b2);
        compute2(buf);
        if (kt + 2 < nk) { if (BN == 128) asm volatile("s_waitcnt vmcnt(6)" ::: "memory"); else asm volatile("s_waitcnt vmcnt(5)" ::: "memory"); }
        else asm volatile("s_waitcnt vmcnt(0)" ::: "memory");
        asm volatile("s_waitcnt lgkmcnt(0)" ::: "memory");
        __builtin_amdgcn_s_barrier();
        buf = buf == 2 ? 0 : buf + 1;
      }
    } else {
      if (!(chain & 1)) {
        issue(0, 0);
        asm volatile("s_waitcnt vmcnt(0)" ::: "memory");
        __syncthreads();
      }
      for (int kt = 0; kt < nk; ++kt) {
        const int buf = kt & 1;
        if (kt + 1 < nk) issue(kt + 1, buf ^ 1);
        else if (chain & 2) issue_at(nmt * 256, nnt * BN, 0, buf ^ 1);
        compute2(buf);
        asm volatile("s_waitcnt vmcnt(0)" ::: "memory");
        __syncthreads();
      }
    }
    __syncthreads();
  } else {
    GLOAD(0, ra0, rw0);
    LSTORE(0, ra0, rw0);
    __syncthreads();
    for (int kt = 0; kt < nk; ++kt) {
      const int buf = kt & 1;
      if (kt + 1 < nk) GLOAD(kt + 1, ra0, rw0);
      compute(buf);
      if (kt + 1 < nk) LSTORE(buf ^ 1, ra0, rw0);
      __syncthreads();
    }
  }
#undef GLOAD
#undef LSTORE
  float* rsl = (float*)(smem + 147456);
  if (EPI == EPI_UP || EPI == EPI_INPROJ) {
    if (tid < 256) rsl[tid] = rs_early;
    __syncthreads();
  }
  const int nw = n0 + wn * 64;
#pragma unroll
  for (int i = 0; i < MI; ++i) {
    const int m = m0 + wm * (MI * 32) + i * 32 + l32;
    if (EPI == EPI_UP) {
      const float rs = rsl[m - m0];
      const int hb0 = nw >> 1;
#pragma unroll
      for (int gq = 0; gq < 4; ++gq) {
        float v[4];
#pragma unroll
        for (int r = 0; r < 4; ++r) {
          float gt = acc[i][0][4 * gq + r] * rs, up = acc[i][1][4 * gq + r] * rs;
          v[r] = gt * sigmoidf_(gt) * up;
        }
        int hid = hb0 + 8 * gq + 4 * hh;
        u16* dst = hid < 1408 ? p.regB + (size_t)m * 1408 + hid : (u16*)p.out + (size_t)m * 1408 + (hid - 1408);
        store4(dst, v[0], v[1], v[2], v[3]);
      }
    } else if (EPI == EPI_RES) {
      float ss = 0.f;
#pragma unroll
      for (int j = 0; j < 2; ++j)
#pragma unroll
        for (int gq = 0; gq < 4; ++gq) {
          u16* hp = p.hb + (size_t)m * 1024 + nw + j * 32 + 8 * gq + 4 * hh;
          uint2 old = *(const uint2*)hp;
          float h0 = bflo(old.x) + g.scale * acc[i][j][4 * gq + 0];
          float h1 = bfhi(old.x) + g.scale * acc[i][j][4 * gq + 1];
          float h2 = bflo(old.y) + g.scale * acc[i][j][4 * gq + 2];
          float h3 = bfhi(old.y) + g.scale * acc[i][j][4 * gq + 3];
          unsigned p0 = pack2(h0, h1), p1 = pack2(h2, h3);
          *(uint2*)hp = make_uint2(p0, p1);
          float r0 = bflo(p0), r1 = bfhi(p0), r2 = bflo(p1), r3 = bfhi(p1);
          ss += r0 * r0 + r1 * r1 + r2 * r2 + r3 * r3;
        }
      ss += __shfl_xor(ss, 32);
      if (hh == 0) p.ssq[(size_t)(nw >> 6) * TP + m] = ss;
    } else if (EPI == EPI_INPROJ) {
      const float rs = rsl[m - m0];
      int s, pos, L; row2seq(m < T ? m : 0, s, pos, L);
      float ss = 0.f;
#pragma unroll
      for (int j = 0; j < 2; ++j) {
        const int nb = nw + j * 32;
        if (nb == 384) {
          u16* kr = (u16*)p.out + (size_t)TP * 1024 + (size_t)TP * 768 + (size_t)m * 32;
#pragma unroll
          for (int gq = 0; gq < 2; ++gq) {
            float o1[4], o2[4];
#pragma unroll
            for (int r = 0; r < 4; ++r) {
              int ii = 8 * gq + 4 * hh + r;
              float c = p.ropec[pos * 16 + ii], sn = p.ropes[pos * 16 + ii];
              float x1 = acc[i][j][4 * gq + r] * rs, x2 = acc[i][j][4 * (gq + 2) + r] * rs;
              o1[r] = x1 * c - x2 * sn; o2[r] = x2 * c + x1 * sn;
            }
            store4(kr + 8 * gq + 4 * hh, o1[0], o1[1], o1[2], o1[3]);
            store4(kr + 16 + 8 * gq + 4 * hh, o2[0], o2[1], o2[2], o2[3]);
          }
        } else {
#pragma unroll
          for (int gq = 0; gq < 4; ++gq) {
            int n = nb + 8 * gq + 4 * hh;
            unsigned p0 = pack2(acc[i][j][4 * gq] * rs, acc[i][j][4 * gq + 1] * rs);
            unsigned p1 = pack2(acc[i][j][4 * gq + 2] * rs, acc[i][j][4 * gq + 3] * rs);
            if (n < 512) {
              *(uint2*)((u16*)p.out + (size_t)m * 512 + n) = make_uint2(p0, p1);
              float r0 = bflo(p0), r1 = bfhi(p0), r2 = bflo(p1), r3 = bfhi(p1);
              ss += r0 * r0 + r1 * r1 + r2 * r2 + r3 * r3;
            } else if (n - 512 < 1952) {
              *(uint2*)(p.regB + (size_t)m * 1952 + (n - 512)) = make_uint2(p0, p1);
              if (m < T && ((pos & 63) == 0 || (pos & 63) == 63)) {
                const int ch = (s < 2 ? s * 129 : 258 + (s - 2) * 33) + (pos >> 6);
                *(uint2*)(halo_ptr(p) + ((size_t)ch * 2 + ((pos & 63) ? 1 : 0)) * 1952 + (n - 512)) = make_uint2(p0, p1);
              }
            }
          }
        }
      }
      if (nw < 384) {
        ss += __shfl_xor(ss, 32);
        if (hh == 0) p.ssqq[(size_t)(nw >> 6) * TP + m] = ss;
      }
    } else if (EPI == EPI_Q) {
      float sq = p.ssqq[m] + p.ssqq[(size_t)TP + m] + p.ssqq[(size_t)2 * TP + m] + p.ssqq[(size_t)3 * TP + m];
      const float rs = rsqrtf(sq * (1.f / 256.f) + RMS_EPS) * QSCALE;
      int s, pos, L; row2seq(m < T ? m : 0, s, pos, L);
      u16* qrow = (u16*)p.out + (size_t)TP * 1024 + (size_t)m * 768;
#pragma unroll
      for (int j = 0; j < 2; ++j) {
        const int nb = nw + j * 32;
        if (((nb >> 5) % 3) == 2) {
#pragma unroll
          for (int gq = 0; gq < 2; ++gq) {
            float o1[4], o2[4];
#pragma unroll
            for (int r = 0; r < 4; ++r) {
              int ii = 8 * gq + 4 * hh + r;
              float c = p.ropec[pos * 16 + ii], sn = p.ropes[pos * 16 + ii];
              float x1 = acc[i][j][4 * gq + r] * rs, x2 = acc[i][j][4 * (gq + 2) + r] * rs;
              o1[r] = x1 * c - x2 * sn; o2[r] = x2 * c + x1 * sn;
            }
            store4(qrow + nb + 8 * gq + 4 * hh, o1[0], o1[1], o1[2], o1[3]);
            store4(qrow + nb + 16 + 8 * gq + 4 * hh, o2[0], o2[1], o2[2], o2[3]);
          }
        } else {
#pragma unroll
          for (int gq = 0; gq < 4; ++gq)
            store4(qrow + nb + 8 * gq + 4 * hh, acc[i][j][4 * gq] * rs, acc[i][j][4 * gq + 1] * rs, acc[i][j][4 * gq + 2] * rs, acc[i][j][4 * gq + 3] * rs);
        }
      }
    } else if (EPI == EPI_KV) {
      if (m < T) {
        float sq = p.ssqq[(size_t)4 * TP + m] + p.ssqq[(size_t)5 * TP + m];
        const float rs = rsqrtf(sq * (1.f / 128.f) + RMS_EPS);
        int s, pos, L; row2seq(m, s, pos, L);
        const int head = nw >> 7;
        const int ppos = (pos & ~15) | (pos & 3) | (((pos >> 3) & 1) << 2) | (((pos >> 2) & 1) << 3);
#pragma unroll
        for (int j = 0; j < 2; ++j) {
          const int jj = (nw & 127) + j * 32;
#pragma unroll
          for (int gq = 0; gq < 4; ++gq) {
            int c = jj + 8 * gq + 4 * hh;
            if (jj < 64) {
              store4(p.kn + (size_t)m * 512 + head * 64 + c, acc[i][j][4 * gq] * rs, acc[i][j][4 * gq + 1] * rs, acc[i][j][4 * gq + 2] * rs, acc[i][j][4 * gq + 3] * rs);
            } else {
#pragma unroll
              for (int r = 0; r < 4; ++r) {
                int dv = c - 64 + r;
                p.vt[(size_t)seq_start(s) * 512 + (size_t)(head * 64 + dv) * L + ppos] = f2bf(acc[i][j][4 * gq + r] * rs);
              }
            }
          }
        }
      }
    } else if (EPI == EPI_POST) {
      if (m < T) {
        int s, pos, L; row2seq(m, s, pos, L);
        const int hd = nw >> 6;
        u16* yb = (u16*)p.out + (size_t)m * 1024;
        float y[2][16];
        float sum = 0.f;
#pragma unroll
        for (int j = 0; j < 2; ++j)
#pragma unroll
          for (int gq = 0; gq < 4; ++gq) {
            int n = nw + j * 32 + 8 * gq + 4 * hh;
            uint2 a = *(const uint2*)(yb + n), b = *(const uint2*)(yb + 512 + n);
            y[j][4 * gq + 0] = bflo(a.x) + bflo(b.x); y[j][4 * gq + 1] = bfhi(a.x) + bfhi(b.x);
            y[j][4 * gq + 2] = bflo(a.y) + bflo(b.y); y[j][4 * gq + 3] = bfhi(a.y) + bfhi(b.y);
            sum += y[j][4 * gq] + y[j][4 * gq + 1] + y[j][4 * gq + 2] + y[j][4 * gq + 3];
          }
        sum += __shfl_xor(sum, 32);
        const float mu = sum * (1.f / 64.f);
        float vs = 0.f;
#pragma unroll
        for (int j = 0; j < 2; ++j)
#pragma unroll
          for (int r = 0; r < 16; ++r) { float dlt = y[j][r] - mu; vs += dlt * dlt; }
        vs += __shfl_xor(vs, 32);
        const float rstd = rsqrtf(vs * (1.f / 64.f) + LNX_EPS);
        const float bsum = p.bsc[(size_t)m * 8 + hd] + p.bsc[((size_t)TP + m) * 8 + hd];
        const u16* vb = p.regB + (size_t)m * 1952 + 1024;
#pragma unroll
        for (int j = 0; j < 2; ++j)
#pragma unroll
          for (int gq = 0; gq < 4; ++gq) {
            int n = nw + j * 32 + 8 * gq + 4 * hh;
            uint2 c = *(const uint2*)(vb + n);
            float cv[4] = {bflo(c.x), bfhi(c.x), bflo(c.y), bfhi(c.y)};
            float o[4];
#pragma unroll
            for (int r = 0; r < 4; ++r) {
              float vsh = cv[r];
              float yn = (y[j][4 * gq + r] - mu) * rstd * p.lnx_w[g.layer * 512 + n + r] + p.lnx_b[g.layer * 512 + n + r];
              o[r] = (yn + bsum * vsh) * acc[i][j][4 * gq + r];
            }
            store4(yb + n, o[0], o[1], o[2], o[3]);
          }
      }
    }
  }
}

template <int MODE, int EPI, int BN = 128>
DI void gemm_phase_item(CP p, const GArgs& g, int item, int NT, char* smem) {
  const int grp = item / (8 * NT);
  const int gsz = min(8, NMT - grp * 8);
  const int idx = item - grp * 8 * NT;
  gemm_tile<MODE, EPI, BN>(p, g, grp * 8 + idx % gsz, idx / gsz, smem);
}

template <int MODE, int EPI, int BN>
DI void gemm_phase(CP p, const GArgs& g, int NT, char* smem) {
  const int x = blockIdx.x & 7, j = blockIdx.x >> 3, nj = gridDim.x >> 3;
  const int total = 16 * NT;
  const bool can_chain = BN == 256 && (((g.K >> 6) & 1) == 0);
  bool first = true;
  for (int e = j; e < total; e += nj) {
    const int grp = e / (8 * NT);
    const int rem = e - grp * 8 * NT;
    const int e2 = e + nj;
    const bool has_next = can_chain && e2 < total;
    const int grp2 = e2 / (8 * NT), rem2 = e2 - grp2 * 8 * NT;
    const int chain = can_chain ? ((first ? 0 : 1) | (has_next ? 2 : 0)) : 0;
    gemm_tile<MODE, EPI, BN>(p, g, x + 8 * (grp * 8 + (rem & 7)), rem >> 3, smem, chain, x + 8 * (grp2 * 8 + (rem2 & 7)), rem2 >> 3);
    first = false;
  }
  const int ntail = NT * (BN / 64);
  for (int e = (int)gridDim.x - 1 - (int)blockIdx.x; e < ntail; e += gridDim.x) gemm_tile<MODE, EPI, 64>(p, g, NMT - 1, e, smem);
}

DI void attn_item(CP p, int s, int hd, int qb, char* smem, bool dostore = true) {
  u16* Ks = (u16*)smem;
  u16* Vs = Ks + 2 * 64 * 104;
  const int tid = tidx(), lane = tid & 63, wv = tid >> 6, l32 = lane & 31, hh = lane >> 5;
  const int L = seq_len(s), r0 = seq_start(s);
  const u16* Qb = (const u16*)p.out + (size_t)TP * 1024;
  const u16* KR = Qb + (size_t)TP * 768;
  const int qpos = qb * 256 + wv * 32 + l32;
  const bool wvalid = (qb * 256 + wv * 32) < L;
  const int qrow = r0 + min(qpos, L - 1);
  bf16x8 qf[6];
#pragma unroll
  for (int ks = 0; ks < 6; ++ks) qf[ks] = *(const bf16x8*)(Qb + (size_t)qrow * 768 + hd * 96 + ks * 16 + hh * 8);
  f32x16 o[2];
#pragma unroll
  for (int u = 0; u < 2; ++u)
#pragma unroll
    for (int r = 0; r < 16; ++r) o[u][r] = 0.f;
  float mrun = -1e30f, lrun = 0.f;
  const int nt = (L + 63) >> 6;
  const u16* vtb = p.vt + (size_t)r0 * 512 + (size_t)hd * 64 * L;
  uint4 rg[3];
  auto ldc = [&](int kt, int c) -> uint4 {
    uint4 z = make_uint4(0, 0, 0, 0);
    if (c < 768) {
      int key = c / 12, cc = c - key * 12, kpos = kt * 64 + key;
      if (kpos >= L) return z;
      const u16* src = cc < 8 ? p.kn + (size_t)(r0 + kpos) * 512 + hd * 64 + cc * 8 : KR + (size_t)(r0 + kpos) * 32 + (cc - 8) * 8;
      return *(const uint4*)src;
    } else {
      int c2 = c - 768, dv = c2 >> 3, kc = c2 & 7, kp0 = kt * 64 + kc * 8;
      if (kp0 >= L) return z;
      return *(const uint4*)(vtb + (size_t)dv * L + kp0);
    }
  };
  auto stc = [&](int buf, int c, uint4 v) {
    if (c < 768) { int key = c / 12, cc = c - key * 12; *(uint4*)(Ks + (buf * 64 + key) * 104 + cc * 8) = v; }
    else { int c2 = c - 768, dv = c2 >> 3, kc = c2 & 7; *(uint4*)(Vs + (buf * 64 + dv) * 72 + kc * 8) = v; }
  };
  rg[0] = ldc(0, tid); rg[1] = ldc(0, tid + 512); if (tid < 256) rg[2] = ldc(0, tid + 1024);
  stc(0, tid, rg[0]); stc(0, tid + 512, rg[1]); if (tid < 256) stc(0, tid + 1024, rg[2]);
  __syncthreads();
  for (int kt = 0; kt < nt; ++kt) {
    const int buf = kt & 1;
    if (kt + 1 < nt) { rg[0] = ldc(kt + 1, tid); rg[1] = ldc(kt + 1, tid + 512); if (tid < 256) rg[2] = ldc(kt + 1, tid + 1024); }
    if (wvalid) {
      f32x16 st[2];
#pragma unroll
      for (int t = 0; t < 2; ++t) {
#pragma unroll
        for (int r = 0; r < 16; ++r) st[t][r] = 0.f;
        const u16* kb = Ks + (buf * 64 + t * 32 + l32) * 104 + hh * 8;
#pragma unroll
        for (int ks = 0; ks < 6; ++ks) st[t] = MFMA(*(const bf16x8*)(kb + ks * 16), qf[ks], st[t]);
      }
      if (kt == nt - 1) {
#pragma unroll
        for (int t = 0; t < 2; ++t)
#pragma unroll
          for (int r = 0; r < 16; ++r) if (kt * 64 + t * 32 + crow(r, hh) >= L) st[t][r] = -1e30f;
      }
      float mx = -1e30f;
#pragma unroll
      for (int t = 0; t < 2; ++t)
#pragma unroll
        for (int r = 0; r < 16; ++r) mx = fmaxf(mx, st[t][r]);
      mx = fmaxf(mx, __shfl_xor(mx, 32));
      const float mnew = fmaxf(mrun, mx);
      const float alpha = __builtin_amdgcn_exp2f(mrun - mnew);
      float ls = 0.f;
#pragma unroll
      for (int t = 0; t < 2; ++t)
#pragma unroll
        for (int r = 0; r < 16; ++r) { float pv = __builtin_amdgcn_exp2f(st[t][r] - mnew); st[t][r] = pv; ls += pv; }
      lrun = lrun * alpha + ls; mrun = mnew;
#pragma unroll
      for (int u = 0; u < 2; ++u)
#pragma unroll
        for (int r = 0; r < 16; ++r) o[u][r] *= alpha;
#pragma unroll
      for (int t = 0; t < 2; ++t)
#pragma unroll
        for (int s2 = 0; s2 < 2; ++s2) {
          uint4 pk;
          pk.x = pack2(st[t][8 * s2 + 0], st[t][8 * s2 + 1]); pk.y = pack2(st[t][8 * s2 + 2], st[t][8 * s2 + 3]);
          pk.z = pack2(st[t][8 * s2 + 4], st[t][8 * s2 + 5]); pk.w = pack2(st[t][8 * s2 + 6], st[t][8 * s2 + 7]);
          bf16x8 pf = __builtin_bit_cast(bf16x8, pk);
#pragma unroll
          for (int u = 0; u < 2; ++u) {
            bf16x8 vf = *(const bf16x8*)(Vs + (buf * 64 + u * 32 + l32) * 72 + t * 32 + s2 * 16 + hh * 8);
            o[u] = MFMA(vf, pf, o[u]);
          }
        }
    }
    if (kt + 1 < nt) { stc(buf ^ 1, tid, rg[0]); stc(buf ^ 1, tid + 512, rg[1]); if (tid < 256) stc(buf ^ 1, tid + 1024, rg[2]); }
    __syncthreads();
  }
  if (wvalid) {
    float lt = lrun + __shfl_xor(lrun, 32);
    const float inv = 1.f / lt;
    if (qpos < L && dostore) {
      u16* dst = (u16*)p.out + (size_t)TP * 1024 + (size_t)(r0 + qpos) * 768 + hd * 96;
#pragma unroll
      for (int u = 0; u < 2; ++u)
#pragma unroll
        for (int gq = 0; gq < 4; ++gq)
          store4(dst + u * 32 + 8 * gq + 4 * hh, o[u][4 * gq] * inv, o[u][4 * gq + 1] * inv, o[u][4 * gq + 2] * inv, o[u][4 * gq + 3] * inv);
    }
  }
}

DI void scan_block(CP p, int layer, int s, int d, int hd, char* smem) {
  float* OP = (float*)smem;
  float* WA = OP + 32 * 392;
  float* YB = WA + 2 * 32 * 64;
  u16* XL = (u16*)(YB + 32 * 64);
  float* MU = (float*)(XL + 2 * 32 * 72);
  float* CS = MU + 5 * 2 * 64;
  const int tid = tidx(), lane = tid & 63, wv = tid >> 6, l32 = lane & 31, hh = lane >> 5;
  const int L = seq_len(s), r0 = seq_start(s);
  const int sj = tid >> 4, q = tid & 15;
  const int rloc = lane >> 3, cg8 = lane & 7, row = wv * 8 + rloc;
  const int aoff[5] = {hd * 64, 512 + hd * 64, 1024 + hd * 64, 1536 + d * 64, 1664 + d * 64};
  __syncthreads();
  for (int i = tid; i < 640; i += NTHR) {
    int a = i >> 7, w = (i >> 6) & 1, c = i & 63;
    int off = a == 0 ? aoff[0] : a == 1 ? aoff[1] : a == 2 ? aoff[2] : a == 3 ? aoff[3] : aoff[4];
    MU[i] = p.shift_mu[(size_t)(layer * 2 + w) * 1952 + off + c];
  }
  if (tid < 64) {
    CS[tid] = p.key_k_k[layer * 512 + hd * 64 + tid];
    CS[64 + tid] = p.key_k_a[layer * 512 + hd * 64 + tid];
    CS[128 + tid] = p.bonus_r_k[layer * 512 + hd * 64 + tid];
  }
  const int mat = (wv >> 1) & 1, ntile = wv & 1;
  bf16x8 wfr[4];
  {
    const u16* wb = p.wM + (mat ? OFF_A : OFF_DEC) + (size_t)(d * 512 + hd * 64 + ntile * 32 + l32) * 64 + hh * 8;
#pragma unroll
    for (int ks = 0; ks < 4; ++ks) wfr[ks] = *(const bf16x8*)(wb + ks * 16);
  }
  const float bias = mat ? p.iclr_a0[(size_t)(layer * 2 + d) * 512 + hd * 64 + ntile * 32 + l32]
                         : p.decay_w0[(size_t)(layer * 2 + d) * 512 + hd * 64 + ntile * 32 + l32];
  __syncthreads();
  float S[8];
#pragma unroll
  for (int i = 0; i < 8; ++i) S[i] = 0.f;
  const int nch = (L + 31) >> 5;
  uint2 raw[15];
  float r4[4], k4[4], kk4[4], v4[4];

  auto prefetch = [&](int c) {
    const int sidx = c * 32 + sj;
    const bool valid = sidx < L;
    const int tok = d == 0 ? sidx : L - 1 - sidx;
    const u16* base = p.regB + (size_t)(r0 + tok) * 1952 + 4 * q;
#pragma unroll
    for (int a = 0; a < 5; ++a) {
      const int off = a == 0 ? aoff[0] : a == 1 ? aoff[1] : a == 2 ? aoff[2] : a == 3 ? aoff[3] : aoff[4];
      raw[a * 3 + 0] = (valid && tok > 0) ? *(const uint2*)(base - 1952 + off) : make_uint2(0, 0);
      raw[a * 3 + 1] = valid ? *(const uint2*)(base + off) : make_uint2(0, 0);
      raw[a * 3 + 2] = (valid && tok + 1 < L) ? *(const uint2*)(base + 1952 + off) : make_uint2(0, 0);
    }
  };
  auto shift4 = [&](int a, float* x) {
    const float4 m0 = *(const float4*)(MU + (a * 2 + 0) * 64 + 4 * q);
    const float4 m1 = *(const float4*)(MU + (a * 2 + 1) * 64 + 4 * q);
    const uint2 pm = raw[a * 3], c = raw[a * 3 + 1], pp = raw[a * 3 + 2];
    float c0 = bflo(c.x), c1 = bfhi(c.x), c2 = bflo(c.y), c3 = bfhi(c.y);
    x[0] = c0 + m0.x * (bflo(pm.x) - c0) + m1.x * (bflo(pp.x) - c0);
    x[1] = c1 + m0.y * (bfhi(pm.x) - c1) + m1.y * (bfhi(pp.x) - c1);
    x[2] = c2 + m0.z * (bflo(pm.y) - c2) + m1.z * (bflo(pp.y) - c2);
    x[3] = c3 + m0.w * (bfhi(pm.y) - c3) + m1.w * (bfhi(pp.y) - c3);
  };
  auto stage = [&](int c) {
    shift4(0, r4); shift4(1, k4); shift4(2, v4);
    float xw[4], xa[4];
    shift4(3, xw); shift4(4, xa);
#pragma unroll
    for (int e = 0; e < 4; ++e) xw[e] = 1.f - 2.f / (__expf(2.f * xw[e]) + 1.f);
    store4(XL + sj * 72 + 4 * q, xw[0], xw[1], xw[2], xw[3]);
    store4(XL + 32 * 72 + sj * 72 + 4 * q, xa[0], xa[1], xa[2], xa[3]);
    {
      const float4 kkw = *(const float4*)(CS + 4 * q);
      float x0 = k4[0] * kkw.x, x1 = k4[1] * kkw.y, x2 = k4[2] * kkw.z, x3 = k4[3] * kkw.w;
      float ss = sum16(x0 * x0 + x1 * x1 + x2 * x2 + x3 * x3);
      float inv = 1.f / fmaxf(sqrtf(ss), 1e-12f);
      kk4[0] = x0 * inv; kk4[1] = x1 * inv; kk4[2] = x2 * inv; kk4[3] = x3 * inv;
    }
    __syncthreads();
    if (wv < 4) {
      f32x16 acc;
#pragma unroll
      for (int r = 0; r < 16; ++r) acc[r] = 0.f;
      const u16* xb = XL + mat * 32 * 72 + l32 * 72 + hh * 8;
#pragma unroll
      for (int ks = 0; ks < 4; ++ks) acc = MFMA(*(const bf16x8*)(xb + ks * 16), wfr[ks], acc);
#pragma unroll
      for (int r = 0; r < 16; ++r) {
        float x = acc[r] + bias;
        float sg = sigmoidf_(x);
        float val = mat ? sg : __expf(-0.6065306597126334f * sg);
        WA[(mat * 32 + crow(r, hh)) * 64 + ntile * 32 + l32] = val;
      }
    }
    __syncthreads();
    {
      const float4 w4 = *(const float4*)(WA + sj * 64 + 4 * q);
      const float4 a4 = *(const float4*)(WA + (32 + sj) * 64 + 4 * q);
      const float4 ka = *(const float4*)(CS + 64 + 4 * q);
      const float4 brk = *(const float4*)(CS + 128 + 4 * q);
      const float wv4[4] = {w4.x, w4.y, w4.z, w4.w}, av4[4] = {a4.x, a4.y, a4.z, a4.w};
      const float kav[4] = {ka.x, ka.y, ka.z, ka.w}, bkv[4] = {brk.x, brk.y, brk.z, brk.w};
      float aa[4], wr[4], bb[4], kd[4];
      float br = 0.f, kr = 0.f, bs = 0.f;
#pragma unroll
      for (int e = 0; e < 4; ++e) {
        aa[e] = -kk4[e]; wr[e] = wv4[e] * r4[e]; bb[e] = kk4[e] * av4[e];
        kd[e] = k4[e] * (1.f + (av4[e] - 1.f) * kav[e]);
        br += bb[e] * r4[e]; kr += kd[e] * r4[e]; bs += r4[e] * kd[e] * bkv[e];
      }
      br = sum16(br); kr = sum16(kr); bs = sum16(bs);
      float* o = OP + sj * 392 + 4 * q;
      *(float4*)(o) = make_float4(aa[0], aa[1], aa[2], aa[3]);
      *(float4*)(o + 64) = make_float4(wr[0], wr[1], wr[2], wr[3]);
      *(float4*)(o + 128) = w4;
      *(float4*)(o + 192) = make_float4(bb[0], bb[1], bb[2], bb[3]);
      *(float4*)(o + 256) = make_float4(kd[0], kd[1], kd[2], kd[3]);
      *(float4*)(o + 320) = make_float4(v4[0], v4[1], v4[2], v4[3]);
      if (q == 0) {
        OP[sj * 392 + 384] = br; OP[sj * 392 + 385] = kr;
        const int sidx = c * 32 + sj;
        if (sidx < L) { const int tok = d == 0 ? sidx : L - 1 - sidx; p.bsc[((size_t)d * TP + r0 + tok) * 8 + hd] = bs; }
      }
    }
    __syncthreads();
  };

  prefetch(0);
  stage(0);
  for (int c = 0; c < nch; ++c) {
    if (c + 1 < nch) prefetch(c + 1);
    const int nst = min(32, L - c * 32);
    for (int jj = 0; jj < nst; ++jj) {
      const float* o = OP + jj * 392;
      const float4 a0 = *(const float4*)(o + cg8 * 8), a1 = *(const float4*)(o + cg8 * 8 + 4);
      const float4 y0 = *(const float4*)(o + 64 + cg8 * 8), y1 = *(const float4*)(o + 64 + cg8 * 8 + 4);
      const float4 w0 = *(const float4*)(o + 128 + cg8 * 8), w1 = *(const float4*)(o + 128 + cg8 * 8 + 4);
      const float4 b0 = *(const float4*)(o + 192 + cg8 * 8), b1 = *(const float4*)(o + 192 + cg8 * 8 + 4);
      const float4 k0 = *(const float4*)(o + 256 + cg8 * 8), k1 = *(const float4*)(o + 256 + cg8 * 8 + 4);
      const float vv = o[320 + row];
      const float2 sc = *(const float2*)(o + 384);
      float da = S[0] * a0.x + S[1] * a0.y + S[2] * a0.z + S[3] * a0.w + S[4] * a1.x + S[5] * a1.y + S[6] * a1.z + S[7] * a1.w;
      float dy = S[0] * y0.x + S[1] * y0.y + S[2] * y0.z + S[3] * y0.w + S[4] * y1.x + S[5] * y1.y + S[6] * y1.z + S[7] * y1.w;
      da = dpp_sum8(da); dy = dpp_sum8(dy);
      const float yv = dy + da * sc.x + vv * sc.y;
      S[0] = S[0] * w0.x + da * b0.x + vv * k0.x; S[1] = S[1] * w0.y + da * b0.y + vv * k0.y;
      S[2] = S[2] * w0.z + da * b0.z + vv * k0.z; S[3] = S[3] * w0.w + da * b0.w + vv * k0.w;
      S[4] = S[4] * w1.x + da * b1.x + vv * k1.x; S[5] = S[5] * w1.y + da * b1.y + vv * k1.y;
      S[6] = S[6] * w1.z + da * b1.z + vv * k1.z; S[7] = S[7] * w1.w + da * b1.w + vv * k1.w;
      if (cg8 == 0) YB[jj * 64 + row] = yv;
    }
    __syncthreads();
    {
      const int sidx = c * 32 + sj;
      if (sidx < L) {
        const int tok = d == 0 ? sidx : L - 1 - sidx;
        const float4 yv = *(const float4*)(YB + sj * 64 + 4 * q);
        store4((u16*)p.out + (size_t)(r0 + tok) * 1024 + d * 512 + hd * 64 + 4 * q, yv.x, yv.y, yv.z, yv.w);
      }
    }
    if (c + 1 < nch) stage(c + 1);
  }
  __syncthreads();
}

typedef float f2 __attribute__((ext_vector_type(2)));
DI f2 mk2(float a, float b) { f2 r; r.x = a; r.y = b; return r; }
#define LDS_FENCE() asm volatile("s_waitcnt lgkmcnt(0)" ::: "memory")

template <int CPL>
DI void scan_block2(CP p, int layer, int s, int d, int hd, int rowhalf, char* smem) {
  float* OP = (float*)smem;
  float* YB = OP + 2 * 32 * 392;
  u16* XL = (u16*)(YB + 2 * 32 * 64);
  float* MU = (float*)(XL + 2 * 32 * 72);
  float* CS = MU + 640;
  u16* WL = (u16*)(CS + 192);
  const int tid = tidx(), lane = tid & 63, wv = tid >> 6, l32 = lane & 31, hh = lane >> 5;
  const int L = seq_len(s), r0 = seq_start(s);
  const int aoff0 = hd * 64, aoff1 = 512 + hd * 64, aoff2 = 1024 + hd * 64, aoff3 = 1536 + d * 64, aoff4 = 1664 + d * 64;
  __syncthreads();
  for (int i = tid; i < 640; i += NTHR) {
    int a = i >> 7, w = (i >> 6) & 1, c = i & 63;
    int off = a == 0 ? aoff0 : a == 1 ? aoff1 : a == 2 ? aoff2 : a == 3 ? aoff3 : aoff4;
    MU[i] = p.shift_mu[(size_t)(layer * 2 + w) * 1952 + off + c];
  }
#pragma unroll
  for (int i = 0; i < 2; ++i) {
    const int idx = tid + i * NTHR, mat = idx >> 9, col = (idx >> 3) & 63, kc = idx & 7;
    *(uint4*)(WL + (mat * 64 + col) * 72 + kc * 8) = *(const uint4*)(p.wM + (mat ? OFF_A : OFF_DEC) + (size_t)(d * 512 + hd * 64 + col) * 64 + kc * 8);
  }
  if (tid < 64) {
    CS[tid] = p.key_k_k[layer * 512 + hd * 64 + tid];
    CS[64 + tid] = p.key_k_a[layer * 512 + hd * 64 + tid];
    CS[128 + tid] = p.bonus_r_k[layer * 512 + hd * 64 + tid];
  }
  __syncthreads();
  const int nch = (L + 31) >> 5;

  if (wv >= 4) {
    const int sw = wv - 4;
    const int q = lane & 15;
    float bias[2][2];
#pragma unroll
    for (int mat = 0; mat < 2; ++mat)
#pragma unroll
      for (int nt2 = 0; nt2 < 2; ++nt2)
        bias[mat][nt2] = mat ? p.iclr_a0[(size_t)(layer * 2 + d) * 512 + hd * 64 + nt2 * 32 + l32]
                             : p.decay_w0[(size_t)(layer * 2 + d) * 512 + hd * 64 + nt2 * 32 + l32];
    uint2 raw[2][5];
    auto load_raw = [&](int c) {
#pragma unroll
      for (int u = 0; u < 2; ++u) {
        const int sj = 8 * sw + 4 * u + (lane >> 4);
        const int sidc = min(c * 32 + sj, L - 1);
        const int tok = d == 0 ? sidc : L - 1 - sidc;
        const u16* base = p.regB + (size_t)(r0 + tok) * 1952 + 4 * q;
        raw[u][0] = *(const uint2*)(base + aoff0); raw[u][1] = *(const uint2*)(base + aoff1); raw[u][2] = *(const uint2*)(base + aoff2);
        raw[u][3] = *(const uint2*)(base + aoff3); raw[u][4] = *(const uint2*)(base + aoff4);
      }
    };
    auto stage = [&](int c) {
      float r4[2][4], k4[2][4], kk4[2][4], v4[2][4];
#pragma unroll
      for (int u = 0; u < 2; ++u) {
        const int sj = 8 * sw + 4 * u + (lane >> 4);
        r4[u][0] = bflo(raw[u][0].x); r4[u][1] = bfhi(raw[u][0].x); r4[u][2] = bflo(raw[u][0].y); r4[u][3] = bfhi(raw[u][0].y);
        k4[u][0] = bflo(raw[u][1].x); k4[u][1] = bfhi(raw[u][1].x); k4[u][2] = bflo(raw[u][1].y); k4[u][3] = bfhi(raw[u][1].y);
        v4[u][0] = bflo(raw[u][2].x); v4[u][1] = bfhi(raw[u][2].x); v4[u][2] = bflo(raw[u][2].y); v4[u][3] = bfhi(raw[u][2].y);
        *(uint2*)(XL + sj * 72 + 4 * q) = raw[u][3];
        *(uint2*)(XL + 32 * 72 + sj * 72 + 4 * q) = raw[u][4];
        const float4 kkw = *(const float4*)(CS + 4 * q);
        float x0 = k4[u][0] * kkw.x, x1 = k4[u][1] * kkw.y, x2 = k4[u][2] * kkw.z, x3 = k4[u][3] * kkw.w;
        float ss = sum16(x0 * x0 + x1 * x1 + x2 * x2 + x3 * x3);
        float inv = __builtin_amdgcn_rsqf(fmaxf(ss, 1e-24f));
        kk4[u][0] = x0 * inv; kk4[u][1] = x1 * inv; kk4[u][2] = x2 * inv; kk4[u][3] = x3 * inv;
      }
      LDS_FENCE();
      float* OPn = OP + (c & 1) * 32 * 392;
#pragma unroll
      for (int mat = 0; mat < 2; ++mat)
#pragma unroll
        for (int nt2 = 0; nt2 < 2; ++nt2) {
          f32x16 acc;
#pragma unroll
          for (int r = 0; r < 16; ++r) acc[r] = 0.f;
          const u16* xb = XL + mat * 32 * 72 + (8 * sw + (l32 & 7)) * 72 + hh * 8;
#pragma unroll
          for (int ks = 0; ks < 4; ++ks) acc = MFMA(*(const bf16x8*)(xb + ks * 16), *(const bf16x8*)(WL + (mat * 64 + nt2 * 32 + l32) * 72 + ks * 16 + hh * 8), acc);
#pragma unroll
          for (int r = 0; r < 4; ++r) {
            float x = acc[r] + bias[mat][nt2];
            float sg = sigmoidf_(x);
            float val = mat ? sg : __expf(-0.6065306597126334f * sg);
            OPn[(8 * sw + 4 * hh + r) * 392 + (mat ? 0 : 128) + nt2 * 32 + l32] = val;
          }
        }
      LDS_FENCE();
#pragma unroll
      for (int u = 0; u < 2; ++u) {
        const int sj = 8 * sw + 4 * u + (lane >> 4);
        const float4 w4 = *(const float4*)(OPn + sj * 392 + 128 + 4 * q);
        const float4 a4 = *(const float4*)(OPn + sj * 392 + 4 * q);
        const float4 ka = *(const float4*)(CS + 64 + 4 * q);
        const float4 brk = *(const float4*)(CS + 128 + 4 * q);
        const float wv4[4] = {w4.x, w4.y, w4.z, w4.w}, av4[4] = {a4.x, a4.y, a4.z, a4.w};
        const float kav[4] = {ka.x, ka.y, ka.z, ka.w}, bkv[4] = {brk.x, brk.y, brk.z, brk.w};
        float aa[4], wr[4], bb[4], kd[4];
        float br = 0.f, kr = 0.f, bs = 0.f;
#pragma unroll
        for (int e = 0; e < 4; ++e) {
          aa[e] = -kk4[u][e]; wr[e] = wv4[e] * r4[u][e]; bb[e] = kk4[u][e] * av4[e];
          kd[e] = k4[u][e] * (1.f + (av4[e] - 1.f) * kav[e]);
          br += bb[e] * r4[u][e]; kr += kd[e] * r4[u][e]; bs += r4[u][e] * kd[e] * bkv[e];
        }
        br = sum16(br); kr = sum16(kr); bs = sum16(bs);
        float* o = OPn + sj * 392 + 4 * q;
        *(float4*)(o) = make_float4(aa[0], aa[1], aa[2], aa[3]);
        *(float4*)(o + 64) = make_float4(wr[0], wr[1], wr[2], wr[3]);
        *(float4*)(o + 128) = w4;
        *(float4*)(o + 192) = make_float4(bb[0], bb[1], bb[2], bb[3]);
        *(float4*)(o + 256) = make_float4(kd[0], kd[1], kd[2], kd[3]);
        *(float4*)(o + 320) = make_float4(v4[u][0], v4[u][1], v4[u][2], v4[u][3]);
        if (q == 0) {
          OPn[sj * 392 + 384] = br; OPn[sj * 392 + 385] = kr;
          const int sidx = c * 32 + sj;
          if (sidx < L && rowhalf == 0) { const int tok = d == 0 ? sidx : L - 1 - sidx; p.bsc[((size_t)d * TP + r0 + tok) * 8 + hd] = bs; }
        }
      }
    };
    auto writeout = [&](int c) {
      const float* yb = YB + (c & 1) * 2048;
#pragma unroll
      for (int u = 0; u < 2; ++u) {
        const int sj = 8 * sw + 4 * u + (lane >> 4);
        const int sidx = c * 32 + sj;
        const bool mine = CPL == 16 ? true : ((q >> 3) == rowhalf);
        if (sidx < L && mine) {
          const int tok = d == 0 ? sidx : L - 1 - sidx;
          const float4 yv = *(const float4*)(yb + sj * 64 + 4 * q);
          store4((u16*)p.out + (size_t)(r0 + tok) * 1024 + d * 512 + hd * 64 + 4 * q, yv.x, yv.y, yv.z, yv.w);
        }
      }
    };
    load_raw(0);
    stage(0);
    if (nch > 1) load_raw(1);
    __syncthreads();
    for (int c = 0; c < nch; ++c) {
      if (c + 1 < nch) { stage(c + 1); if (c + 2 < nch) load_raw(c + 2); }
      if (c >= 1) writeout(c - 1);
      __syncthreads();
    }
    writeout(nch - 1);
  } else {
    constexpr int LPRW = 64 / CPL;
    constexpr int NV = CPL / 2;
    const int cg = lane % LPRW;
    const int row = (CPL == 8 ? rowhalf * 32 + wv * 8 : wv * 16) + lane / LPRW;
    f2 S[NV];
#pragma unroll
    for (int i = 0; i < NV; ++i) S[i] = mk2(0.f, 0.f);
    __builtin_amdgcn_s_setprio(3);
    __syncthreads();
    for (int c = 0; c < nch; ++c) {
      const int nst = min(32, L - c * 32);
      const float* ob = OP + (c & 1) * 32 * 392;
      float* yb = YB + (c & 1) * 2048;
      float* ydst = cg == 0 ? yb + row : (float*)(smem + 147712) + lane;
      const int ystride = cg == 0 ? 64 : 0;
      float4 ca[CPL / 4], cy[CPL / 4], cw[CPL / 4], cb[CPL / 4], ck[CPL / 4];
      float cvv; float2 csc;
      {
        const float* o = ob + cg * CPL;
#pragma unroll
        for (int i = 0; i < CPL / 4; ++i) {
          ca[i] = *(const float4*)(o + 4 * i); cy[i] = *(const float4*)(o + 64 + 4 * i); cw[i] = *(const float4*)(o + 128 + 4 * i);
          cb[i] = *(const float4*)(o + 192 + 4 * i); ck[i] = *(const float4*)(o + 256 + 4 * i);
        }
        cvv = ob[320 + row]; csc = *(const float2*)(ob + 384);
      }
#pragma unroll 4
      for (int jj = 0; jj < nst; ++jj) {
        float4 na[CPL / 4], ny[CPL / 4], nw[CPL / 4], nb[CPL / 4], nk[CPL / 4];
        float nvv; float2 nsc;
        {
          const int jn = jj + 1;
          const float* o = ob + jn * 392 + cg * CPL;
#pragma unroll
          for (int i = 0; i < CPL / 4; ++i) {
            na[i] = *(const float4*)(o + 4 * i); ny[i] = *(const float4*)(o + 64 + 4 * i); nw[i] = *(const float4*)(o + 128 + 4 * i);
            nb[i] = *(const float4*)(o + 192 + 4 * i); nk[i] = *(const float4*)(o + 256 + 4 * i);
          }
          nvv = ob[jn * 392 + 320 + row]; nsc = *(const float2*)(ob + jn * 392 + 384);
        }
        f2 A[NV], Y[NV], W[NV], B[NV], K[NV];
#pragma unroll
        for (int i = 0; i < CPL / 4; ++i) {
          A[2 * i] = mk2(ca[i].x, ca[i].y); A[2 * i + 1] = mk2(ca[i].z, ca[i].w);
          Y[2 * i] = mk2(cy[i].x, cy[i].y); Y[2 * i + 1] = mk2(cy[i].z, cy[i].w);
          W[2 * i] = mk2(cw[i].x, cw[i].y); W[2 * i + 1] = mk2(cw[i].z, cw[i].w);
          B[2 * i] = mk2(cb[i].x, cb[i].y); B[2 * i + 1] = mk2(cb[i].z, cb[i].w);
          K[2 * i] = mk2(ck[i].x, ck[i].y); K[2 * i + 1] = mk2(ck[i].z, ck[i].w);
        }
        const float vv = cvv;
        f2 pa0 = S[0] * A[0], pa1 = S[1] * A[1], py0 = S[0] * Y[0], py1 = S[1] * Y[1];
#pragma unroll
        for (int i = 2; i < NV; i += 2) {
          pa0 = S[i] * A[i] + pa0; pa1 = S[i + 1] * A[i + 1] + pa1;
          py0 = S[i] * Y[i] + py0; py1 = S[i + 1] * Y[i + 1] + py1;
        }
        pa0 = pa0 + pa1; py0 = py0 + py1;
        float da = pa0.x + pa0.y, dy = py0.x + py0.y;
        const f2 vvv = mk2(vv, vv);
        f2 SW[NV];
#pragma unroll
        for (int i = 0; i < NV; ++i) SW[i] = S[i] * W[i] + vvv * K[i];
        da += __int_as_float(__builtin_amdgcn_update_dpp(0, __float_as_int(da), 0xB1, 0xf, 0xf, false));
        dy += __int_as_float(__builtin_amdgcn_update_dpp(0, __float_as_int(dy), 0xB1, 0xf, 0xf, false));
        da += __int_as_float(__builtin_amdgcn_update_dpp(0, __float_as_int(da), 0x4E, 0xf, 0xf, false));
        dy += __int_as_float(__builtin_amdgcn_update_dpp(0, __float_as_int(dy), 0x4E, 0xf, 0xf, false));
        if (CPL == 8) {
          da += __int_as_float(__builtin_amdgcn_update_dpp(0, __float_as_int(da), 0x141, 0xf, 0xf, false));
          dy += __int_as_float(__builtin_amdgcn_update_dpp(0, __float_as_int(dy), 0x141, 0xf, 0xf, false));
        }
        const f2 dav = mk2(da, da);
#pragma unroll
        for (int i = 0; i < NV; ++i) S[i] = dav * B[i] + SW[i];
        const float yv = dy + da * csc.x + vv * csc.y;
        ydst[jj * ystride] = yv;
#pragma unroll
        for (int i = 0; i < CPL / 4; ++i) { ca[i] = na[i]; cy[i] = ny[i]; cw[i] = nw[i]; cb[i] = nb[i]; ck[i] = nk[i]; }
        cvv = nvv; csc = nsc;
      }
      __syncthreads();
    }
    __builtin_amdgcn_s_setprio(0);
  }
  __syncthreads();
}

DI void shift_item(CP p, int layer, int ch, char* smem) {
  const int tid = tidx();
  int s, c;
  if (ch < 258) { s = ch / 129; c = ch - s * 129; } else { int x = ch - 258; s = 2 + x / 33; c = x - (s - 2) * 33; }
  const int L = seq_len(s), r0 = seq_start(s) + c * 64;
  const int nrows = min(64, L - c * 64);
  const int cgp = tid & 255, rg = tid >> 8;
  const int col = cgp * 8;
  const int rlo = rg * 32, rhi = min(rlo + 32, nrows);
  const bool act = cgp < 244 && rlo < nrows;
  typedef unsigned u32x4 __attribute__((ext_vector_type(4)));
  u32x4 prev = {0u, 0u, 0u, 0u}, cur = prev, lastn = prev;
  float mu0[8], mu1[8];
  u16* base = p.regB + (size_t)r0 * 1952 + col;
  if (act) {
#pragma unroll
    for (int e = 0; e < 8; ++e) { mu0[e] = p.shift_mu[(size_t)(layer * 2) * 1952 + col + e]; mu1[e] = p.shift_mu[(size_t)(layer * 2 + 1) * 1952 + col + e]; }
    if (rlo > 0) prev = *(const u32x4*)(base + (size_t)(rlo - 1) * 1952);
    else if (c > 0) prev = *(const u32x4*)(halo_ptr(p) + ((size_t)(ch - 1) * 2 + 1) * 1952 + col);
    cur = *(const u32x4*)(base + (size_t)rlo * 1952);
    if (rhi < nrows) lastn = *(const u32x4*)(base + (size_t)rhi * 1952);
    else if (c * 64 + nrows < L) lastn = *(const u32x4*)(halo_ptr(p) + ((size_t)(ch + 1) * 2) * 1952 + col);
  }
  __syncthreads();
  if (act) {
    const int kind = col < 1536 ? 0 : col < 1664 ? 1 : col < 1792 ? 0 : 2;
    for (int rb = rlo; rb < rhi; rb += 8) {
      u32x4 rw[9];
      rw[0] = cur;
#pragma unroll
      for (int i = 1; i < 9; ++i) { const int r = rb + i; rw[i] = (r < rhi) ? *(const u32x4*)(base + (size_t)r * 1952) : lastn; }
#pragma unroll
      for (int i = 0; i < 8; ++i) {
        const u32x4 cc = rw[i], nn = rw[i + 1];
        const unsigned pc[4] = {cc.x, cc.y, cc.z, cc.w}, pm[4] = {prev.x, prev.y, prev.z, prev.w}, pn[4] = {nn.x, nn.y, nn.z, nn.w};
        unsigned o[4];
#pragma unroll
        for (int e = 0; e < 4; ++e) {
          float c0 = bflo(pc[e]), c1 = bfhi(pc[e]);
          float x0 = c0 + mu0[2 * e] * (bflo(pm[e]) - c0) + mu1[2 * e] * (bflo(pn[e]) - c0);
          float x1 = c1 + mu0[2 * e + 1] * (bfhi(pm[e]) - c1) + mu1[2 * e + 1] * (bfhi(pn[e]) - c1);
          if (kind == 1) { x0 = 1.f - 2.f * __builtin_amdgcn_rcpf(__expf(2.f * x0) + 1.f); x1 = 1.f - 2.f * __builtin_amdgcn_rcpf(__expf(2.f * x1) + 1.f); }
          else if (kind == 2) { x0 = sigmoidf_(x0); x1 = sigmoidf_(x1); }
          o[e] = pack2(x0, x1);
        }
        { u32x4 ov = {o[0], o[1], o[2], o[3]}; *(u32x4*)(base + (size_t)(rb + i) * 1952) = ov; }
        prev = cc;
      }
      cur = rw[8];
    }
  }
  __syncthreads();
}

DI void init_rows(CP p, int item) {
  const int lane = tidx() & 63, wv = tidx() >> 6;
  const int r = item * 8 + wv;
  if (r >= TP) return;
  u16* dst = p.hb + (size_t)r * 1024 + lane * 16;
  float ss = 0.f;
  if (r < T) {
    int s, pos, L; row2seq(r, s, pos, L);
    const float* src = pos < 16 ? p.meta + pos * 1024
                     : (s < 2 ? p.x_prompt + ((size_t)s * 8192 + pos - 16) * 1024 : p.x_sample + ((size_t)(s - 2) * 2048 + pos - 16) * 1024);
    src += lane * 16;
    unsigned pk[8];
#pragma unroll
    for (int i = 0; i < 4; ++i) {
      float4 v = *(const float4*)(src + 4 * i);
      pk[2 * i] = pack2(v.x, v.y); pk[2 * i + 1] = pack2(v.z, v.w);
      float a = bflo(pk[2 * i]), b = bfhi(pk[2 * i]), c = bflo(pk[2 * i + 1]), dd = bfhi(pk[2 * i + 1]);
      ss += a * a + b * b + c * c + dd * dd;
    }
    *(uint4*)dst = make_uint4(pk[0], pk[1], pk[2], pk[3]);
    *(uint4*)(dst + 8) = make_uint4(pk[4], pk[5], pk[6], pk[7]);
  } else {
    *(uint4*)dst = make_uint4(0, 0, 0, 0);
    *(uint4*)(dst + 8) = make_uint4(0, 0, 0, 0);
  }
#pragma unroll
  for (int o = 32; o > 0; o >>= 1) ss += __shfl_xor(ss, o);
  if (lane < 16) p.ssq[(size_t)lane * TP + r] = lane == 0 ? ss : 0.f;
}
DI void init_rope(CP p, int item) {
  const int idx = item * NTHR + tidx();
  if (idx >= LPR * 16) return;
  const int pos = idx >> 4, i = idx & 15;
  double rev = (double)pos * ROPE_INV[i] * 0.15915494309189535;
  rev -= rint(rev);
  const float fr = (float)rev;
  p.ropec[idx] = __builtin_amdgcn_cosf(fr);
  p.ropes[idx] = __builtin_amdgcn_sinf(fr);
}
DI void final_rows(CP p, int item) {
  const int lane = tidx() & 63, wv = tidx() >> 6;
  const int orow = item * 8 + wv;
  int r;
  if (orow < 16384) { int s = orow >> 13; r = s * LPR + 16 + (orow & 8191); }
  else { int x = orow - 16384; int s = x >> 11; r = 2 * LPR + s * LSM + 16 + (x & 2047); }
  const float rs = rstd16(p.ssq, r);
  const u16* src = p.hb + (size_t)r * 1024 + lane * 16;
  uint4 a = *(const uint4*)src, b = *(const uint4*)(src + 8);
  unsigned w[8] = {a.x, a.y, a.z, a.w, b.x, b.y, b.z, b.w};
  float* dst = p.out + (size_t)orow * 1024 + lane * 16;
  const float* gn = p.final_norm + lane * 16;
#pragma unroll
  for (int i = 0; i < 4; ++i) {
    float4 o;
    o.x = bflo(w[2 * i]) * rs * gn[4 * i]; o.y = bfhi(w[2 * i]) * rs * gn[4 * i + 1];
    o.z = bflo(w[2 * i + 1]) * rs * gn[4 * i + 2]; o.w = bfhi(w[2 * i + 1]) * rs * gn[4 * i + 3];
    *(float4*)(dst + 4 * i) = o;
  }
}

#define XB_TMO      128
#define XB_XCNT(j)  (256  + 64 * (j))
#define XB_XSUB(j)  (1280 + 64 * (j))
#define XB_XGEN(j)  (2304 + 64 * (j))
#define XB_TOP      3328
#define XB_TOPGEN   3392
#define XCD_BAR_WORDS 3456
#define XB_SPIN_CAP (1u << 18)
#define LAS __attribute__((address_space(3)))

__device__ __forceinline__ unsigned xb_ld(unsigned* p)              { return __hip_atomic_load(p, __ATOMIC_RELAXED, __HIP_MEMORY_SCOPE_AGENT); }
__device__ __forceinline__ unsigned xb_add(unsigned* p, unsigned v) { return __hip_atomic_fetch_add(p, v, __ATOMIC_RELAXED, __HIP_MEMORY_SCOPE_AGENT); }
__device__ __forceinline__ unsigned xb_xcc_id() { return (unsigned)__builtin_amdgcn_s_getreg((3 << 11) | 20) & 0xFu; }
#define XB_SPIN(cond, bar) do { unsigned _sp = 0; while (cond) { __builtin_amdgcn_s_sleep(1); \
    if ((++_sp & 255u) == 0u) { if (xb_ld(&(bar)[XB_TMO])) break; if (_sp > XB_SPIN_CAP) { atomicAdd(&(bar)[XB_TMO], 1u); break; } } } } while (0)

struct XcdBarrier {
    unsigned* bar; unsigned x;
    volatile LAS unsigned* st;
};

__device__ __forceinline__ XcdBarrier xcd_barrier_post(unsigned* bar, volatile LAS unsigned* st) {
    XcdBarrier b; b.bar = bar; b.x = xb_xcc_id(); b.st = st;
    if (threadIdx.x == 0) (void)xb_add(&bar[XB_XCNT(b.x)], 1u);
    return b;
}
__device__ __forceinline__ void xcd_barrier_complete(unsigned* bar, unsigned x, unsigned& nloc, unsigned& nx) {
    const unsigned G = gridDim.x * gridDim.y * gridDim.z;
    unsigned sum, cnt, mine, sp = 0u;
    for (;;) {
        sum = 0u; cnt = 0u; mine = 0u;
#pragma unroll
        for (unsigned j = 0; j < 16; ++j) { const unsigned c = xb_ld(&bar[XB_XCNT(j)]); sum += c; cnt += (c > 0u) ? 1u : 0u; mine = (j == x) ? c : mine; }
        if (sum == G) break;
        __builtin_amdgcn_s_sleep(1);
        if ((++sp & 255u) == 0u) { if (xb_ld(&bar[XB_TMO])) break; if (sp > XB_SPIN_CAP) { atomicAdd(&bar[XB_TMO], 1u); break; } }
    }
    nloc = mine > 0u ? mine : 1u; nx = cnt > 0u ? cnt : 1u;
}

__device__ __forceinline__ void xcd_barrier(const XcdBarrier& b) {
    asm volatile("s_waitcnt vmcnt(0)" ::: "memory");
    __syncthreads();
    if (threadIdx.x == 0) {
        unsigned* bar = b.bar;
        __builtin_amdgcn_s_waitcnt(0);
        unsigned nloc = b.st[0], nx = b.st[1];
        if (nloc == 0u) { xcd_barrier_complete(bar, b.x, nloc, nx); b.st[0] = nloc; b.st[1] = nx; }
        const unsigned old = xb_add(&bar[XB_XSUB(b.x)], 1u);
        const unsigned gen = old / nloc;
        if (old + 1u == (gen + 1u) * nloc) {
            __builtin_amdgcn_fence(__ATOMIC_RELEASE, "agent");
            asm volatile("s_waitcnt vmcnt(0)" ::: "memory");
            const unsigned og = xb_add(&bar[XB_TOP], 1u);
            const unsigned tg = og / nx;
            if (og + 1u == (tg + 1u) * nx) xb_add(&bar[XB_TOPGEN], 1u);
            else XB_SPIN(xb_ld(&bar[XB_TOPGEN]) == tg, bar);
            __builtin_amdgcn_fence(__ATOMIC_ACQUIRE, "agent");
            xb_add(&bar[XB_XGEN(b.x)], 1u);
            asm volatile("s_waitcnt vmcnt(0)" ::: "memory");
        } else {
            XB_SPIN(xb_ld(&bar[XB_XGEN(b.x)]) == gen, bar);
            __builtin_amdgcn_fence(__ATOMIC_ACQUIRE, "agent");
            asm volatile("s_waitcnt vmcnt(0)" ::: "memory");
        }
    }
    __syncthreads();
}

constexpr int NPHASE = 21;
#ifndef ONLY
#define EN(x) true
#else
#define EN(x) ((x) == ONLY)
#endif
DI void run_phase(CP p, int ph, char* smem) {
  const int bid = blockIdx.x, nb = gridDim.x;
  const int fidx = (bid & 7) ? (bid >> 3) * 7 + (bid & 7) - 1 : -1, nfill = (nb >> 3) * 7;
  if (EN(100) && ph == 0) {
    const int n0 = NCONV_FFN, n1 = n0, n2 = n1 + TP / 8, n3 = n2 + (LPR * 16 + NTHR - 1) / NTHR;
    for (int it = bid; it < n3; it += nb) {
      if (it < n0) conv_ffn(p, 0, 0, it, smem);
      else if (it < n2) init_rows(p, it - n1);
      else init_rope(p, it - n2);
    }
    if (bid == 0 && tidx() < 4) p.ctr[tidx()] = 0u;
    return;
  }
  if (ph == 10) return;
  if (EN(102) && ph == 20) { for (int it = bid; it < 4096; it += nb) final_rows(p, it); return; }
  const int layer = ph > 10 ? 1 : 0;
  const int k = ph - (layer ? 11 : 1);
  GArgs g{};
  g.layer = layer; g.scale = 1.f;
  u16* outb = (u16*)p.out;
  switch (k) {
    case 0: case 7: if (EN(0)) {
      g.a0 = p.hb; g.ld0 = 1024; g.split = 1 << 30; g.ks0 = 64; g.a1 = p.hb; g.ld1 = 1024; g.W = (layer == 1 && k == 0) ? p.kn : p.wF; g.K = 1024;
      gemm_phase<0, EPI_UP, 256>(p, g, 22, smem);
      if (k == 7 && layer == 0 && fidx >= 0) for (int it = fidx; it < NCONV_FFN; it += nfill) conv_ffn(p, 1, 0, it, smem);
    } break;
    case 1: case 8: if (EN(1)) {
      g.a0 = p.regB; g.ld0 = 1408; g.split = 22; g.ks0 = 64; g.a1 = outb; g.ld1 = 1408; g.W = ((layer == 1 && k == 1) ? p.kn : p.wF) + OFF_WD; g.K = 2816; g.scale = 0.5f;
      gemm_phase<0, EPI_RES, 256>(p, g, 4, smem);
      if (layer == 0 && fidx >= 0) for (int it = fidx; it < NCONV_MIX; it += nfill) conv_mix(p, k == 1 ? 0 : 1, it, smem);
    } break;
    case 2: if (EN(2)) {
      g.a0 = p.hb; g.ld0 = 1024; g.split = 1 << 30; g.ks0 = 64; g.a1 = p.hb; g.ld1 = 1024; g.W = p.wM + OFF_IN; g.K = 1024;
      gemm_phase<0, EPI_INPROJ, 256>(p, g, 10, smem);
    } break;
    case 3: if (EN(3)) {
      const int nq = NMT * 6, nkv = NMT * 8, nsh = 522, ntot = nq + nkv + nsh;
      for (int it = bid; it < ntot; it += nb) {
        if (it < nq) {
          g.a0 = outb; g.ld0 = 512; g.split = 1 << 30; g.ks0 = 64; g.a1 = outb; g.ld1 = 512; g.W = p.wM + OFF_UQ; g.K = 256;
          gemm_phase_item<0, EPI_Q>(p, g, it, 6, smem);
        } else if (it < nq + nkv) {
          g.a0 = outb + 256; g.ld0 = 512; g.split = 1 << 30; g.ks0 = 64; g.a1 = outb; g.ld1 = 512; g.W = p.wM + OFF_UKV; g.K = 128;
          gemm_phase_item<0, EPI_KV>(p, g, it - nq, 8, smem);
        } else shift_item(p, layer, it - nq - nkv, smem);
      }
    } break;
    case 4: if (EN(4)) {
      for (int sc = bid; sc < 192; sc += nb) {
        if (sc < 64) { int x = sc >> 1; scan_block2<8>(p, layer, x >> 4, (x >> 3) & 1, x & 7, sc & 1, smem); }
        else { int x = sc - 64; scan_block2<16>(p, layer, 2 + (x >> 4), (x >> 3) & 1, x & 7, 0, smem); }
      }
      unsigned* bc = (unsigned*)(smem + SMEM_BYTES - 16);
      while (true) {
        __syncthreads();
        if (tidx() == 0) *bc = atomicAdd(p.ctr + layer, 1u);
        __syncthreads();
        const int it = (int)*bc;
        if (it >= 1104 + NCONV_FFN) break;
        if (it >= 1104) { conv_ffn(p, layer, 1, it - 1104, smem); continue; }
        int s, hd, qb;
        if (it < 528) { s = it / 264; int rem = it - s * 264; hd = rem / 33; qb = rem - hd * 33; }
        else { int x = it - 528; s = 2 + x / 72; int rem = x % 72; hd = rem / 9; qb = rem - hd * 9; }
#ifdef PROBE_ATT2
        attn_item(p, s, hd, qb, smem, p.ctr[8] == 12345u);
        __syncthreads();
#endif
        attn_item(p, s, hd, qb, smem);
      }
    } break;
    case 5: if (EN(5)) {
      g.W = p.wM + OFF_G; g.K = 192; g.a0 = p.regB + 1792; g.a1 = g.a0; g.ld0 = g.ld1 = 1952; g.split = 1 << 30; g.ks0 = 64;
      gemm_phase<0, EPI_POST, 256>(p, g, 2, smem);
    } break;
    case 6: if (EN(6)) {
      g.a0 = outb + (size_t)TP * 1024; g.ld0 = 768; g.split = 8; g.ks0 = 96; g.a1 = outb; g.ld1 = 1024; g.W = p.wM + OFF_OUT; g.K = 1024;
      gemm_phase<0, EPI_RES, 256>(p, g, 4, smem);
    } break;
  }
}

template <bool COOP>
__global__ void __launch_bounds__(NTHR) mega(Params pp, int lo, int hi) {
  extern __shared__ __attribute__((aligned(16))) char smem[];
  const __attribute__((address_space(4))) Params* kp = (const __attribute__((address_space(4))) Params*)__builtin_amdgcn_kernarg_segment_ptr();
  volatile LAS unsigned* st = (volatile LAS unsigned*)(smem + SMEM_BYTES - 32);
  if (threadIdx.x == 0) { st[0] = 0u; st[1] = 0u; }
  __syncthreads();
  XcdBarrier xb = xcd_barrier_post(kp->bar, st);
  for (int ph = lo; ph < hi; ++ph) {
    if (ph == 10) continue;
    asm volatile("" : "+s"(kp));
    run_phase(*kp, ph, smem);
    if (COOP && ph + 1 < hi) {
      if (ph == 0) cg::this_grid().sync();
      else xcd_barrier(xb);
    }
  }
}

extern "C" void kernel_launch(void* const* d_in, const int* in_sizes, int n_in, void* d_out, int out_size, void* d_ws, size_t ws_size,
                              hipStream_t stream) {
  Params p{};
  const float** pf = (const float**)&p;
  for (int i = 0; i < 30; ++i) pf[i] = (const float*)d_in[i];
  p.out = (float*)d_out;
  char* w = (char*)d_ws;
  size_t off = 0;
  auto take = [&](size_t bytes) { char* r = w + off; off += (bytes + 255) & ~(size_t)255; return r; };
  p.hb = (u16*)take((size_t)TP * 1024 * 2);
  p.regB = (u16*)take((size_t)TP * 1952 * 2);
  p.kn = (u16*)take((size_t)TP * 512 * 2);
  p.vt = (u16*)take((size_t)TP * 512 * 2);
  p.wF = (u16*)take((size_t)WF_ELEMS * 2);
  p.wM = (u16*)take((size_t)WM_ELEMS * 2);
  p.ssq = (float*)take((size_t)16 * TP * 4);
  p.ssqq = (float*)take((size_t)6 * TP * 4);
  p.bsc = (float*)take((size_t)2 * TP * 8 * 4);
  p.ropec = (float*)take((size_t)LPR * 16 * 4);
  p.ropes = (float*)take((size_t)LPR * 16 * 4);
  p.ctr = (unsigned*)take(256);
  p.bar = (unsigned*)take((size_t)XCD_BAR_WORDS * 4);
  if (off > ws_size) fprintf(stderr, "workspace too small: need %zu have %zu\n", off, ws_size);
#ifndef MULTI_LAUNCH
  static int grid_blocks = 0;
  if (!grid_blocks) {
    hipFuncSetAttribute((const void*)mega<true>, hipFuncAttributeMaxDynamicSharedMemorySize, SMEM_BYTES);
    int dev = 0, cus = 0, per_cu = 0;
    hipGetDevice(&dev);
    hipDeviceGetAttribute(&cus, hipDeviceAttributeMultiprocessorCount, dev);
    hipOccupancyMaxActiveBlocksPerMultiprocessor(&per_cu, mega<true>, NTHR, SMEM_BYTES);
    if (per_cu > 1) per_cu = 1;
    grid_blocks = cus * per_cu;
  }
  hipMemsetAsync(p.bar, 0, (size_t)XCD_BAR_WORDS * 4, stream);
  int lo = 0, hi = NPHASE;
  void* args[] = {&p, &lo, &hi};
  hipError_t e = hipLaunchCooperativeKernel((void*)mega<true>, dim3(grid_blocks), dim3(NTHR), args, SMEM_BYTES, stream);
  if (e != hipSuccess) fprintf(stderr, "cooperative launch failed: %s (grid %d)\n", hipGetErrorString(e), grid_blocks);
#else
  hipFuncSetAttribute((const void*)mega<false>, hipFuncAttributeMaxDynamicSharedMemorySize, SMEM_BYTES);
  for (int ph = 0; ph < NPHASE; ++ph) mega<false><<<256, NTHR, SMEM_BYTES, stream>>>(p, ph, ph + 1);
#endif
}
```

```cpp
#include <hip/hip_runtime.h>
#include <hip/hip_cooperative_groups.h>
#include <cstdio>
namespace cg = cooperative_groups;

typedef unsigned short u16;
typedef __attribute__((ext_vector_type(8))) short bf16x8;
typedef __attribute__((ext_vector_type(16))) float f32x16;
#define DI __device__ __forceinline__
#define MFMA(a, b, c) __builtin_amdgcn_mfma_f32_32x32x16_bf16((a), (b), (c), 0, 0, 0)

constexpr int T = 32928, TP = 33024, LPR = 8208, LSM = 2064, NMT = 129;
constexpr int NTHR = 512;
constexpr float RMS_EPS = 1e-6f, LNX_EPS = 64e-5f;
constexpr float QSCALE = 0.10206207261596575f * 1.4426950408889634f;
constexpr int OFF_IN = 0, OFF_UQ = 2621440, OFF_UKV = 2818048, OFF_DEC = 2949120, OFF_A = 3014656, OFF_G = 3080192, OFF_OUT = 3178496, WM_ELEMS = 4227072;
constexpr int OFF_WD = 5767168, WF_ELEMS = 8650752;
constexpr int SMEM_BYTES = 149504;

__constant__ double ROPE_INV[16] = {1.0, 0.5623413251903491, 0.31622776601683794, 0.1778279410038923, 0.1, 0.05623413251903491,
  0.031622776601683794, 0.01778279410038923, 0.01, 0.005623413251903491, 0.0031622776601683794, 0.001778279410038923,
  0.001, 0.0005623413251903491, 0.00031622776601683794, 0.0001778279410038923};

struct Params {
  const float *x_prompt, *x_sample, *meta, *ffn1_norm, *ffn1_wg, *ffn1_wu, *ffn1_wd, *mix_norm, *w_in, *shift_mu, *q_norm, *w_uq,
      *kv_norm, *w_ukv, *decay_w0, *decay_w2, *iclr_a0, *iclr_a2, *gate_g2, *key_k_k, *key_k_a, *bonus_r_k, *lnx_w, *lnx_b, *w_out,
      *ffn2_norm, *ffn2_wg, *ffn2_wu, *ffn2_wd, *final_norm;
  float* out;
  u16 *hb, *regB, *kn, *vt, *wF, *wM;
  float *ssq, *ssqq, *bsc, *ropec, *ropes;
  unsigned* ctr;
  unsigned* bar;
};

typedef const __attribute__((address_space(4))) Params& CP;
DI int tidx() { int t = __builtin_amdgcn_workitem_id_x(); asm volatile("" : "+v"(t)); return t; }
DI u16 f2bf(float x) { unsigned u = __float_as_uint(x); u += 0x7fffu + ((u >> 16) & 1u); return (u16)(u >> 16); }
DI float bf2f(u16 b) { return __uint_as_float(((unsigned)b) << 16); }
typedef __bf16 bf16x2_t __attribute__((ext_vector_type(2)));
typedef float fl2_t __attribute__((ext_vector_type(2)));
DI unsigned pack2(float a, float b) { fl2_t f; f.x = a; f.y = b; bf16x2_t r = __builtin_convertvector(f, bf16x2_t); return __builtin_bit_cast(unsigned, r); }
DI float bflo(unsigned u) { return __uint_as_float(u << 16); }
DI float bfhi(unsigned u) { return __uint_as_float(u & 0xffff0000u); }
DI float sigmoidf_(float x) { return __builtin_amdgcn_rcpf(1.f + __expf(-x)); }
DI int crow(int reg, int h) { return (reg & 3) + 8 * (reg >> 2) + 4 * h; }
DI void row2seq(int r, int& s, int& pos, int& L) {
  if (r < 2 * LPR) { s = r >= LPR ? 1 : 0; pos = r - s * LPR; L = LPR; }
  else { int q = (r - 2 * LPR) / LSM; s = 2 + q; pos = r - 2 * LPR - q * LSM; L = LSM; }
}
DI int seq_start(int s) { return s < 2 ? s * LPR : 2 * LPR + (s - 2) * LSM; }
DI int seq_len(int s) { return s < 2 ? LPR : LSM; }
DI float dpp_sum8(float x) {
  x += __int_as_float(__builtin_amdgcn_update_dpp(0, __float_as_int(x), 0xB1, 0xf, 0xf, false));
  x += __int_as_float(__builtin_amdgcn_update_dpp(0, __float_as_int(x), 0x4E, 0xf, 0xf, false));
  x += __int_as_float(__builtin_amdgcn_update_dpp(0, __float_as_int(x), 0x141, 0xf, 0xf, false));
  return x;
}
DI float sum16(float x) {
  x += __int_as_float(__builtin_amdgcn_update_dpp(0, __float_as_int(x), 0x128, 0xf, 0xf, false));
  x += __int_as_float(__builtin_amdgcn_update_dpp(0, __float_as_int(x), 0x124, 0xf, 0xf, false));
  x += __int_as_float(__builtin_amdgcn_update_dpp(0, __float_as_int(x), 0x122, 0xf, 0xf, false));
  x += __int_as_float(__builtin_amdgcn_update_dpp(0, __float_as_int(x), 0x121, 0xf, 0xf, false));
  return x;
}
DI float rstd16(const float* ssq, int m) {
  float s = 0.f;
#pragma unroll
  for (int c = 0; c < 16; ++c) s += ssq[(size_t)c * TP + m];
  return rsqrtf(s * (1.f / 1024.f) + RMS_EPS);
}

struct CJob { const float* src; const float* gain; u16* dst; int K, N, ld, map, nkt; };
DI int rowmap(int map, int n) {
  if (map == 1) return (n >> 5) * 64 + (n & 31);
  if (map == 2) return (n >> 5) * 64 + 32 + (n & 31);
  if (map == 3) return n < 416 ? n : n + 96;
  return n;
}
DI void conv_tile(const CJob& jb, int t, char* smem) {
  const int tid = tidx();
  const int kt = t % jb.nkt, ntile = t / jb.nkt;
  const int ny = tid >> 3, kx = tid & 7;
  const int n = ntile * 64 + ny, kb = kt * 64 + kx * 8;
  float v[8];
#pragma unroll
  for (int j = 0; j < 8; ++j) {
    const int k = kb + j, kc = min(k, jb.K - 1);
    float x = jb.src[(size_t)kc * jb.N + n];
    if (jb.gain) x *= jb.gain[kc];
    v[j] = k < jb.K ? x : 0.f;
  }
  uint4 o;
  o.x = pack2(v[0], v[1]); o.y = pack2(v[2], v[3]); o.z = pack2(v[4], v[5]); o.w = pack2(v[6], v[7]);
  *(uint4*)(jb.dst + (size_t)rowmap(jb.map, n) * jb.ld + kb) = o;
}
constexpr int NCONV_FFN = 2112, NCONV_MIX = 1032;
DI void conv_ffn(CP p, int l, int f, int t, char* smem) {
  CJob jb;
  u16* slot = (l == 1 && f == 0) ? p.kn : p.wF;
  const float* wg = f ? p.ffn2_wg : p.ffn1_wg; const float* wu = f ? p.ffn2_wu : p.ffn1_wu; const float* wd = f ? p.ffn2_wd : p.ffn1_wd;
  const float* nr = f ? p.ffn2_norm : p.ffn1_norm;
  if (t < 704) { jb = CJob{wg + (size_t)l * 1024 * 2816, nr + l * 1024, slot, 1024, 2816, 1024, 1, 16}; }
  else if (t < 1408) { t -= 704; jb = CJob{wu + (size_t)l * 1024 * 2816, nr + l * 1024, slot, 1024, 2816, 1024, 2, 16}; }
  else { t -= 1408; jb = CJob{wd + (size_t)l * 2816 * 1024, nullptr, slot + OFF_WD, 2816, 1024, 2816, 0, 44}; }
  conv_tile(jb, t, smem);
}
DI void conv_mix(CP p, int l, int t, char* smem) {
  CJob jb;
  if (t < 592) jb = CJob{p.w_in + (size_t)l * 1024 * 2368, p.mix_norm + l * 1024, p.wM + OFF_IN, 1024, 2368, 1024, 3, 16};
  else if (t < 640) { t -= 592; jb = CJob{p.w_uq + (size_t)l * 256 * 768, p.q_norm + l * 256, p.wM + OFF_UQ, 256, 768, 256, 0, 4}; }
  else if (t < 672) { t -= 640; jb = CJob{p.w_ukv + (size_t)l * 128 * 1024, p.kv_norm + l * 128, p.wM + OFF_UKV, 128, 1024, 128, 0, 2}; }
  else if (t < 688) { t -= 672; int d = t >> 3; t &= 7; jb = CJob{p.decay_w2 + (size_t)(l * 2 + d) * 64 * 512, nullptr, p.wM + OFF_DEC + d * 32768, 64, 512, 64, 0, 1}; }
  else if (t < 704) { t -= 688; int d = t >> 3; t &= 7; jb = CJob{p.iclr_a2 + (size_t)(l * 2 + d) * 64 * 512, nullptr, p.wM + OFF_A + d * 32768, 64, 512, 64, 0, 1}; }
  else if (t < 728) { t -= 704; jb = CJob{p.gate_g2 + (size_t)l * 160 * 512, nullptr, p.wM + OFF_G, 160, 512, 192, 0, 3}; }
  else if (t < 984) { t -= 728; jb = CJob{p.w_out + (size_t)l * 1024 * 1024, nullptr, p.wM + OFF_OUT, 1024, 1024, 1024, 0, 16}; }
  else {
    t -= 984;
    size_t base = (t < 24) ? (size_t)416 * 1024 + (size_t)t * 4096 : (size_t)2464 * 1024 + (size_t)(t - 24) * 4096;
    *(uint4*)(p.wM + OFF_IN + base + tidx() * 8) = make_uint4(0, 0, 0, 0);
    return;
  }
  conv_tile(jb, t, smem);
}

struct GArgs { const u16 *a0, *a1; int ld0, ld1, split, ks0; const u16* W; int K; int layer; float scale; };
enum { EPI_UP = 0, EPI_RES = 1, EPI_INPROJ = 2, EPI_Q = 3, EPI_KV = 4, EPI_POST = 5 };

DI uint4 load_gate(CP p, int layer, int m, int k) {
  uint4 z = make_uint4(0, 0, 0, 0);
  if (m >= T || k >= 160) return z;
  int s, pos, L; row2seq(m, s, pos, L);
  const u16* pb = p.regB + (size_t)m * 1952 + 1792 + k;
  uint4 c = *(const uint4*)pb;
  uint4 pm = pos > 0 ? *(const uint4*)(pb - 1952) : z;
  uint4 pp = pos + 1 < L ? *(const uint4*)(pb + 1952) : z;
  const float* mu0 = p.shift_mu + (size_t)(layer * 2 + 0) * 1952 + 1792 + k;
  const float* mu1 = p.shift_mu + (size_t)(layer * 2 + 1) * 1952 + 1792 + k;
  unsigned cc[4] = {c.x, c.y, c.z, c.w}, mm[4] = {pm.x, pm.y, pm.z, pm.w}, nn[4] = {pp.x, pp.y, pp.z, pp.w};
  unsigned o[4];
#pragma unroll
  for (int e = 0; e < 4; ++e) {
    float c0 = bflo(cc[e]), c1 = bfhi(cc[e]);
    float x0 = c0 + mu0[2 * e] * (bflo(mm[e]) - c0) + mu1[2 * e] * (bflo(nn[e]) - c0);
    float x1 = c1 + mu0[2 * e + 1] * (bfhi(mm[e]) - c1) + mu1[2 * e + 1] * (bfhi(nn[e]) - c1);
    o[e] = pack2(sigmoidf_(x0), sigmoidf_(x1));
  }
  return make_uint4(o[0], o[1], o[2], o[3]);
}

template <int MODE>
DI uint4 load_a(CP p, const GArgs& g, int row, int kt, int kc) {
  if (MODE == 1) return load_gate(p, g.layer, row, kt * 64 + kc * 8);
  const u16* ap = (kt < g.split) ? g.a0 + (size_t)row * g.ld0 + kt * g.ks0 : g.a1 + (size_t)row * g.ld1 + (kt - g.split) * 64;
  return *(const uint4*)(ap + kc * 8);
}

DI u16* halo_ptr(CP p) { return (u16*)p.out + (size_t)TP * 1024 + (size_t)TP * 768 + (size_t)TP * 32; }
DI uint4 ldg16(const u16* p) { uint4 v = *(const uint4*)p; return v; }
DI void sts16(u16* p, uint4 v) { *(uint4*)p = v; }
DI void store4(u16* dst, float a, float b, float c, float d) { *(uint2*)dst = make_uint2(pack2(a, b), pack2(c, d)); }

template <int MODE, int EPI, int BN>
DI void gemm_tile(CP p, const GArgs& g, int mt, int nt, char* smem, int chain = 0, int nmt = 0, int nnt = 0) {
  constexpr int WN = BN / 64, WM = 8 / WN, MI = 256 / WM / 32, NWC = BN / 64;
  u16* As = (u16*)smem;
  u16* Ws = As + 2 * 256 * 72;
  const int tid = tidx(), lane = tid & 63, wv = tid >> 6, wm = wv / WN, wn = wv % WN, l32 = lane & 31, hh = lane >> 5;
  const int m0 = mt * 256, n0 = nt * BN;
  const int nk = g.K >> 6;
  f32x16 acc[MI][2];
  float rs_early = 0.f;
  if ((EPI == EPI_UP || EPI == EPI_INPROJ) && tid < 256) rs_early = rstd16(p.ssq, m0 + tid);
#pragma unroll
  for (int i = 0; i < MI; ++i)
#pragma unroll
    for (int j = 0; j < 2; ++j)
#pragma unroll
      for (int r = 0; r < 16; ++r) acc[i][j][r] = 0.f;
  uint4 ra0[4], ra1[4], rw0[4], rw1[4];
#define GLA(KT, DA, I) { const int c_ = tid + (I) * 512; DA[I] = load_a<MODE>(p, g, m0 + (c_ >> 3), (KT), c_ & 7); }
#define GLW(KT, DW, I) if ((I) < NWC) { const int c_ = tid + (I) * 512; DW[I] = ldg16(g.W + (size_t)(n0 + (c_ >> 3)) * g.K + (KT) * 64 + (c_ & 7) * 8); }
#define GLOAD(KT, DA, DW) do { GLA(KT, DA, 0) GLA(KT, DA, 1) GLA(KT, DA, 2) GLA(KT, DA, 3) GLW(KT, DW, 0) GLW(KT, DW, 1) GLW(KT, DW, 2) GLW(KT, DW, 3) } while (0)
#define LSA(BUF, DA, I) { const int c_ = tid + (I) * 512; sts16(As + ((BUF) * 256 + (c_ >> 3)) * 72 + (c_ & 7) * 8, DA[I]); }
#define LSW(BUF, DW, I) if ((I) < NWC) { const int c_ = tid + (I) * 512; sts16(Ws + ((BUF) * BN + (c_ >> 3)) * 72 + (c_ & 7) * 8, DW[I]); }
#define LSTORE(BUF, DA, DW) do { LSA(BUF, DA, 0) LSA(BUF, DA, 1) LSA(BUF, DA, 2) LSA(BUF, DA, 3) LSW(BUF, DW, 0) LSW(BUF, DW, 1) LSW(BUF, DW, 2) LSW(BUF, DW, 3) } while (0)
  auto compute = [&](int buf) {
    const u16* Ab = As + buf * 256 * 72 + (wm * (MI * 32) + l32) * 72 + hh * 8;
    const u16* Wb = Ws + buf * BN * 72 + (wn * 64 + l32) * 72 + hh * 8;
#pragma unroll
    for (int ks = 0; ks < 4; ++ks) {
      bf16x8 wf0 = *(const bf16x8*)(Wb + ks * 16);
      bf16x8 wf1 = *(const bf16x8*)(Wb + 32 * 72 + ks * 16);
#pragma unroll
      for (int i = 0; i < MI; ++i) {
        bf16x8 xf = *(const bf16x8*)(Ab + i * 32 * 72 + ks * 16);
        acc[i][0] = MFMA(wf0, xf, acc[i][0]);
        acc[i][1] = MFMA(wf1, xf, acc[i][1]);
      }
    }
  };
  if (true) {
    char* L0 = smem;
    constexpr int BUFB = (256 + BN) * 128;
    constexpr int NBUF = BN <= 128 ? 3 : 2;
    constexpr int NGL = 4 + BN / 64;
    const int gl_row = lane >> 3;
    auto issue_at = [&](int mm0, int nn0, int kt, int buf) {
      char* lb = L0 + buf * BUFB;
#pragma unroll
      for (int i = 0; i < 4; ++i) {
        const int seg = wv * 4 + i, row = seg * 8 + gl_row;
        const int c = (lane & 7) ^ ((row >> 1) & 7);
        const u16* ap = (kt < g.split) ? g.a0 + (size_t)(mm0 + row) * g.ld0 + kt * g.ks0 : g.a1 + (size_t)(mm0 + row) * g.ld1 + (kt - g.split) * 64;
        __builtin_amdgcn_global_load_lds((const unsigned*)(ap + c * 8), (__attribute__((address_space(3))) unsigned*)(lb + seg * 1024 + lane * 16), 16, 0, 0);
      }
#pragma unroll
      for (int i = 0; i < BN / 64; ++i) {
        const int seg = wv * (BN / 64) + i, row = seg * 8 + gl_row;
        const int c = (lane & 7) ^ ((row >> 1) & 7);
        __builtin_amdgcn_global_load_lds((const unsigned*)(g.W + (size_t)(nn0 + row) * g.K + kt * 64 + c * 8),
                                         (__attribute__((address_space(3))) unsigned*)(lb + 256 * 128 + seg * 1024 + lane * 16), 16, 0, 0);
      }
    };
    auto issue = [&](int kt, int buf) { issue_at(m0, n0, kt, buf); };
    auto compute2 = [&](int buf) {
      const char* lb = L0 + buf * BUFB;
#pragma unroll
      for (int ks = 0; ks < 4; ++ks) {
        const int c = ks * 2 + hh;
        bf16x8 wf[2], xf[MI];
#pragma unroll
        for (int j = 0; j < 2; ++j) { const int r = wn * 64 + j * 32 + l32; wf[j] = *(const bf16x8*)(lb + 256 * 128 + r * 128 + ((c ^ ((r >> 1) & 7)) << 4)); }
#pragma unroll
        for (int i = 0; i < MI; ++i) { const int r = wm * (MI * 32) + i * 32 + l32; xf[i] = *(const bf16x8*)(lb + r * 128 + ((c ^ ((r >> 1) & 7)) << 4)); }
#pragma unroll
        for (int i = 0; i < MI; ++i) {
          acc[i][0] = MFMA(wf[0], xf[i], acc[i][0]);
          acc[i][1] = MFMA(wf[1], xf[i], acc[i][1]);
        }
      }
    };
    if (NBUF == 3) {
      issue(0, 0);
      if (nk > 1) { issue(1, 1); if (BN == 128) asm volatile("s_waitcnt vmcnt(6)" ::: "memory"); else asm volatile("s_waitcnt vmcnt(5)" ::: "memory"); }
      else asm volatile("s_waitcnt vmcnt(0)" ::: "memory");
      asm volatile("s_waitcnt lgkmcnt(0)" ::: "memory");
      __builtin_amdgcn_s_barrier();
      int buf = 0;
      for (int kt = 0; kt < nk; ++kt) {
        const int b2 = buf == 0 ? 2 : buf - 1;
        if (kt + 2 < nk) issue(kt + 2, b2);
        compute2(buf);
        if (kt + 2 < nk) { if (BN == 128) asm volatile("s_waitcnt vmcnt(6)" ::: "memory"); else asm volatile("s_waitcnt vmcnt(5)" ::: "memory"); }
        else asm volatile("s_waitcnt vmcnt(0)" ::: "memory");
        asm volatile("s_waitcnt lgkmcnt(0)" ::: "memory");
        __builtin_amdgcn_s_barrier();
        buf = buf == 2 ? 0 : buf + 1;
      }
    } else {
      if (!(chain & 1)) {
        issue(0, 0);
        asm volatile("s_waitcnt vmcnt(0)" ::: "memory");
        __syncthreads();
      }
      for (int kt = 0; kt < nk; ++kt) {
        const int buf = kt & 1;
        if (kt + 1 < nk) issue(kt + 1, buf ^ 1);
        else if (chain & 2) issue_at(nmt * 256, nnt * BN, 0, buf ^ 1);
        compute2(buf);
        asm volatile("s_waitcnt vmcnt(0)" ::: "memory");
        __syncthreads();
      }
    }
    __syncthreads();
  } else {
    GLOAD(0, ra0, rw0);
    LSTORE(0, ra0, rw0);
    __syncthreads();
    for (int kt = 0; kt < nk; ++kt) {
      const int buf = kt & 1;
      if (kt + 1 < nk) GLOAD(kt + 1, ra0, rw0);
      compute(buf);
      if (kt + 1 < nk) LSTORE(buf ^ 1, ra0, rw0);
      __syncthreads();
    }
  }
#undef GLOAD
#undef LSTORE
  float* rsl = (float*)(smem + 147456);
  if (EPI == EPI_UP || EPI == EPI_INPROJ) {
    if (tid < 256) rsl[tid] = rs_early;
    __syncthreads();
  }
  const int nw = n0 + wn * 64;
#pragma unroll
  for (int i = 0; i < MI; ++i) {
    const int m = m0 + wm * (MI * 32) + i * 32 + l32;
    if (EPI == EPI_UP) {
      const float rs = rsl[m - m0];
      const int hb0 = nw >> 1;
#pragma unroll
      for (int gq = 0; gq < 4; ++gq) {
        float v[4];
#pragma unroll
        for (int r = 0; r < 4; ++r) {
          float gt = acc[i][0][4 * gq + r] * rs, up = acc[i][1][4 * gq + r] * rs;
          v[r] = gt * sigmoidf_(gt) * up;
        }
        int hid = hb0 + 8 * gq + 4 * hh;
        u16* dst = hid < 1408 ? p.regB + (size_t)m * 1408 + hid : (u16*)p.out + (size_t)m * 1408 + (hid - 1408);
        store4(dst, v[0], v[1], v[2], v[3]);
      }
    } else if (EPI == EPI_RES) {
      float ss = 0.f;
#pragma unroll
      for (int j = 0; j < 2; ++j)
#pragma unroll
        for (int gq = 0; gq < 4; ++gq) {
          u16* hp = p.hb + (size_t)m * 1024 + nw + j * 32 + 8 * gq + 4 * hh;
          uint2 old = *(const uint2*)hp;
          float h0 = bflo(old.x) + g.scale * acc[i][j][4 * gq + 0];
          float h1 = bfhi(old.x) + g.scale * acc[i][j][4 * gq + 1];
          float h2 = bflo(old.y) + g.scale * acc[i][j][4 * gq + 2];
          float h3 = bfhi(old.y) + g.scale * acc[i][j][4 * gq + 3];
          unsigned p0 = pack2(h0, h1), p1 = pack2(h2, h3);
          *(uint2*)hp = make_uint2(p0, p1);
          float r0 = bflo(p0), r1 = bfhi(p0), r2 = bflo(p1), r3 = bfhi(p1);
          ss += r0 * r0 + r1 * r1 + r2 * r2 + r3 * r3;
        }
      ss += __shfl_xor(ss, 32);
      if (hh == 0) p.ssq[(size_t)(nw >> 6) * TP + m] = ss;
    } else if (EPI == EPI_INPROJ) {
      const float rs = rsl[m - m0];
      int s, pos, L; row2seq(m < T ? m : 0, s, pos, L);
      float ss = 0.f;
#pragma unroll
      for (int j = 0; j < 2; ++j) {
        const int nb = nw + j * 32;
        if (nb == 384) {
          u16* kr = (u16*)p.out + (size_t)TP * 1024 + (size_t)TP * 768 + (size_t)m * 32;
#pragma unroll
          for (int gq = 0; gq < 2; ++gq) {
            float o1[4], o2[4];
#pragma unroll
            for (int r = 0; r < 4; ++r) {
              int ii = 8 * gq + 4 * hh + r;
              float c = p.ropec[pos * 16 + ii], sn = p.ropes[pos * 16 + ii];
              float x1 = acc[i][j][4 * gq + r] * rs, x2 = acc[i][j][4 * (gq + 2) + r] * rs;
              o1[r] = x1 * c - x2 * sn; o2[r] = x2 * c + x1 * sn;
            }
            store4(kr + 8 * gq + 4 * hh, o1[0], o1[1], o1[2], o1[3]);
            store4(kr + 16 + 8 * gq + 4 * hh, o2[0], o2[1], o2[2], o2[3]);
          }
        } else {
#pragma unroll
          for (int gq = 0; gq < 4; ++gq) {
            int n = nb + 8 * gq + 4 * hh;
            unsigned p0 = pack2(acc[i][j][4 * gq] * rs, acc[i][j][4 * gq + 1] * rs);
            unsigned p1 = pack2(acc[i][j][4 * gq + 2] * rs, acc[i][j][4 * gq + 3] * rs);
            if (n < 512) {
              *(uint2*)((u16*)p.out + (size_t)m * 512 + n) = make_uint2(p0, p1);
              float r0 = bflo(p0), r1 = bfhi(p0), r2 = bflo(p1), r3 = bfhi(p1);
              ss += r0 * r0 + r1 * r1 + r2 * r2 + r3 * r3;
            } else if (n - 512 < 1952) {
              *(uint2*)(p.regB + (size_t)m * 1952 + (n - 512)) = make_uint2(p0, p1);
              if (m < T && ((pos & 63) == 0 || (pos & 63) == 63)) {
                const int ch = (s < 2 ? s * 129 : 258 + (s - 2) * 33) + (pos >> 6);
                *(uint2*)(halo_ptr(p) + ((size_t)ch * 2 + ((pos & 63) ? 1 : 0)) * 1952 + (n - 512)) = make_uint2(p0, p1);
              }
            }
          }
        }
      }
      if (nw < 384) {
        ss += __shfl_xor(ss, 32);
        if (hh == 0) p.ssqq[(size_t)(nw >> 6) * TP + m] = ss;
      }
    } else if (EPI == EPI_Q) {
      float sq = p.ssqq[m] + p.ssqq[(size_t)TP + m] + p.ssqq[(size_t)2 * TP + m] + p.ssqq[(size_t)3 * TP + m];
      const float rs = rsqrtf(sq * (1.f / 256.f) + RMS_EPS) * QSCALE;
      int s, pos, L; row2seq(m < T ? m : 0, s, pos, L);
      u16* qrow = (u16*)p.out + (size_t)TP * 1024 + (size_t)m * 768;
#pragma unroll
      for (int j = 0; j < 2; ++j) {
        const int nb = nw + j * 32;
        if (((nb >> 5) % 3) == 2) {
#pragma unroll
          for (int gq = 0; gq < 2; ++gq) {
            float o1[4], o2[4];
#pragma unroll
            for (int r = 0; r < 4; ++r) {
              int ii = 8 * gq + 4 * hh + r;
              float c = p.ropec[pos * 16 + ii], sn = p.ropes[pos * 16 + ii];
              float x1 = acc[i][j][4 * gq + r] * rs, x2 = acc[i][j][4 * (gq + 2) + r] * rs;
              o1[r] = x1 * c - x2 * sn; o2[r] = x2 * c + x1 * sn;
            }
            store4(qrow + nb + 8 * gq + 4 * hh, o1[0], o1[1], o1[2], o1[3]);
            store4(qrow + nb + 16 + 8 * gq + 4 * hh, o2[0], o2[1], o2[2], o2[3]);
          }
        } else {
#pragma unroll
          for (int gq = 0; gq < 4; ++gq)
            store4(qrow + nb + 8 * gq + 4 * hh, acc[i][j][4 * gq] * rs, acc[i][j][4 * gq + 1] * rs, acc[i][j][4 * gq + 2] * rs, acc[i][j][4 * gq + 3] * rs);
        }
      }
    } else if (EPI == EPI_KV) {
      if (m < T) {
        float sq = p.ssqq[(size_t)4 * TP + m] + p.ssqq[(size_t)5 * TP + m];
        const float rs = rsqrtf(sq * (1.f / 128.f) + RMS_EPS);
        int s, pos, L; row2seq(m, s, pos, L);
        const int head = nw >> 7;
        const int ppos = (pos & ~15) | (pos & 3) | (((pos >> 3) & 1) << 2) | (((pos >> 2) & 1) << 3);
#pragma unroll
        for (int j = 0; j < 2; ++j) {
          const int jj = (nw & 127) + j * 32;
#pragma unroll
          for (int gq = 0; gq < 4; ++gq) {
            int c = jj + 8 * gq + 4 * hh;
            if (jj < 64) {
              store4(p.kn + (size_t)m * 512 + head * 64 + c, acc[i][j][4 * gq] * rs, acc[i][j][4 * gq + 1] * rs, acc[i][j][4 * gq + 2] * rs, acc[i][j][4 * gq + 3] * rs);
            } else {
#pragma unroll
              for (int r = 0; r < 4; ++r) {
                int dv = c - 64 + r;
                p.vt[(size_t)seq_start(s) * 512 + (size_t)(head * 64 + dv) * L + ppos] = f2bf(acc[i][j][4 * gq + r] * rs);
              }
            }
          }
        }
      }
    } else if (EPI == EPI_POST) {
      if (m < T) {
        int s, pos, L; row2seq(m, s, pos, L);
        const int hd = nw >> 6;
        u16* yb = (u16*)p.out + (size_t)m * 1024;
        float y[2][16];
        float sum = 0.f;
#pragma unroll
        for (int j = 0; j < 2; ++j)
#pragma unroll
          for (int gq = 0; gq < 4; ++gq) {
            int n = nw + j * 32 + 8 * gq + 4 * hh;
            uint2 a = *(const uint2*)(yb + n), b = *(const uint2*)(yb + 512 + n);
            y[j][4 * gq + 0] = bflo(a.x) + bflo(b.x); y[j][4 * gq + 1] = bfhi(a.x) + bfhi(b.x);
            y[j][4 * gq + 2] = bflo(a.y) + bflo(b.y); y[j][4 * gq + 3] = bfhi(a.y) + bfhi(b.y);
            sum += y[j][4 * gq] + y[j][4 * gq + 1] + y[j][4 * gq + 2] + y[j][4 * gq + 3];
          }
        sum += __shfl_xor(sum, 32);
        const float mu = sum * (1.f / 64.f);
        float vs = 0.f;
#pragma unroll
        for (int j = 0; j < 2; ++j)
#pragma unroll
          for (int r = 0; r < 16; ++r) { float dlt = y[j][r] - mu; vs += dlt * dlt; }
        vs += __shfl_xor(vs, 32);
        const float rstd = rsqrtf(vs * (1.f / 64.f) + LNX_EPS);
        const float bsum = p.bsc[(size_t)m * 8 + hd] + p.bsc[((size_t)TP + m) * 8 + hd];
        const u16* vb = p.regB + (size_t)m * 1952 + 1024;
#pragma unroll
        for (int j = 0; j < 2; ++j)
#pragma unroll
          for (int gq = 0; gq < 4; ++gq) {
            int n = nw + j * 32 + 8 * gq + 4 * hh;
            uint2 c = *(const uint2*)(vb + n);
            float cv[4] = {bflo(c.x), bfhi(c.x), bflo(c.y), bfhi(c.y)};
            float o[4];
#pragma unroll
            for (int r = 0; r < 4; ++r) {
              float vsh = cv[r];
              float yn = (y[j][4 * gq + r] - mu) * rstd * p.lnx_w[g.layer * 512 + n + r] + p.lnx_b[g.layer * 512 + n + r];
              o[r] = (yn + bsum * vsh) * acc[i][j][4 * gq + r];
            }
            store4(yb + n, o[0], o[1], o[2], o[3]);
          }
      }
    }
  }
}

template <int MODE, int EPI, int BN = 128>
DI void gemm_phase_item(CP p, const GArgs& g, int item, int NT, char* smem) {
  const int grp = item / (8 * NT);
  const int gsz = min(8, NMT - grp * 8);
  const int idx = item - grp * 8 * NT;
  gemm_tile<MODE, EPI, BN>(p, g, grp * 8 + idx % gsz, idx / gsz, smem);
}

template <int MODE, int EPI, int BN>
DI void gemm_phase(CP p, const GArgs& g, int NT, char* smem) {
  const int x = blockIdx.x & 7, j = blockIdx.x >> 3, nj = gridDim.x >> 3;
  const int total = 16 * NT;
  const bool can_chain = BN == 256 && (((g.K >> 6) & 1) == 0);
  bool first = true;
  for (int e = j; e < total; e += nj) {
    const int grp = e / (8 * NT);
    const int rem = e - grp * 8 * NT;
    const int e2 = e + nj;
    const bool has_next = can_chain && e2 < total;
    const int grp2 = e2 / (8 * NT), rem2 = e2 - grp2 * 8 * NT;
    const int chain = can_chain ? ((first ? 0 : 1) | (has_next ? 2 : 0)) : 0;
    gemm_tile<MODE, EPI, BN>(p, g, x + 8 * (grp * 8 + (rem & 7)), rem >> 3, smem, chain, x + 8 * (grp2 * 8 + (rem2 & 7)), rem2 >> 3);
    first = false;
  }
  const int ntail = NT * (BN / 64);
  for (int e = (int)gridDim.x - 1 - (int)blockIdx.x; e < ntail; e += gridDim.x) gemm_tile<MODE, EPI, 64>(p, g, NMT - 1, e, smem);
}

DI void attn_item(CP p, int s, int hd, int qb, char* smem, bool dostore = true) {
  u16* Ks = (u16*)smem;
  u16* Vs = Ks + 2 * 64 * 104;
  const int tid = tidx(), lane = tid & 63, wv = tid >> 6, l32 = lane & 31, hh = lane >> 5;
  const int L = seq_len(s), r0 = seq_start(s);
  const u16* Qb = (const u16*)p.out + (size_t)TP * 1024;
  const u16* KR = Qb + (size_t)TP * 768;
  const int qpos = qb * 256 + wv * 32 + l32;
  const bool wvalid = (qb * 256 + wv * 32) < L;
  const int qrow = r0 + min(qpos, L - 1);
  bf16x8 qf[6];
#pragma unroll
  for (int ks = 0; ks < 6; ++ks) qf[ks] = *(const bf16x8*)(Qb + (size_t)qrow * 768 + hd * 96 + ks * 16 + hh * 8);
  f32x16 o[2];
#pragma unroll
  for (int u = 0; u < 2; ++u)
#pragma unroll
    for (int r = 0; r < 16; ++r) o[u][r] = 0.f;
  float mrun = -1e30f, lrun = 0.f;
  const int nt = (L + 63) >> 6;
  const u16* vtb = p.vt + (size_t)r0 * 512 + (size_t)hd * 64 * L;
  uint4 rg[3];
  auto ldc = [&](int kt, int c) -> uint4 {
    uint4 z = make_uint4(0, 0, 0, 0);
    if (c < 768) {
      int key = c / 12, cc = c - key * 12, kpos = kt * 64 + key;
      if (kpos >= L) return z;
      const u16* src = cc < 8 ? p.kn + (size_t)(r0 + kpos) * 512 + hd * 64 + cc * 8 : KR + (size_t)(r0 + kpos) * 32 + (cc - 8) * 8;
      return *(const uint4*)src;
    } else {
      int c2 = c - 768, dv = c2 >> 3, kc = c2 & 7, kp0 = kt * 64 + kc * 8;
      if (kp0 >= L) return z;
      return *(const uint4*)(vtb + (size_t)dv * L + kp0);
    }
  };
  auto stc = [&](int buf, int c, uint4 v) {
    if (c < 768) { int key = c / 12, cc = c - key * 12; *(uint4*)(Ks + (buf * 64 + key) * 104 + cc * 8) = v; }
    else { int c2 = c - 768, dv = c2 >> 3, kc = c2 & 7; *(uint4*)(Vs + (buf * 64 + dv) * 72 + kc * 8) = v; }
  };
  rg[0] = ldc(0, tid); rg[1] = ldc(0, tid + 512); if (tid < 256) rg[2] = ldc(0, tid + 1024);
  stc(0, tid, rg[0]); stc(0, tid + 512, rg[1]); if (tid < 256) stc(0, tid + 1024, rg[2]);
  __syncthreads();
  for (int kt = 0; kt < nt; ++kt) {
    const int buf = kt & 1;
    if (kt + 1 < nt) { rg[0] = ldc(kt + 1, tid); rg[1] = ldc(kt + 1, tid + 512); if (tid < 256) rg[2] = ldc(kt + 1, tid + 1024); }
    if (wvalid) {
      f32x16 st[2];
#pragma unroll
      for (int t = 0; t < 2; ++t) {
#pragma unroll
        for (int r = 0; r < 16; ++r) st[t][r] = 0.f;
        const u16* kb = Ks + (buf * 64 + t * 32 + l32) * 104 + hh * 8;
#pragma unroll
        for (int ks = 0; ks < 6; ++ks) st[t] = MFMA(*(const bf16x8*)(kb + ks * 16), qf[ks], st[t]);
      }
      if (kt == nt - 1) {
#pragma unroll
        for (int t = 0; t < 2; ++t)
#pragma unroll
          for (int r = 0; r < 16; ++r) if (kt * 64 + t * 32 + crow(r, hh) >= L) st[t][r] = -1e30f;
      }
      float mx = -1e30f;
#pragma unroll
      for (int t = 0; t < 2; ++t)
#pragma unroll
        for (int r = 0; r < 16; ++r) mx = fmaxf(mx, st[t][r]);
      mx = fmaxf(mx, __shfl_xor(mx, 32));
      const float mnew = fmaxf(mrun, mx);
      const float alpha = __builtin_amdgcn_exp2f(mrun - mnew);
      float ls = 0.f;
#pragma unroll
      for (int t = 0; t < 2; ++t)
#pragma unroll
        for (int r = 0; r < 16; ++r) { float pv = __builtin_amdgcn_exp2f(st[t][r] - mnew); st[t][r] = pv; ls += pv; }
      lrun = lrun * alpha + ls; mrun = mnew;
#pragma unroll
      for (int u = 0; u < 2; ++u)
#pragma unroll
        for (int r = 0; r < 16; ++r) o[u][r] *= alpha;
#pragma unroll
      for (int t = 0; t < 2; ++t)
#pragma unroll
        for (int s2 = 0; s2 < 2; ++s2) {
          uint4 pk;
          pk.x = pack2(st[t][8 * s2 + 0], st[t][8 * s2 + 1]); pk.y = pack2(st[t][8 * s2 + 2], st[t][8 * s2 + 3]);
          pk.z = pack2(st[t][8 * s2 + 4], st[t][8 * s2 + 5]); pk.w = pack2(st[t][8 * s2 + 6], st[t][8 * s2 + 7]);
          bf16x8 pf = __builtin_bit_cast(bf16x8, pk);
#pragma unroll
          for (int u = 0; u < 2; ++u) {
            bf16x8 vf = *(const bf16x8*)(Vs + (buf * 64 + u * 32 + l32) * 72 + t * 32 + s2 * 16 + hh * 8);
            o[u] = MFMA(vf, pf, o[u]);
          }
        }
    }
    if (kt + 1 < nt) { stc(buf ^ 1, tid, rg[0]); stc(buf ^ 1, tid + 512, rg[1]); if (tid < 256) stc(buf ^ 1, tid + 1024, rg[2]); }
    __syncthreads();
  }
  if (wvalid) {
    float lt = lrun + __shfl_xor(lrun, 32);
    const float inv = 1.f / lt;
    if (qpos < L && dostore) {
      u16* dst = (u16*)p.out + (size_t)TP * 1024 + (size_t)(r0 + qpos) * 768 + hd * 96;
#pragma unroll
      for (int u = 0; u < 2; ++u)
#pragma unroll
        for (int gq = 0; gq < 4; ++gq)
          store4(dst + u * 32 + 8 * gq + 4 * hh, o[u][4 * gq] * inv, o[u][4 * gq + 1] * inv, o[u][4 * gq + 2] * inv, o[u][4 * gq + 3] * inv);
    }
  }
}

DI void scan_block(CP p, int layer, int s, int d, int hd, char* smem) {
  float* OP = (float*)smem;
  float* WA = OP + 32 * 392;
  float* YB = WA + 2 * 32 * 64;
  u16* XL = (u16*)(YB + 32 * 64);
  float* MU = (float*)(XL + 2 * 32 * 72);
  float* CS = MU + 5 * 2 * 64;
  const int tid = tidx(), lane = tid & 63, wv = tid >> 6, l32 = lane & 31, hh = lane >> 5;
  const int L = seq_len(s), r0 = seq_start(s);
  const int sj = tid >> 4, q = tid & 15;
  const int rloc = lane >> 3, cg8 = lane & 7, row = wv * 8 + rloc;
  const int aoff[5] = {hd * 64, 512 + hd * 64, 1024 + hd * 64, 1536 + d * 64, 1664 + d * 64};
  __syncthreads();
  for (int i = tid; i < 640; i += NTHR) {
    int a = i >> 7, w = (i >> 6) & 1, c = i & 63;
    int off = a == 0 ? aoff[0] : a == 1 ? aoff[1] : a == 2 ? aoff[2] : a == 3 ? aoff[3] : aoff[4];
    MU[i] = p.shift_mu[(size_t)(layer * 2 + w) * 1952 + off + c];
  }
  if (tid < 64) {
    CS[tid] = p.key_k_k[layer * 512 + hd * 64 + tid];
    CS[64 + tid] = p.key_k_a[layer * 512 + hd * 64 + tid];
    CS[128 + tid] = p.bonus_r_k[layer * 512 + hd * 64 + tid];
  }
  const int mat = (wv >> 1) & 1, ntile = wv & 1;
  bf16x8 wfr[4];
  {
    const u16* wb = p.wM + (mat ? OFF_A : OFF_DEC) + (size_t)(d * 512 + hd * 64 + ntile * 32 + l32) * 64 + hh * 8;
#pragma unroll
    for (int ks = 0; ks < 4; ++ks) wfr[ks] = *(const bf16x8*)(wb + ks * 16);
  }
  const float bias = mat ? p.iclr_a0[(size_t)(layer * 2 + d) * 512 + hd * 64 + ntile * 32 + l32]
                         : p.decay_w0[(size_t)(layer * 2 + d) * 512 + hd * 64 + ntile * 32 + l32];
  __syncthreads();
  float S[8];
#pragma unroll
  for (int i = 0; i < 8; ++i) S[i] = 0.f;
  const int nch = (L + 31) >> 5;
  uint2 raw[15];
  float r4[4], k4[4], kk4[4], v4[4];

  auto prefetch = [&](int c) {
    const int sidx = c * 32 + sj;
    const bool valid = sidx < L;
    const int tok = d == 0 ? sidx : L - 1 - sidx;
    const u16* base = p.regB + (size_t)(r0 + tok) * 1952 + 4 * q;
#pragma unroll
    for (int a = 0; a < 5; ++a) {
      const int off = a == 0 ? aoff[0] : a == 1 ? aoff[1] : a == 2 ? aoff[2] : a == 3 ? aoff[3] : aoff[4];
      raw[a * 3 + 0] = (valid && tok > 0) ? *(const uint2*)(base - 1952 + off) : make_uint2(0, 0);
      raw[a * 3 + 1] = valid ? *(const uint2*)(base + off) : make_uint2(0, 0);
      raw[a * 3 + 2] = (valid && tok + 1 < L) ? *(const uint2*)(base + 1952 + off) : make_uint2(0, 0);
    }
  };
  auto shift4 = [&](int a, float* x) {
    const float4 m0 = *(const float4*)(MU + (a * 2 + 0) * 64 + 4 * q);
    const float4 m1 = *(const float4*)(MU + (a * 2 + 1) * 64 + 4 * q);
    const uint2 pm = raw[a * 3], c = raw[a * 3 + 1], pp = raw[a * 3 + 2];
    float c0 = bflo(c.x), c1 = bfhi(c.x), c2 = bflo(c.y), c3 = bfhi(c.y);
    x[0] = c0 + m0.x * (bflo(pm.x) - c0) + m1.x * (bflo(pp.x) - c0);
    x[1] = c1 + m0.y * (bfhi(pm.x) - c1) + m1.y * (bfhi(pp.x) - c1);
    x[2] = c2 + m0.z * (bflo(pm.y) - c2) + m1.z * (bflo(pp.y) - c2);
    x[3] = c3 + m0.w * (bfhi(pm.y) - c3) + m1.w * (bfhi(pp.y) - c3);
  };
  auto stage = [&](int c) {
    shift4(0, r4); shift4(1, k4); shift4(2, v4);
    float xw[4], xa[4];
    shift4(3, xw); shift4(4, xa);
#pragma unroll
    for (int e = 0; e < 4; ++e) xw[e] = 1.f - 2.f / (__expf(2.f * xw[e]) + 1.f);
    store4(XL + sj * 72 + 4 * q, xw[0], xw[1], xw[2], xw[3]);
    store4(XL + 32 * 72 + sj * 72 + 4 * q, xa[0], xa[1], xa[2], xa[3]);
    {
      const float4 kkw = *(const float4*)(CS + 4 * q);
      float x0 = k4[0] * kkw.x, x1 = k4[1] * kkw.y, x2 = k4[2] * kkw.z, x3 = k4[3] * kkw.w;
      float ss = sum16(x0 * x0 + x1 * x1 + x2 * x2 + x3 * x3);
      float inv = 1.f / fmaxf(sqrtf(ss), 1e-12f);
      kk4[0] = x0 * inv; kk4[1] = x1 * inv; kk4[2] = x2 * inv; kk4[3] = x3 * inv;
    }
    __syncthreads();
    if (wv < 4) {
      f32x16 acc;
#pragma unroll
      for (int r = 0; r < 16; ++r) acc[r] = 0.f;
      const u16* xb = XL + mat * 32 * 72 + l32 * 72 + hh * 8;
#pragma unroll
      for (int ks = 0; ks < 4; ++ks) acc = MFMA(*(const bf16x8*)(xb + ks * 16), wfr[ks], acc);
#pragma unroll
      for (int r = 0; r < 16; ++r) {
        float x = acc[r] + bias;
        float sg = sigmoidf_(x);
        float val = mat ? sg : __expf(-0.6065306597126334f * sg);
        WA[(mat * 32 + crow(r, hh)) * 64 + ntile * 32 + l32] = val;
      }
    }
    __syncthreads();
    {
      const float4 w4 = *(const float4*)(WA + sj * 64 + 4 * q);
      const float4 a4 = *(const float4*)(WA + (32 + sj) * 64 + 4 * q);
      const float4 ka = *(const float4*)(CS + 64 + 4 * q);
      const float4 brk = *(const float4*)(CS + 128 + 4 * q);
      const float wv4[4] = {w4.x, w4.y, w4.z, w4.w}, av4[4] = {a4.x, a4.y, a4.z, a4.w};
      const float kav[4] = {ka.x, ka.y, ka.z, ka.w}, bkv[4] = {brk.x, brk.y, brk.z, brk.w};
      float aa[4], wr[4], bb[4], kd[4];
      float br = 0.f, kr = 0.f, bs = 0.f;
#pragma unroll
      for (int e = 0; e < 4; ++e) {
        aa[e] = -kk4[e]; wr[e] = wv4[e] * r4[e]; bb[e] = kk4[e] * av4[e];
        kd[e] = k4[e] * (1.f + (av4[e] - 1.f) * kav[e]);
        br += bb[e] * r4[e]; kr += kd[e] * r4[e]; bs += r4[e] * kd[e] * bkv[e];
      }
      br = sum16(br); kr = sum16(kr); bs = sum16(bs);
      float* o = OP + sj * 392 + 4 * q;
      *(float4*)(o) = make_float4(aa[0], aa[1], aa[2], aa[3]);
      *(float4*)(o + 64) = make_float4(wr[0], wr[1], wr[2], wr[3]);
      *(float4*)(o + 128) = w4;
      *(float4*)(o + 192) = make_float4(bb[0], bb[1], bb[2], bb[3]);
      *(float4*)(o + 256) = make_float4(kd[0], kd[1], kd[2], kd[3]);
      *(float4*)(o + 320) = make_float4(v4[0], v4[1], v4[2], v4[3]);
      if (q == 0) {
        OP[sj * 392 + 384] = br; OP[sj * 392 + 385] = kr;
        const int sidx = c * 32 + sj;
        if (sidx < L) { const int tok = d == 0 ? sidx : L - 1 - sidx; p.bsc[((size_t)d * TP + r0 + tok) * 8 + hd] = bs; }
      }
    }
    __syncthreads();
  };

  prefetch(0);
  stage(0);
  for (int c = 0; c < nch; ++c) {
    if (c + 1 < nch) prefetch(c + 1);
    const int nst = min(32, L - c * 32);
    for (int jj = 0; jj < nst; ++jj) {
      const float* o = OP + jj * 392;
      const float4 a0 = *(const float4*)(o + cg8 * 8), a1 = *(const float4*)(o + cg8 * 8 + 4);
      const float4 y0 = *(const float4*)(o + 64 + cg8 * 8), y1 = *(const float4*)(o + 64 + cg8 * 8 + 4);
      const float4 w0 = *(const float4*)(o + 128 + cg8 * 8), w1 = *(const float4*)(o + 128 + cg8 * 8 + 4);
      const float4 b0 = *(const float4*)(o + 192 + cg8 * 8), b1 = *(const float4*)(o + 192 + cg8 * 8 + 4);
      const float4 k0 = *(const float4*)(o + 256 + cg8 * 8), k1 = *(const float4*)(o + 256 + cg8 * 8 + 4);
      const float vv = o[320 + row];
      const float2 sc = *(const float2*)(o + 384);
      float da = S[0] * a0.x + S[1] * a0.y + S[2] * a0.z + S[3] * a0.w + S[4] * a1.x + S[5] * a1.y + S[6] * a1.z + S[7] * a1.w;
      float dy = S[0] * y0.x + S[1] * y0.y + S[2] * y0.z + S[3] * y0.w + S[4] * y1.x + S[5] * y1.y + S[6] * y1.z + S[7] * y1.w;
      da = dpp_sum8(da); dy = dpp_sum8(dy);
      const float yv = dy + da * sc.x + vv * sc.y;
      S[0] = S[0] * w0.x + da * b0.x + vv * k0.x; S[1] = S[1] * w0.y + da * b0.y + vv * k0.y;
      S[2] = S[2] * w0.z + da * b0.z + vv * k0.z; S[3] = S[3] * w0.w + da * b0.w + vv * k0.w;
      S[4] = S[4] * w1.x + da * b1.x + vv * k1.x; S[5] = S[5] * w1.y + da * b1.y + vv * k1.y;
      S[6] = S[6] * w1.z + da * b1.z + vv * k1.z; S[7] = S[7] * w1.w + da * b1.w + vv * k1.w;
      if (cg8 == 0) YB[jj * 64 + row] = yv;
    }
    __syncthreads();
    {
      const int sidx = c * 32 + sj;
      if (sidx < L) {
        const int tok = d == 0 ? sidx : L - 1 - sidx;
        const float4 yv = *(const float4*)(YB + sj * 64 + 4 * q);
        store4((u16*)p.out + (size_t)(r0 + tok) * 1024 + d * 512 + hd * 64 + 4 * q, yv.x, yv.y, yv.z, yv.w);
      }
    }
    if (c + 1 < nch) stage(c + 1);
  }
  __syncthreads();
}

typedef float f2 __attribute__((ext_vector_type(2)));
DI f2 mk2(float a, float b) { f2 r; r.x = a; r.y = b; return r; }
#define LDS_FENCE() asm volatile("s_waitcnt lgkmcnt(0)" ::: "memory")

template <int CPL>
DI void scan_block2(CP p, int layer, int s, int d, int hd, int rowhalf, char* smem) {
  float* OP = (float*)smem;
  float* YB = OP + 2 * 32 * 392;
  u16* XL = (u16*)(YB + 2 * 32 * 64);
  float* MU = (float*)(XL + 2 * 32 * 72);
  float* CS = MU + 640;
  u16* WL = (u16*)(CS + 192);
  const int tid = tidx(), lane = tid & 63, wv = tid >> 6, l32 = lane & 31, hh = lane >> 5;
  const int L = seq_len(s), r0 = seq_start(s);
  const int aoff0 = hd * 64, aoff1 = 512 + hd * 64, aoff2 = 1024 + hd * 64, aoff3 = 1536 + d * 64, aoff4 = 1664 + d * 64;
  __syncthreads();
  for (int i = tid; i < 640; i += NTHR) {
    int a = i >> 7, w = (i >> 6) & 1, c = i & 63;
    int off = a == 0 ? aoff0 : a == 1 ? aoff1 : a == 2 ? aoff2 : a == 3 ? aoff3 : aoff4;
    MU[i] = p.shift_mu[(size_t)(layer * 2 + w) * 1952 + off + c];
  }
#pragma unroll
  for (int i = 0; i < 2; ++i) {
    const int idx = tid + i * NTHR, mat = idx >> 9, col = (idx >> 3) & 63, kc = idx & 7;
    *(uint4*)(WL + (mat * 64 + col) * 72 + kc * 8) = *(const uint4*)(p.wM + (mat ? OFF_A : OFF_DEC) + (size_t)(d * 512 + hd * 64 + col) * 64 + kc * 8);
  }
  if (tid < 64) {
    CS[tid] = p.key_k_k[layer * 512 + hd * 64 + tid];
    CS[64 + tid] = p.key_k_a[layer * 512 + hd * 64 + tid];
    CS[128 + tid] = p.bonus_r_k[layer * 512 + hd * 64 + tid];
  }
  __syncthreads();
  const int nch = (L + 31) >> 5;

  if (wv >= 4) {
    const int sw = wv - 4;
    const int q = lane & 15;
    float bias[2][2];
#pragma unroll
    for (int mat = 0; mat < 2; ++mat)
#pragma unroll
      for (int nt2 = 0; nt2 < 2; ++nt2)
        bias[mat][nt2] = mat ? p.iclr_a0[(size_t)(layer * 2 + d) * 512 + hd * 64 + nt2 * 32 + l32]
                             : p.decay_w0[(size_t)(layer * 2 + d) * 512 + hd * 64 + nt2 * 32 + l32];
    uint2 raw[2][5];
    auto load_raw = [&](int c) {
#pragma unroll
      for (int u = 0; u < 2; ++u) {
        const int sj = 8 * sw + 4 * u + (lane >> 4);
        const int sidc = min(c * 32 + sj, L - 1);
        const int tok = d == 0 ? sidc : L - 1 - sidc;
        const u16* base = p.regB + (size_t)(r0 + tok) * 1952 + 4 * q;
        raw[u][0] = *(const uint2*)(base + aoff0); raw[u][1] = *(const uint2*)(base + aoff1); raw[u][2] = *(const uint2*)(base + aoff2);
        raw[u][3] = *(const uint2*)(base + aoff3); raw[u][4] = *(const uint2*)(base + aoff4);
      }
    };
    auto stage = [&](int c) {
      float r4[2][4], k4[2][4], kk4[2][4], v4[2][4];
#pragma unroll
      for (int u = 0; u < 2; ++u) {
        const int sj = 8 * sw + 4 * u + (lane >> 4);
        r4[u][0] = bflo(raw[u][0].x); r4[u][1] = bfhi(raw[u][0].x); r4[u][2] = bflo(raw[u][0].y); r4[u][3] = bfhi(raw[u][0].y);
        k4[u][0] = bflo(raw[u][1].x); k4[u][1] = bfhi(raw[u][1].x); k4[u][2] = bflo(raw[u][1].y); k4[u][3] = bfhi(raw[u][1].y);
        v4[u][0] = bflo(raw[u][2].x); v4[u][1] = bfhi(raw[u][2].x); v4[u][2] = bflo(raw[u][2].y); v4[u][3] = bfhi(raw[u][2].y);
        *(uint2*)(XL + sj * 72 + 4 * q) = raw[u][3];
        *(uint2*)(XL + 32 * 72 + sj * 72 + 4 * q) = raw[u][4];
        const float4 kkw = *(const float4*)(CS + 4 * q);
        float x0 = k4[u][0] * kkw.x, x1 = k4[u][1] * kkw.y, x2 = k4[u][2] * kkw.z, x3 = k4[u][3] * kkw.w;
        float ss = sum16(x0 * x0 + x1 * x1 + x2 * x2 + x3 * x3);
        float inv = __builtin_amdgcn_rsqf(fmaxf(ss, 1e-24f));
        kk4[u][0] = x0 * inv; kk4[u][1] = x1 * inv; kk4[u][2] = x2 * inv; kk4[u][3] = x3 * inv;
      }
      LDS_FENCE();
      float* OPn = OP + (c & 1) * 32 * 392;
#pragma unroll
      for (int mat = 0; mat < 2; ++mat)
#pragma unroll
        for (int nt2 = 0; nt2 < 2; ++nt2) {
          f32x16 acc;
#pragma unroll
          for (int r = 0; r < 16; ++r) acc[r] = 0.f;
          const u16* xb = XL + mat * 32 * 72 + (8 * sw + (l32 & 7)) * 72 + hh * 8;
#pragma unroll
          for (int ks = 0; ks < 4; ++ks) acc = MFMA(*(const bf16x8*)(xb + ks * 16), *(const bf16x8*)(WL + (mat * 64 + nt2 * 32 + l32) * 72 + ks * 16 + hh * 8), acc);
#pragma unroll
          for (int r = 0; r < 4; ++r) {
            float x = acc[r] + bias[mat][nt2];
            float sg = sigmoidf_(x);
            float val = mat ? sg : __expf(-0.6065306597126334f * sg);
            OPn[(8 * sw + 4 * hh + r) * 392 + (mat ? 0 : 128) + nt2 * 32 + l32] = val;
          }
        }
      LDS_FENCE();
#pragma unroll
      for (int u = 0; u < 2; ++u) {
        const int sj = 8 * sw + 4 * u + (lane >> 4);
        const float4 w4 = *(const float4*)(OPn + sj * 392 + 128 + 4 * q);
        const float4 a4 = *(const float4*)(OPn + sj * 392 + 4 * q);
        const float4 ka = *(const float4*)(CS + 64 + 4 * q);
        const float4 brk = *(const float4*)(CS + 128 + 4 * q);
        const float wv4[4] = {w4.x, w4.y, w4.z, w4.w}, av4[4] = {a4.x, a4.y, a4.z, a4.w};
        const float kav[4] = {ka.x, ka.y, ka.z, ka.w}, bkv[4] = {brk.x, brk.y, brk.z, brk.w};
        float bb[4], kd[4];
        float bs = 0.f;
#pragma unroll
        for (int e = 0; e < 4; ++e) {
          bb[e] = -kk4[u][e] * av4[e];
          kd[e] = k4[u][e] * (1.f + (av4[e] - 1.f) * kav[e]);
          bs += r4[u][e] * kd[e] * bkv[e];
        }
        bs = sum16(bs);
        float* o = OPn + sj * 392 + 4 * q;
        *(float4*)(o) = make_float4(kk4[u][0], kk4[u][1], kk4[u][2], kk4[u][3]);
        *(float4*)(o + 64) = make_float4(r4[u][0], r4[u][1], r4[u][2], r4[u][3]);
        *(float4*)(o + 128) = w4;
        *(float4*)(o + 192) = make_float4(bb[0], bb[1], bb[2], bb[3]);
        *(float4*)(o + 256) = make_float4(kd[0], kd[1], kd[2], kd[3]);
        *(float4*)(o + 320) = make_float4(v4[u][0], v4[u][1], v4[u][2], v4[u][3]);
        if (q == 0) {
          const int sidx = c * 32 + sj;
          if (sidx < L && rowhalf == 0) { const int tok = d == 0 ? sidx : L - 1 - sidx; p.bsc[((size_t)d * TP + r0 + tok) * 8 + hd] = bs; }
        }
      }
    };
    auto writeout = [&](int c) {
      const float* yb = YB + (c & 1) * 2048;
#pragma unroll
      for (int u = 0; u < 2; ++u) {
        const int sj = 8 * sw + 4 * u + (lane >> 4);
        const int sidx = c * 32 + sj;
        const bool mine = CPL == 16 ? true : ((q >> 3) == rowhalf);
        if (sidx < L && mine) {
          const int tok = d == 0 ? sidx : L - 1 - sidx;
          const float4 yv = *(const float4*)(yb + sj * 64 + 4 * q);
          store4((u16*)p.out + (size_t)(r0 + tok) * 1024 + d * 512 + hd * 64 + 4 * q, yv.x, yv.y, yv.z, yv.w);
        }
      }
    };
    load_raw(0);
    stage(0);
    if (nch > 1) load_raw(1);
    __syncthreads();
    for (int c = 0; c < nch; ++c) {
      if (c + 1 < nch) { stage(c + 1); if (c + 2 < nch) load_raw(c + 2); }
      if (c >= 1) writeout(c - 1);
      __syncthreads();
    }
    writeout(nch - 1);
  } else {
    constexpr int LPRW = 64 / CPL;
    constexpr int NV = CPL / 2;
    const int cg = lane % LPRW;
    const int row = (CPL == 8 ? rowhalf * 32 + wv * 8 : wv * 16) + lane / LPRW;
    f2 S[NV];
#pragma unroll
    for (int i = 0; i < NV; ++i) S[i] = mk2(0.f, 0.f);
    __builtin_amdgcn_s_setprio(3);
    __syncthreads();
    for (int c = 0; c < nch; ++c) {
      const int nst = min(32, L - c * 32);
      const float* ob = OP + (c & 1) * 32 * 392;
      float* yb = YB + (c & 1) * 2048;
      float* ydst = cg == 0 ? yb + row : (float*)(smem + 147712) + lane;
      const int ystride = cg == 0 ? 64 : 0;
      float4 ca[CPL / 4], cy[CPL / 4], cw[CPL / 4], cb[CPL / 4], ck[CPL / 4];
      float cvv;
      {
        const float* o = ob + cg * CPL;
#pragma unroll
        for (int i = 0; i < CPL / 4; ++i) {
          ca[i] = *(const float4*)(o + 4 * i); cy[i] = *(const float4*)(o + 64 + 4 * i); cw[i] = *(const float4*)(o + 128 + 4 * i);
          cb[i] = *(const float4*)(o + 192 + 4 * i); ck[i] = *(const float4*)(o + 256 + 4 * i);
        }
        cvv = ob[320 + row];
      }
#pragma unroll 4
      for (int jj = 0; jj < nst; ++jj) {
        float4 na[CPL / 4], ny[CPL / 4], nw[CPL / 4], nb[CPL / 4], nk[CPL / 4];
        float nvv;
        {
          const int jn = jj + 1;
          const float* o = ob + jn * 392 + cg * CPL;
#pragma unroll
          for (int i = 0; i < CPL / 4; ++i) {
            na[i] = *(const float4*)(o + 4 * i); ny[i] = *(const float4*)(o + 64 + 4 * i); nw[i] = *(const float4*)(o + 128 + 4 * i);
            nb[i] = *(const float4*)(o + 192 + 4 * i); nk[i] = *(const float4*)(o + 256 + 4 * i);
          }
          nvv = ob[jn * 392 + 320 + row];
        }
        f2 A[NV], Y[NV], W[NV], B[NV], K[NV];
#pragma unroll
        for (int i = 0; i < CPL / 4; ++i) {
          A[2 * i] = mk2(ca[i].x, ca[i].y); A[2 * i + 1] = mk2(ca[i].z, ca[i].w);
          Y[2 * i] = mk2(cy[i].x, cy[i].y); Y[2 * i + 1] = mk2(cy[i].z, cy[i].w);
          W[2 * i] = mk2(cw[i].x, cw[i].y); W[2 * i + 1] = mk2(cw[i].z, cw[i].w);
          B[2 * i] = mk2(cb[i].x, cb[i].y); B[2 * i + 1] = mk2(cb[i].z, cb[i].w);
          K[2 * i] = mk2(ck[i].x, ck[i].y); K[2 * i + 1] = mk2(ck[i].z, ck[i].w);
        }
        const float vv = cvv;
        f2 pa0 = S[0] * A[0], pa1 = S[1] * A[1];
#pragma unroll
        for (int i = 2; i < NV; i += 2) { pa0 = S[i] * A[i] + pa0; pa1 = S[i + 1] * A[i + 1] + pa1; }
        pa0 = pa0 + pa1;
        float da = pa0.x + pa0.y;
        const f2 vvv = mk2(vv, vv);
        f2 SW[NV];
#pragma unroll
        for (int i = 0; i < NV; ++i) SW[i] = S[i] * W[i] + vvv * K[i];
        da += __int_as_float(__builtin_amdgcn_update_dpp(0, __float_as_int(da), 0xB1, 0xf, 0xf, false));
        da += __int_as_float(__builtin_amdgcn_update_dpp(0, __float_as_int(da), 0x4E, 0xf, 0xf, false));
        if (CPL == 8) da += __int_as_float(__builtin_amdgcn_update_dpp(0, __float_as_int(da), 0x141, 0xf, 0xf, false));
        const f2 dav = mk2(da, da);
#pragma unroll
        for (int i = 0; i < NV; ++i) S[i] = dav * B[i] + SW[i];
        f2 py0 = S[0] * Y[0], py1 = S[1] * Y[1];
#pragma unroll
        for (int i = 2; i < NV; i += 2) { py0 = S[i] * Y[i] + py0; py1 = S[i + 1] * Y[i + 1] + py1; }
        py0 = py0 + py1;
        float yv = py0.x + py0.y;
        yv += __int_as_float(__builtin_amdgcn_update_dpp(0, __float_as_int(yv), 0xB1, 0xf, 0xf, false));
        yv += __int_as_float(__builtin_amdgcn_update_dpp(0, __float_as_int(yv), 0x4E, 0xf, 0xf, false));
        if (CPL == 8) yv += __int_as_float(__builtin_amdgcn_update_dpp(0, __float_as_int(yv), 0x141, 0xf, 0xf, false));
        ydst[jj * ystride] = yv;
#pragma unroll
        for (int i = 0; i < CPL / 4; ++i) { ca[i] = na[i]; cy[i] = ny[i]; cw[i] = nw[i]; cb[i] = nb[i]; ck[i] = nk[i]; }
        cvv = nvv;
      }
      __syncthreads();
    }
    __builtin_amdgcn_s_setprio(0);
  }
  __syncthreads();
}

DI void shift_item(CP p, int layer, int ch, char* smem) {
  const int tid = tidx();
  int s, c;
  if (ch < 258) { s = ch / 129; c = ch - s * 129; } else { int x = ch - 258; s = 2 + x / 33; c = x - (s - 2) * 33; }
  const int L = seq_len(s), r0 = seq_start(s) + c * 64;
  const int nrows = min(64, L - c * 64);
  const int cgp = tid & 255, rg = tid >> 8;
  const int col = cgp * 8;
  const int rlo = rg * 32, rhi = min(rlo + 32, nrows);
  const bool act = cgp < 244 && rlo < nrows;
  typedef unsigned u32x4 __attribute__((ext_vector_type(4)));
  u32x4 prev = {0u, 0u, 0u, 0u}, cur = prev, lastn = prev;
  float mu0[8], mu1[8];
  u16* base = p.regB + (size_t)r0 * 1952 + col;
  if (act) {
#pragma unroll
    for (int e = 0; e < 8; ++e) { mu0[e] = p.shift_mu[(size_t)(layer * 2) * 1952 + col + e]; mu1[e] = p.shift_mu[(size_t)(layer * 2 + 1) * 1952 + col + e]; }
    if (rlo > 0) prev = *(const u32x4*)(base + (size_t)(rlo - 1) * 1952);
    else if (c > 0) prev = *(const u32x4*)(halo_ptr(p) + ((size_t)(ch - 1) * 2 + 1) * 1952 + col);
    cur = *(const u32x4*)(base + (size_t)rlo * 1952);
    if (rhi < nrows) lastn = *(const u32x4*)(base + (size_t)rhi * 1952);
    else if (c * 64 + nrows < L) lastn = *(const u32x4*)(halo_ptr(p) + ((size_t)(ch + 1) * 2) * 1952 + col);
  }
  __syncthreads();
  if (act) {
    const int kind = col < 1536 ? 0 : col < 1664 ? 1 : col < 1792 ? 0 : 2;
    for (int rb = rlo; rb < rhi; rb += 8) {
      u32x4 rw[9];
      rw[0] = cur;
#pragma unroll
      for (int i = 1; i < 9; ++i) { const int r = rb + i; rw[i] = (r < rhi) ? *(const u32x4*)(base + (size_t)r * 1952) : lastn; }
#pragma unroll
      for (int i = 0; i < 8; ++i) {
        const u32x4 cc = rw[i], nn = rw[i + 1];
        const unsigned pc[4] = {cc.x, cc.y, cc.z, cc.w}, pm[4] = {prev.x, prev.y, prev.z, prev.w}, pn[4] = {nn.x, nn.y, nn.z, nn.w};
        unsigned o[4];
#pragma unroll
        for (int e = 0; e < 4; ++e) {
          float c0 = bflo(pc[e]), c1 = bfhi(pc[e]);
          float x0 = c0 + mu0[2 * e] * (bflo(pm[e]) - c0) + mu1[2 * e] * (bflo(pn[e]) - c0);
          float x1 = c1 + mu0[2 * e + 1] * (bfhi(pm[e]) - c1) + mu1[2 * e + 1] * (bfhi(pn[e]) - c1);
          if (kind == 1) { x0 = 1.f - 2.f * __builtin_amdgcn_rcpf(__expf(2.f * x0) + 1.f); x1 = 1.f - 2.f * __builtin_amdgcn_rcpf(__expf(2.f * x1) + 1.f); }
          else if (kind == 2) { x0 = sigmoidf_(x0); x1 = sigmoidf_(x1); }
          o[e] = pack2(x0, x1);
        }
        { u32x4 ov = {o[0], o[1], o[2], o[3]}; *(u32x4*)(base + (size_t)(rb + i) * 1952) = ov; }
        prev = cc;
      }
      cur = rw[8];
    }
  }
  __syncthreads();
}

DI void init_rows(CP p, int item) {
  const int lane = tidx() & 63, wv = tidx() >> 6;
  const int r = item * 8 + wv;
  if (r >= TP) return;
  u16* dst = p.hb + (size_t)r * 1024 + lane * 16;
  float ss = 0.f;
  if (r < T) {
    int s, pos, L; row2seq(r, s, pos, L);
    const float* src = pos < 16 ? p.meta + pos * 1024
                     : (s < 2 ? p.x_prompt + ((size_t)s * 8192 + pos - 16) * 1024 : p.x_sample + ((size_t)(s - 2) * 2048 + pos - 16) * 1024);
    src += lane * 16;
    unsigned pk[8];
#pragma unroll
    for (int i = 0; i < 4; ++i) {
      float4 v = *(const float4*)(src + 4 * i);
      pk[2 * i] = pack2(v.x, v.y); pk[2 * i + 1] = pack2(v.z, v.w);
      float a = bflo(pk[2 * i]), b = bfhi(pk[2 * i]), c = bflo(pk[2 * i + 1]), dd = bfhi(pk[2 * i + 1]);
      ss += a * a + b * b + c * c + dd * dd;
    }
    *(uint4*)dst = make_uint4(pk[0], pk[1], pk[2], pk[3]);
    *(uint4*)(dst + 8) = make_uint4(pk[4], pk[5], pk[6], pk[7]);
  } else {
    *(uint4*)dst = make_uint4(0, 0, 0, 0);
    *(uint4*)(dst + 8) = make_uint4(0, 0, 0, 0);
  }
#pragma unroll
  for (int o = 32; o > 0; o >>= 1) ss += __shfl_xor(ss, o);
  if (lane < 16) p.ssq[(size_t)lane * TP + r] = lane == 0 ? ss : 0.f;
}
DI void init_rope(CP p, int item) {
  const int idx = item * NTHR + tidx();
  if (idx >= LPR * 16) return;
  const int pos = idx >> 4, i = idx & 15;
  double rev = (double)pos * ROPE_INV[i] * 0.15915494309189535;
  rev -= rint(rev);
  const float fr = (float)rev;
  p.ropec[idx] = __builtin_amdgcn_cosf(fr);
  p.ropes[idx] = __builtin_amdgcn_sinf(fr);
}
DI void final_rows(CP p, int item) {
  const int lane = tidx() & 63, wv = tidx() >> 6;
  const int orow = item * 8 + wv;
  int r;
  if (orow < 16384) { int s = orow >> 13; r = s * LPR + 16 + (orow & 8191); }
  else { int x = orow - 16384; int s = x >> 11; r = 2 * LPR + s * LSM + 16 + (x & 2047); }
  const float rs = rstd16(p.ssq, r);
  const u16* src = p.hb + (size_t)r * 1024 + lane * 16;
  uint4 a = *(const uint4*)src, b = *(const uint4*)(src + 8);
  unsigned w[8] = {a.x, a.y, a.z, a.w, b.x, b.y, b.z, b.w};
  float* dst = p.out + (size_t)orow * 1024 + lane * 16;
  const float* gn = p.final_norm + lane * 16;
#pragma unroll
  for (int i = 0; i < 4; ++i) {
    float4 o;
    o.x = bflo(w[2 * i]) * rs * gn[4 * i]; o.y = bfhi(w[2 * i]) * rs * gn[4 * i + 1];
    o.z = bflo(w[2 * i + 1]) * rs * gn[4 * i + 2]; o.w = bfhi(w[2 * i + 1]) * rs * gn[4 * i + 3];
    *(float4*)(dst + 4 * i) = o;
  }
}

#define XB_TMO      128
#define XB_XCNT(j)  (256  + 64 * (j))
#define XB_XSUB(j)  (1280 + 64 * (j))
#define XB_XGEN(j)  (2304 + 64 * (j))
#define XB_TOP      3328
#define XB_TOPGEN   3392
#define XCD_BAR_WORDS 3456
#define XB_SPIN_CAP (1u << 18)
#define LAS __attribute__((address_space(3)))

__device__ __forceinline__ unsigned xb_ld(unsigned* p)              { return __hip_atomic_load(p, __ATOMIC_RELAXED, __HIP_MEMORY_SCOPE_AGENT); }
__device__ __forceinline__ unsigned xb_add(unsigned* p, unsigned v) { return __hip_atomic_fetch_add(p, v, __ATOMIC_RELAXED, __HIP_MEMORY_SCOPE_AGENT); }
__device__ __forceinline__ unsigned xb_xcc_id() { return (unsigned)__builtin_amdgcn_s_getreg((3 << 11) | 20) & 0xFu; }
#define XB_SPIN(cond, bar) do { unsigned _sp = 0; while (cond) { __builtin_amdgcn_s_sleep(1); \
    if ((++_sp & 255u) == 0u) { if (xb_ld(&(bar)[XB_TMO])) break; if (_sp > XB_SPIN_CAP) { atomicAdd(&(bar)[XB_TMO], 1u); break; } } } } while (0)

struct XcdBarrier {
    unsigned* bar; unsigned x;
    volatile LAS unsigned* st;
};

__device__ __forceinline__ XcdBarrier xcd_barrier_post(unsigned* bar, volatile LAS unsigned* st) {
    XcdBarrier b; b.bar = bar; b.x = xb_xcc_id(); b.st = st;
    if (threadIdx.x == 0) (void)xb_add(&bar[XB_XCNT(b.x)], 1u);
    return b;
}
__device__ __forceinline__ void xcd_barrier_complete(unsigned* bar, unsigned x, unsigned& nloc, unsigned& nx) {
    const unsigned G = gridDim.x * gridDim.y * gridDim.z;
    unsigned sum, cnt, mine, sp = 0u;
    for (;;) {
        sum = 0u; cnt = 0u; mine = 0u;
#pragma unroll
        for (unsigned j = 0; j < 16; ++j) { const unsigned c = xb_ld(&bar[XB_XCNT(j)]); sum += c; cnt += (c > 0u) ? 1u : 0u; mine = (j == x) ? c : mine; }
        if (sum == G) break;
        __builtin_amdgcn_s_sleep(1);
        if ((++sp & 255u) == 0u) { if (xb_ld(&bar[XB_TMO])) break; if (sp > XB_SPIN_CAP) { atomicAdd(&bar[XB_TMO], 1u); break; } }
    }
    nloc = mine > 0u ? mine : 1u; nx = cnt > 0u ? cnt : 1u;
}

__device__ __forceinline__ void xcd_barrier(const XcdBarrier& b) {
    asm volatile("s_waitcnt vmcnt(0)" ::: "memory");
    __syncthreads();
    if (threadIdx.x == 0) {
        unsigned* bar = b.bar;
        __builtin_amdgcn_s_waitcnt(0);
        unsigned nloc = b.st[0], nx = b.st[1];
        if (nloc == 0u) { xcd_barrier_complete(bar, b.x, nloc, nx); b.st[0] = nloc; b.st[1] = nx; }
        const unsigned old = xb_add(&bar[XB_XSUB(b.x)], 1u);
        const unsigned gen = old / nloc;
        if (old + 1u == (gen + 1u) * nloc) {
            __builtin_amdgcn_fence(__ATOMIC_RELEASE, "agent");
            asm volatile("s_waitcnt vmcnt(0)" ::: "memory");
            const unsigned og = xb_add(&bar[XB_TOP], 1u);
            const unsigned tg = og / nx;
            if (og + 1u == (tg + 1u) * nx) xb_add(&bar[XB_TOPGEN], 1u);
            else XB_SPIN(xb_ld(&bar[XB_TOPGEN]) == tg, bar);
            __builtin_amdgcn_fence(__ATOMIC_ACQUIRE, "agent");
            xb_add(&bar[XB_XGEN(b.x)], 1u);
            asm volatile("s_waitcnt vmcnt(0)" ::: "memory");
        } else {
            XB_SPIN(xb_ld(&bar[XB_XGEN(b.x)]) == gen, bar);
            __builtin_amdgcn_fence(__ATOMIC_ACQUIRE, "agent");
            asm volatile("s_waitcnt vmcnt(0)" ::: "memory");
        }
    }
    __syncthreads();
}

constexpr int NPHASE = 21;
#ifndef ONLY
#define EN(x) true
#else
#define EN(x) ((x) == ONLY)
#endif
DI void run_phase(CP p, int ph, char* smem) {
  const int bid = blockIdx.x, nb = gridDim.x;
  const int fidx = (bid & 7) ? (bid >> 3) * 7 + (bid & 7) - 1 : -1, nfill = (nb >> 3) * 7;
  if (EN(100) && ph == 0) {
    const int n0 = NCONV_FFN, n1 = n0, n2 = n1 + TP / 8, n3 = n2 + (LPR * 16 + NTHR - 1) / NTHR;
    for (int it = bid; it < n3; it += nb) {
      if (it < n0) conv_ffn(p, 0, 0, it, smem);
      else if (it < n2) init_rows(p, it - n1);
      else init_rope(p, it - n2);
    }
    if (bid == 0 && tidx() < 4) p.ctr[tidx()] = 0u;
    return;
  }
  if (ph == 10) return;
  if (EN(102) && ph == 20) { for (int it = bid; it < 4096; it += nb) final_rows(p, it); return; }
  const int layer = ph > 10 ? 1 : 0;
  const int k = ph - (layer ? 11 : 1);
  GArgs g{};
  g.layer = layer; g.scale = 1.f;
  u16* outb = (u16*)p.out;
  switch (k) {
    case 0: case 7: if (EN(0)) {
      g.a0 = p.hb; g.ld0 = 1024; g.split = 1 << 30; g.ks0 = 64; g.a1 = p.hb; g.ld1 = 1024; g.W = (layer == 1 && k == 0) ? p.kn : p.wF; g.K = 1024;
      gemm_phase<0, EPI_UP, 256>(p, g, 22, smem);
      if (k == 7 && layer == 0 && fidx >= 0) for (int it = fidx; it < NCONV_FFN; it += nfill) conv_ffn(p, 1, 0, it, smem);
    } break;
    case 1: case 8: if (EN(1)) {
      g.a0 = p.regB; g.ld0 = 1408; g.split = 22; g.ks0 = 64; g.a1 = outb; g.ld1 = 1408; g.W = ((layer == 1 && k == 1) ? p.kn : p.wF) + OFF_WD; g.K = 2816; g.scale = 0.5f;
      gemm_phase<0, EPI_RES, 256>(p, g, 4, smem);
      if (layer == 0 && fidx >= 0) for (int it = fidx; it < NCONV_MIX; it += nfill) conv_mix(p, k == 1 ? 0 : 1, it, smem);
    } break;
    case 2: if (EN(2)) {
      g.a0 = p.hb; g.ld0 = 1024; g.split = 1 << 30; g.ks0 = 64; g.a1 = p.hb; g.ld1 = 1024; g.W = p.wM + OFF_IN; g.K = 1024;
      gemm_phase<0, EPI_INPROJ, 256>(p, g, 10, smem);
    } break;
    case 3: if (EN(3)) {
      const int nq = NMT * 6, nkv = NMT * 8, nsh = 522, ntot = nq + nkv + nsh;
      for (int it = bid; it < ntot; it += nb) {
        if (it < nq) {
          g.a0 = outb; g.ld0 = 512; g.split = 1 << 30; g.ks0 = 64; g.a1 = outb; g.ld1 = 512; g.W = p.wM + OFF_UQ; g.K = 256;
          gemm_phase_item<0, EPI_Q>(p, g, it, 6, smem);
        } else if (it < nq + nkv) {
          g.a0 = outb + 256; g.ld0 = 512; g.split = 1 << 30; g.ks0 = 64; g.a1 = outb; g.ld1 = 512; g.W = p.wM + OFF_UKV; g.K = 128;
          gemm_phase_item<0, EPI_KV>(p, g, it - nq, 8, smem);
        } else shift_item(p, layer, it - nq - nkv, smem);
      }
    } break;
    case 4: if (EN(4)) {
      for (int sc = bid; sc < 192; sc += nb) {
        if (sc < 64) { int x = sc >> 1; scan_block2<8>(p, layer, x >> 4, (x >> 3) & 1, x & 7, sc & 1, smem); }
        else { int x = sc - 64; scan_block2<16>(p, layer, 2 + (x >> 4), (x >> 3) & 1, x & 7, 0, smem); }
      }
      unsigned* bc = (unsigned*)(smem + SMEM_BYTES - 16);
      while (true) {
        __syncthreads();
        if (tidx() == 0) *bc = atomicAdd(p.ctr + layer, 1u);
        __syncthreads();
        const int it = (int)*bc;
        if (it >= 1104 + NCONV_FFN) break;
        if (it >= 1104) { conv_ffn(p, layer, 1, it - 1104, smem); continue; }
        int s, hd, qb;
        if (it < 528) { s = it / 264; int rem = it - s * 264; hd = rem / 33; qb = rem - hd * 33; }
        else { int x = it - 528; s = 2 + x / 72; int rem = x % 72; hd = rem / 9; qb = rem - hd * 9; }
#ifdef PROBE_ATT2
        attn_item(p, s, hd, qb, smem, p.ctr[8] == 12345u);
        __syncthreads();
#endif
        attn_item(p, s, hd, qb, smem);
      }
    } break;
    case 5: if (EN(5)) {
      g.W = p.wM + OFF_G; g.K = 192; g.a0 = p.regB + 1792; g.a1 = g.a0; g.ld0 = g.ld1 = 1952; g.split = 1 << 30; g.ks0 = 64;
      gemm_phase<0, EPI_POST, 256>(p, g, 2, smem);
    } break;
    case 6: if (EN(6)) {
      g.a0 = outb + (size_t)TP * 1024; g.ld0 = 768; g.split = 8; g.ks0 = 96; g.a1 = outb; g.ld1 = 1024; g.W = p.wM + OFF_OUT; g.K = 1024;
      gemm_phase<0, EPI_RES, 256>(p, g, 4, smem);
    } break;
  }
}

template <bool COOP>
__global__ void __launch_bounds__(NTHR) mega(Params pp, int lo, int hi) {
  extern __shared__ __attribute__((aligned(16))) char smem[];
  const __attribute__((address_space(4))) Params* kp = (const __attribute__((address_space(4))) Params*)__builtin_amdgcn_kernarg_segment_ptr();
  volatile LAS unsigned* st = (volatile LAS unsigned*)(smem + SMEM_BYTES - 32);
  if (threadIdx.x == 0) { st[0] = 0u; st[1] = 0u; }
  __syncthreads();
  XcdBarrier xb = xcd_barrier_post(kp->bar, st);
  for (int ph = lo; ph < hi; ++ph) {
    if (ph == 10) continue;
    asm volatile("" : "+s"(kp));
    run_phase(*kp, ph, smem);
    if (COOP && ph + 1 < hi) {
      if (ph == 0) cg::this_grid().sync();
      else xcd_barrier(xb);
    }
  }
}

extern "C" void kernel_launch(void* const* d_in, const int* in_sizes, int n_in, void* d_out, int out_size, void* d_ws, size_t ws_size,
                              hipStream_t stream) {
  Params p{};
  const float** pf = (const float**)&p;
  for (int i = 0; i < 30; ++i) pf[i] = (const float*)d_in[i];
  p.out = (float*)d_out;
  char* w = (char*)d_ws;
  size_t off = 0;
  auto take = [&](size_t bytes) { char* r = w + off; off += (bytes + 255) & ~(size_t)255; return r; };
  p.hb = (u16*)take((size_t)TP * 1024 * 2);
  p.regB = (u16*)take((size_t)TP * 1952 * 2);
  p.kn = (u16*)take((size_t)TP * 512 * 2);
  p.vt = (u16*)take((size_t)TP * 512 * 2);
  p.wF = (u16*)take((size_t)WF_ELEMS * 2);
  p.wM = (u16*)take((size_t)WM_ELEMS * 2);
  p.ssq = (float*)take((size_t)16 * TP * 4);
  p.ssqq = (float*)take((size_t)6 * TP * 4);
  p.bsc = (float*)take((size_t)2 * TP * 8 * 4);
  p.ropec = (float*)take((size_t)LPR * 16 * 4);
  p.ropes = (float*)take((size_t)LPR * 16 * 4);
  p.ctr = (unsigned*)take(256);
  p.bar = (unsigned*)take((size_t)XCD_BAR_WORDS * 4);
  if (off > ws_size) fprintf(stderr, "workspace too small: need %zu have %zu\n", off, ws_size);
#ifndef MULTI_LAUNCH
  static int grid_blocks = 0;
  if (!grid_blocks) {
    hipFuncSetAttribute((const void*)mega<true>, hipFuncAttributeMaxDynamicSharedMemorySize, SMEM_BYTES);
    int dev = 0, cus = 0, per_cu = 0;
    hipGetDevice(&dev);
    hipDeviceGetAttribute(&cus, hipDeviceAttributeMultiprocessorCount, dev);
    hipOccupancyMaxActiveBlocksPerMultiprocessor(&per_cu, mega<true>, NTHR, SMEM_BYTES);
    if (per_cu > 1) per_cu = 1;
    grid_blocks = cus * per_cu;
  }
  hipMemsetAsync(p.bar, 0, (size_t)XCD_BAR_WORDS * 4, stream);
  int lo = 0, hi = NPHASE;
  void* args[] = {&p, &lo, &hi};
  hipError_t e = hipLaunchCooperativeKernel((void*)mega<true>, dim3(grid_blocks), dim3(NTHR), args, SMEM_BYTES, stream);
  if (e != hipSuccess) fprintf(stderr, "cooperative launch failed: %s (grid %d)\n", hipGetErrorString(e), grid_blocks);
#else
  hipFuncSetAttribute((const void*)mega<false>, hipFuncAttributeMaxDynamicSharedMemorySize, SMEM_BYTES);
  for (int ph = 0; ph < NPHASE; ++ph) mega<false><<<256, NTHR, SMEM_BYTES, stream>>>(p, ph, ph + 1);
#endif
}
```

```cpp
#include <hip/hip_runtime.h>
#include <hip/hip_cooperative_groups.h>
#include <cstdio>
namespace cg = cooperative_groups;

typedef unsigned short u16;
typedef __attribute__((ext_vector_type(8))) short bf16x8;
typedef __attribute__((ext_vector_type(16))) float f32x16;
#define DI __device__ __forceinline__
#define MFMA(a, b, c) __builtin_amdgcn_mfma_f32_32x32x16_bf16((a), (b), (c), 0, 0, 0)

constexpr int T = 32928, TP = 33024, LPR = 8208, LSM = 2064, NMT = 129;
constexpr int NTHR = 512;
constexpr float RMS_EPS = 1e-6f, LNX_EPS = 64e-5f;
constexpr float QSCALE = 0.10206207261596575f * 1.4426950408889634f;
constexpr int OFF_IN = 0, OFF_UQ = 2621440, OFF_UKV = 2818048, OFF_DEC = 2949120, OFF_A = 3014656, OFF_G = 3080192, OFF_OUT = 3178496, WM_ELEMS = 4227072;
constexpr int OFF_WD = 5767168, WF_ELEMS = 8650752;
constexpr int SMEM_BYTES = 149504;

__constant__ double ROPE_INV[16] = {1.0, 0.5623413251903491, 0.31622776601683794, 0.1778279410038923, 0.1, 0.05623413251903491,
  0.031622776601683794, 0.01778279410038923, 0.01, 0.005623413251903491, 0.0031622776601683794, 0.001778279410038923,
  0.001, 0.0005623413251903491, 0.00031622776601683794, 0.0001778279410038923};

struct Params {
  const float *x_prompt, *x_sample, *meta, *ffn1_norm, *ffn1_wg, *ffn1_wu, *ffn1_wd, *mix_norm, *w_in, *shift_mu, *q_norm, *w_uq,
      *kv_norm, *w_ukv, *decay_w0, *decay_w2, *iclr_a0, *iclr_a2, *gate_g2, *key_k_k, *key_k_a, *bonus_r_k, *lnx_w, *lnx_b, *w_out,
      *ffn2_norm, *ffn2_wg, *ffn2_wu, *ffn2_wd, *final_norm;
  float* out;
  u16 *hb, *regB, *kn, *vt, *wF, *wM;
  float *ssq, *ssqq, *bsc, *ropec, *ropes;
  unsigned* ctr;
  unsigned* bar;
};

typedef const __attribute__((address_space(4))) Params& CP;
DI int tidx() { int t = __builtin_amdgcn_workitem_id_x(); asm volatile("" : "+v"(t)); return t; }
DI u16 f2bf(float x) { unsigned u = __float_as_uint(x); u += 0x7fffu + ((u >> 16) & 1u); return (u16)(u >> 16); }
DI float bf2f(u16 b) { return __uint_as_float(((unsigned)b) << 16); }
typedef __bf16 bf16x2_t __attribute__((ext_vector_type(2)));
typedef float fl2_t __attribute__((ext_vector_type(2)));
DI unsigned pack2(float a, float b) { fl2_t f; f.x = a; f.y = b; bf16x2_t r = __builtin_convertvector(f, bf16x2_t); return __builtin_bit_cast(unsigned, r); }
DI float bflo(unsigned u) { return __uint_as_float(u << 16); }
DI float bfhi(unsigned u) { return __uint_as_float(u & 0xffff0000u); }
DI float sigmoidf_(float x) { return __builtin_amdgcn_rcpf(1.f + __expf(-x)); }
DI int crow(int reg, int h) { return (reg & 3) + 8 * (reg >> 2) + 4 * h; }
DI void row2seq(int r, int& s, int& pos, int& L) {
  if (r < 2 * LPR) { s = r >= LPR ? 1 : 0; pos = r - s * LPR; L = LPR; }
  else { int q = (r - 2 * LPR) / LSM; s = 2 + q; pos = r - 2 * LPR - q * LSM; L = LSM; }
}
DI int seq_start(int s) { return s < 2 ? s * LPR : 2 * LPR + (s - 2) * LSM; }
DI int seq_len(int s) { return s < 2 ? LPR : LSM; }
DI float dpp_sum8(float x) {
  x += __int_as_float(__builtin_amdgcn_update_dpp(0, __float_as_int(x), 0xB1, 0xf, 0xf, false));
  x += __int_as_float(__builtin_amdgcn_update_dpp(0, __float_as_int(x), 0x4E, 0xf, 0xf, false));
  x += __int_as_float(__builtin_amdgcn_update_dpp(0, __float_as_int(x), 0x141, 0xf, 0xf, false));
  return x;
}
DI float sum16(float x) {
  x += __int_as_float(__builtin_amdgcn_update_dpp(0, __float_as_int(x), 0x128, 0xf, 0xf, false));
  x += __int_as_float(__builtin_amdgcn_update_dpp(0, __float_as_int(x), 0x124, 0xf, 0xf, false));
  x += __int_as_float(__builtin_amdgcn_update_dpp(0, __float_as_int(x), 0x122, 0xf, 0xf, false));
  x += __int_as_float(__builtin_amdgcn_update_dpp(0, __float_as_int(x), 0x121, 0xf, 0xf, false));
  return x;
}
DI float rstd16(const float* ssq, int m) {
  float s = 0.f;
#pragma unroll
  for (int c = 0; c < 16; ++c) s += ssq[(size_t)c * TP + m];
  return rsqrtf(s * (1.f / 1024.f) + RMS_EPS);
}

struct CJob { const float* src; const float* gain; u16* dst; int K, N, ld, map, nkt; };
DI int rowmap(int map, int n) {
  if (map == 1) return (n >> 5) * 64 + (n & 31);
  if (map == 2) return (n >> 5) * 64 + 32 + (n & 31);
  if (map == 3) return n < 416 ? n : n + 96;
  return n;
}
DI void conv_tile(const CJob& jb, int t, char* smem) {
  const int tid = tidx();
  const int kt = t % jb.nkt, ntile = t / jb.nkt;
  const int ny = tid >> 3, kx = tid & 7;
  const int n = ntile * 64 + ny, kb = kt * 64 + kx * 8;
  float v[8];
#pragma unroll
  for (int j = 0; j < 8; ++j) {
    const int k = kb + j, kc = min(k, jb.K - 1);
    float x = jb.src[(size_t)kc * jb.N + n];
    if (jb.gain) x *= jb.gain[kc];
    v[j] = k < jb.K ? x : 0.f;
  }
  uint4 o;
  o.x = pack2(v[0], v[1]); o.y = pack2(v[2], v[3]); o.z = pack2(v[4], v[5]); o.w = pack2(v[6], v[7]);
  *(uint4*)(jb.dst + (size_t)rowmap(jb.map, n) * jb.ld + kb) = o;
}
constexpr int NCONV_FFN = 2112, NCONV_MIX = 1032;
DI void conv_ffn(CP p, int l, int f, int t, char* smem) {
  CJob jb;
  u16* slot = (l == 1 && f == 0) ? p.kn : p.wF;
  const float* wg = f ? p.ffn2_wg : p.ffn1_wg; const float* wu = f ? p.ffn2_wu : p.ffn1_wu; const float* wd = f ? p.ffn2_wd : p.ffn1_wd;
  const float* nr = f ? p.ffn2_norm : p.ffn1_norm;
  if (t < 704) { jb = CJob{wg + (size_t)l * 1024 * 2816, nr + l * 1024, slot, 1024, 2816, 1024, 1, 16}; }
  else if (t < 1408) { t -= 704; jb = CJob{wu + (size_t)l * 1024 * 2816, nr + l * 1024, slot, 1024, 2816, 1024, 2, 16}; }
  else { t -= 1408; jb = CJob{wd + (size_t)l * 2816 * 1024, nullptr, slot + OFF_WD, 2816, 1024, 2816, 0, 44}; }
  conv_tile(jb, t, smem);
}
DI void conv_mix(CP p, int l, int t, char* smem) {
  CJob jb;
  if (t < 592) jb = CJob{p.w_in + (size_t)l * 1024 * 2368, p.mix_norm + l * 1024, p.wM + OFF_IN, 1024, 2368, 1024, 3, 16};
  else if (t < 640) { t -= 592; jb = CJob{p.w_uq + (size_t)l * 256 * 768, p.q_norm + l * 256, p.wM + OFF_UQ, 256, 768, 256, 0, 4}; }
  else if (t < 672) { t -= 640; jb = CJob{p.w_ukv + (size_t)l * 128 * 1024, p.kv_norm + l * 128, p.wM + OFF_UKV, 128, 1024, 128, 0, 2}; }
  else if (t < 688) { t -= 672; int d = t >> 3; t &= 7; jb = CJob{p.decay_w2 + (size_t)(l * 2 + d) * 64 * 512, nullptr, p.wM + OFF_DEC + d * 32768, 64, 512, 64, 0, 1}; }
  else if (t < 704) { t -= 688; int d = t >> 3; t &= 7; jb = CJob{p.iclr_a2 + (size_t)(l * 2 + d) * 64 * 512, nullptr, p.wM + OFF_A + d * 32768, 64, 512, 64, 0, 1}; }
  else if (t < 728) { t -= 704; jb = CJob{p.gate_g2 + (size_t)l * 160 * 512, nullptr, p.wM + OFF_G, 160, 512, 192, 0, 3}; }
  else if (t < 984) { t -= 728; jb = CJob{p.w_out + (size_t)l * 1024 * 1024, nullptr, p.wM + OFF_OUT, 1024, 1024, 1024, 0, 16}; }
  else {
    t -= 984;
    size_t base = (t < 24) ? (size_t)416 * 1024 + (size_t)t * 4096 : (size_t)2464 * 1024 + (size_t)(t - 24) * 4096;
    *(uint4*)(p.wM + OFF_IN + base + tidx() * 8) = make_uint4(0, 0, 0, 0);
    return;
  }
  conv_tile(jb, t, smem);
}

struct GArgs { const u16 *a0, *a1; int ld0, ld1, split, ks0; const u16* W; int K; int layer; float scale; };
enum { EPI_UP = 0, EPI_RES = 1, EPI_INPROJ = 2, EPI_Q = 3, EPI_KV = 4, EPI_POST = 5 };

DI uint4 load_gate(CP p, int layer, int m, int k) {
  uint4 z = make_uint4(0, 0, 0, 0);
  if (m >= T || k >= 160) return z;
  int s, pos, L; row2seq(m, s, pos, L);
  const u16* pb = p.regB + (size_t)m * 1952 + 1792 + k;
  uint4 c = *(const uint4*)pb;
  uint4 pm = pos > 0 ? *(const uint4*)(pb - 1952) : z;
  uint4 pp = pos + 1 < L ? *(const uint4*)(pb + 1952) : z;
  const float* mu0 = p.shift_mu + (size_t)(layer * 2 + 0) * 1952 + 1792 + k;
  const float* mu1 = p.shift_mu + (size_t)(layer * 2 + 1) * 1952 + 1792 + k;
  unsigned cc[4] = {c.x, c.y, c.z, c.w}, mm[4] = {pm.x, pm.y, pm.z, pm.w}, nn[4] = {pp.x, pp.y, pp.z, pp.w};
  unsigned o[4];
#pragma unroll
  for (int e = 0; e < 4; ++e) {
    float c0 = bflo(cc[e]), c1 = bfhi(cc[e]);
    float x0 = c0 + mu0[2 * e] * (bflo(mm[e]) - c0) + mu1[2 * e] * (bflo(nn[e]) - c0);
    float x1 = c1 + mu0[2 * e + 1] * (bfhi(mm[e]) - c1) + mu1[2 * e + 1] * (bfhi(nn[e]) - c1);
    o[e] = pack2(sigmoidf_(x0), sigmoidf_(x1));
  }
  return make_uint4(o[0], o[1], o[2], o[3]);
}

template <int MODE>
DI uint4 load_a(CP p, const GArgs& g, int row, int kt, int kc) {
  if (MODE == 1) return load_gate(p, g.layer, row, kt * 64 + kc * 8);
  const u16* ap = (kt < g.split) ? g.a0 + (size_t)row * g.ld0 + kt * g.ks0 : g.a1 + (size_t)row * g.ld1 + (kt - g.split) * 64;
  return *(const uint4*)(ap + kc * 8);
}

DI u16* halo_ptr(CP p) { return (u16*)p.out + (size_t)TP * 1024 + (size_t)TP * 768 + (size_t)TP * 32; }
DI uint4 ldg16(const u16* p) { uint4 v = *(const uint4*)p; return v; }
DI void sts16(u16* p, uint4 v) { *(uint4*)p = v; }
DI void store4(u16* dst, float a, float b, float c, float d) { *(uint2*)dst = make_uint2(pack2(a, b), pack2(c, d)); }

template <int MODE, int EPI, int BN>
DI void gemm_tile(CP p, const GArgs& g, int mt, int nt, char* smem, int chain = 0, int nmt = 0, int nnt = 0) {
  constexpr int WN = BN / 64, WM = 8 / WN, MI = 256 / WM / 32, NWC = BN / 64;
  u16* As = (u16*)smem;
  u16* Ws = As + 2 * 256 * 72;
  const int tid = tidx(), lane = tid & 63, wv = tid >> 6, wm = wv / WN, wn = wv % WN, l32 = lane & 31, hh = lane >> 5;
  const int m0 = mt * 256, n0 = nt * BN;
  const int nk = g.K >> 6;
  f32x16 acc[MI][2];
  float rs_early = 0.f;
  if ((EPI == EPI_UP || EPI == EPI_INPROJ) && tid < 256) rs_early = rstd16(p.ssq, m0 + tid);
#pragma unroll
  for (int i = 0; i < MI; ++i)
#pragma unroll
    for (int j = 0; j < 2; ++j)
#pragma unroll
      for (int r = 0; r < 16; ++r) acc[i][j][r] = 0.f;
  uint4 ra0[4], ra1[4], rw0[4], rw1[4];
#define GLA(KT, DA, I) { const int c_ = tid + (I) * 512; DA[I] = load_a<MODE>(p, g, m0 + (c_ >> 3), (KT), c_ & 7); }
#define GLW(KT, DW, I) if ((I) < NWC) { const int c_ = tid + (I) * 512; DW[I] = ldg16(g.W + (size_t)(n0 + (c_ >> 3)) * g.K + (KT) * 64 + (c_ & 7) * 8); }
#define GLOAD(KT, DA, DW) do { GLA(KT, DA, 0) GLA(KT, DA, 1) GLA(KT, DA, 2) GLA(KT, DA, 3) GLW(KT, DW, 0) GLW(KT, DW, 1) GLW(KT, DW, 2) GLW(KT, DW, 3) } while (0)
#define LSA(BUF, DA, I) { const int c_ = tid + (I) * 512; sts16(As + ((BUF) * 256 + (c_ >> 3)) * 72 + (c_ & 7) * 8, DA[I]); }
#define LSW(BUF, DW, I) if ((I) < NWC) { const int c_ = tid + (I) * 512; sts16(Ws + ((BUF) * BN + (c_ >> 3)) * 72 + (c_ & 7) * 8, DW[I]); }
#define LSTORE(BUF, DA, DW) do { LSA(BUF, DA, 0) LSA(BUF, DA, 1) LSA(BUF, DA, 2) LSA(BUF, DA, 3) LSW(BUF, DW, 0) LSW(BUF, DW, 1) LSW(BUF, DW, 2) LSW(BUF, DW, 3) } while (0)
  auto compute = [&](int buf) {
    const u16* Ab = As + buf * 256 * 72 + (wm * (MI * 32) + l32) * 72 + hh * 8;
    const u16* Wb = Ws + buf * BN * 72 + (wn * 64 + l32) * 72 + hh * 8;
#pragma unroll
    for (int ks = 0; ks < 4; ++ks) {
      bf16x8 wf0 = *(const bf16x8*)(Wb + ks * 16);
      bf16x8 wf1 = *(const bf16x8*)(Wb + 32 * 72 + ks * 16);
#pragma unroll
      for (int i = 0; i < MI; ++i) {
        bf16x8 xf = *(const bf16x8*)(Ab + i * 32 * 72 + ks * 16);
        acc[i][0] = MFMA(wf0, xf, acc[i][0]);
        acc[i][1] = MFMA(wf1, xf, acc[i][1]);
      }
    }
  };
  if (true) {
    char* L0 = smem;
    constexpr int BUFB = (256 + BN) * 128;
    constexpr int NBUF = BN <= 128 ? 3 : 2;
    constexpr int NGL = 4 + BN / 64;
    const int gl_row = lane >> 3;
    auto issue_at = [&](int mm0, int nn0, int kt, int buf) {
      char* lb = L0 + buf * BUFB;
#pragma unroll
      for (int i = 0; i < 4; ++i) {
        const int seg = wv * 4 + i, row = seg * 8 + gl_row;
        const int c = (lane & 7) ^ ((row >> 1) & 7);
        const u16* ap = (kt < g.split) ? g.a0 + (size_t)(mm0 + row) * g.ld0 + kt * g.ks0 : g.a1 + (size_t)(mm0 + row) * g.ld1 + (kt - g.split) * 64;
        __builtin_amdgcn_global_load_lds((const unsigned*)(ap + c * 8), (__attribute__((address_space(3))) unsigned*)(lb + seg * 1024 + lane * 16), 16, 0, 0);
      }
#pragma unroll
      for (int i = 0; i < BN / 64; ++i) {
        const int seg = wv * (BN / 64) + i, row = seg * 8 + gl_row;
        const int c = (lane & 7) ^ ((row >> 1) & 7);
        __builtin_amdgcn_global_load_lds((const unsigned*)(g.W + (size_t)(nn0 + row) * g.K + kt * 64 + c * 8),
                                         (__attribute__((address_space(3))) unsigned*)(lb + 256 * 128 + seg * 1024 + lane * 16), 16, 0, 0);
      }
    };
    auto issue = [&](int kt, int buf) { issue_at(m0, n0, kt, buf); };
    auto compute2 = [&](int buf) {
      const char* lb = L0 + buf * BUFB;
#pragma unroll
      for (int ks = 0; ks < 4; ++ks) {
        const int c = ks * 2 + hh;
        bf16x8 wf[2], xf[MI];
#pragma unroll
        for (int j = 0; j < 2; ++j) { const int r = wn * 64 + j * 32 + l32; wf[j] = *(const bf16x8*)(lb + 256 * 128 + r * 128 + ((c ^ ((r >> 1) & 7)) << 4)); }
#pragma unroll
        for (int i = 0; i < MI; ++i) { const int r = wm * (MI * 32) + i * 32 + l32; xf[i] = *(const bf16x8*)(lb + r * 128 + ((c ^ ((r >> 1) & 7)) << 4)); }
#pragma unroll
        for (int i = 0; i < MI; ++i) {
          acc[i][0] = MFMA(wf[0], xf[i], acc[i][0]);
          acc[i][1] = MFMA(wf[1], xf[i], acc[i][1]);
        }
      }
    };
    if (NBUF == 3) {
      issue(0, 0);
      if (nk > 1) { issue(1, 1); if (BN == 128) asm volatile("s_waitcnt vmcnt(6)" ::: "memory"); else asm volatile("s_waitcnt vmcnt(5)" ::: "memory"); }
      else asm volatile("s_waitcnt vmcnt(0)" ::: "memory");
      asm volatile("s_waitcnt lgkmcnt(0)" ::: "memory");
      __builtin_amdgcn_s_barrier();
      int buf = 0;
      for (int kt = 0; kt < nk; ++kt) {
        const int b2 = buf == 0 ? 2 : buf - 1;
        if (kt + 2 < nk) issue(kt + 2, b2);
        compute2(buf);
        if (kt + 2 < nk) { if (BN == 128) asm volatile("s_waitcnt vmcnt(6)" ::: "memory"); else asm volatile("s_waitcnt vmcnt(5)" ::: "memory"); }
        else asm volatile("s_waitcnt vmcnt(0)" ::: "memory");
        asm volatile("s_waitcnt lgkmcnt(0)" ::: "memory");
        __builtin_amdgcn_s_barrier();
        buf = buf == 2 ? 0 : buf + 1;
      }
    } else {
      if (!(chain & 1)) {
        issue(0, 0);
        asm volatile("s_waitcnt vmcnt(0)" ::: "memory");
        __syncthreads();
      }
      for (int kt = 0; kt < nk; ++kt) {
        const int buf = kt & 1;
        if (kt + 1 < nk) issue(kt + 1, buf ^ 1);
        else if (chain & 2) issue_at(nmt * 256, nnt * BN, 0, buf ^ 1);
        compute2(buf);
        asm volatile("s_waitcnt vmcnt(0)" ::: "memory");
        __syncthreads();
      }
    }
    __syncthreads();
  } else {
    GLOAD(0, ra0, rw0);
    LSTORE(0, ra0, rw0);
    __syncthreads();
    for (int kt = 0; kt < nk; ++kt) {
      const int buf = kt & 1;
      if (kt + 1 < nk) GLOAD(kt + 1, ra0, rw0);
      compute(buf);
      if (kt + 1 < nk) LSTORE(buf ^ 1, ra0, rw0);
      __syncthreads();
    }
  }
#undef GLOAD
#undef LSTORE
  float* rsl = (float*)(smem + 147456);
  if (EPI == EPI_UP || EPI == EPI_INPROJ) {
    if (tid < 256) rsl[tid] = rs_early;
    __syncthreads();
  }
  const int nw = n0 + wn * 64;
#pragma unroll
  for (int i = 0; i < MI; ++i) {
    const int m = m0 + wm * (MI * 32) + i * 32 + l32;
    if (EPI == EPI_UP) {
      const float rs = rsl[m - m0];
      const int hb0 = nw >> 1;
#pragma unroll
      for (int gq = 0; gq < 4; ++gq) {
        float v[4];
#pragma unroll
        for (int r = 0; r < 4; ++r) {
          float gt = acc[i][0][4 * gq + r] * rs, up = acc[i][1][4 * gq + r] * rs;
          v[r] = gt * sigmoidf_(gt) * up;
        }
        int hid = hb0 + 8 * gq + 4 * hh;
        u16* dst = hid < 1408 ? p.regB + (size_t)m * 1408 + hid : (u16*)p.out + (size_t)m * 1408 + (hid - 1408);
        store4(dst, v[0], v[1], v[2], v[3]);
      }
    } else if (EPI == EPI_RES) {
      float ss = 0.f;
#pragma unroll
      for (int j = 0; j < 2; ++j)
#pragma unroll
        for (int gq = 0; gq < 4; ++gq) {
          u16* hp = p.hb + (size_t)m * 1024 + nw + j * 32 + 8 * gq + 4 * hh;
          uint2 old = *(const uint2*)hp;
          float h0 = bflo(old.x) + g.scale * acc[i][j][4 * gq + 0];
          float h1 = bfhi(old.x) + g.scale * acc[i][j][4 * gq + 1];
          float h2 = bflo(old.y) + g.scale * acc[i][j][4 * gq + 2];
          float h3 = bfhi(old.y) + g.scale * acc[i][j][4 * gq + 3];
          unsigned p0 = pack2(h0, h1), p1 = pack2(h2, h3);
          *(uint2*)hp = make_uint2(p0, p1);
          float r0 = bflo(p0), r1 = bfhi(p0), r2 = bflo(p1), r3 = bfhi(p1);
          ss += r0 * r0 + r1 * r1 + r2 * r2 + r3 * r3;
        }
      ss += __shfl_xor(ss, 32);
      if (hh == 0) p.ssq[(size_t)(nw >> 6) * TP + m] = ss;
    } else if (EPI == EPI_INPROJ) {
      const float rs = rsl[m - m0];
      int s, pos, L; row2seq(m < T ? m : 0, s, pos, L);
      float ss = 0.f;
#pragma unroll
      for (int j = 0; j < 2; ++j) {
        const int nb = nw + j * 32;
        if (nb == 384) {
          u16* kr = (u16*)p.out + (size_t)TP * 1024 + (size_t)TP * 768 + (size_t)m * 32;
#pragma unroll
          for (int gq = 0; gq < 2; ++gq) {
            float o1[4], o2[4];
#pragma unroll
            for (int r = 0; r < 4; ++r) {
              int ii = 8 * gq + 4 * hh + r;
              float c = p.ropec[pos * 16 + ii], sn = p.ropes[pos * 16 + ii];
              float x1 = acc[i][j][4 * gq + r] * rs, x2 = acc[i][j][4 * (gq + 2) + r] * rs;
              o1[r] = x1 * c - x2 * sn; o2[r] = x2 * c + x1 * sn;
            }
            store4(kr + 8 * gq + 4 * hh, o1[0], o1[1], o1[2], o1[3]);
            store4(kr + 16 + 8 * gq + 4 * hh, o2[0], o2[1], o2[2], o2[3]);
          }
        } else {
#pragma unroll
          for (int gq = 0; gq < 4; ++gq) {
            int n = nb + 8 * gq + 4 * hh;
            unsigned p0 = pack2(acc[i][j][4 * gq] * rs, acc[i][j][4 * gq + 1] * rs);
            unsigned p1 = pack2(acc[i][j][4 * gq + 2] * rs, acc[i][j][4 * gq + 3] * rs);
            if (n < 512) {
              *(uint2*)((u16*)p.out + (size_t)m * 512 + n) = make_uint2(p0, p1);
              float r0 = bflo(p0), r1 = bfhi(p0), r2 = bflo(p1), r3 = bfhi(p1);
              ss += r0 * r0 + r1 * r1 + r2 * r2 + r3 * r3;
            } else if (n - 512 < 1952) {
              *(uint2*)(p.regB + (size_t)m * 1952 + (n - 512)) = make_uint2(p0, p1);
              if (m < T && ((pos & 63) == 0 || (pos & 63) == 63)) {
                const int ch = (s < 2 ? s * 129 : 258 + (s - 2) * 33) + (pos >> 6);
                *(uint2*)(halo_ptr(p) + ((size_t)ch * 2 + ((pos & 63) ? 1 : 0)) * 1952 + (n - 512)) = make_uint2(p0, p1);
              }
            }
          }
        }
      }
      if (nw < 384) {
        ss += __shfl_xor(ss, 32);
        if (hh == 0) p.ssqq[(size_t)(nw >> 6) * TP + m] = ss;
      }
    } else if (EPI == EPI_Q) {
      float sq = p.ssqq[m] + p.ssqq[(size_t)TP + m] + p.ssqq[(size_t)2 * TP + m] + p.ssqq[(size_t)3 * TP + m];
      const float rs = rsqrtf(sq * (1.f / 256.f) + RMS_EPS) * QSCALE;
      int s, pos, L; row2seq(m < T ? m : 0, s, pos, L);
      u16* qrow = (u16*)p.out + (size_t)TP * 1024 + (size_t)m * 768;
#pragma unroll
      for (int j = 0; j < 2; ++j) {
        const int nb = nw + j * 32;
        if (((nb >> 5) % 3) == 2) {
#pragma unroll
          for (int gq = 0; gq < 2; ++gq) {
            float o1[4], o2[4];
#pragma unroll
            for (int r = 0; r < 4; ++r) {
              int ii = 8 * gq + 4 * hh + r;
              float c = p.ropec[pos * 16 + ii], sn = p.ropes[pos * 16 + ii];
              float x1 = acc[i][j][4 * gq + r] * rs, x2 = acc[i][j][4 * (gq + 2) + r] * rs;
              o1[r] = x1 * c - x2 * sn; o2[r] = x2 * c + x1 * sn;
            }
            store4(qrow + nb + 8 * gq + 4 * hh, o1[0], o1[1], o1[2], o1[3]);
            store4(qrow + nb + 16 + 8 * gq + 4 * hh, o2[0], o2[1], o2[2], o2[3]);
          }
        } else {
#pragma unroll
          for (int gq = 0; gq < 4; ++gq)
            store4(qrow + nb + 8 * gq + 4 * hh, acc[i][j][4 * gq] * rs, acc[i][j][4 * gq + 1] * rs, acc[i][j][4 * gq + 2] * rs, acc[i][j][4 * gq + 3] * rs);
        }
      }
    } else if (EPI == EPI_KV) {
      if (m < T) {
        float sq = p.ssqq[(size_t)4 * TP + m] + p.ssqq[(size_t)5 * TP + m];
        const float rs = rsqrtf(sq * (1.f / 128.f) + RMS_EPS);
        int s, pos, L; row2seq(m, s, pos, L);
        const int head = nw >> 7;
        const int ppos = (pos & ~15) | (pos & 3) | (((pos >> 3) & 1) << 2) | (((pos >> 2) & 1) << 3);
#pragma unroll
        for (int j = 0; j < 2; ++j) {
          const int jj = (nw & 127) + j * 32;
#pragma unroll
          for (int gq = 0; gq < 4; ++gq) {
            int c = jj + 8 * gq + 4 * hh;
            if (jj < 64) {
              store4(p.kn + (size_t)m * 512 + head * 64 + c, acc[i][j][4 * gq] * rs, acc[i][j][4 * gq + 1] * rs, acc[i][j][4 * gq + 2] * rs, acc[i][j][4 * gq + 3] * rs);
            } else {
#pragma unroll
              for (int r = 0; r < 4; ++r) {
                int dv = c - 64 + r;
                p.vt[(size_t)seq_start(s) * 512 + (size_t)(head * 64 + dv) * L + ppos] = f2bf(acc[i][j][4 * gq + r] * rs);
              }
            }
          }
        }
      }
    } else if (EPI == EPI_POST) {
      if (m < T) {
        int s, pos, L; row2seq(m, s, pos, L);
        const int hd = nw >> 6;
        u16* yb = (u16*)p.out + (size_t)m * 1024;
        float y[2][16];
        float sum = 0.f;
#pragma unroll
        for (int j = 0; j < 2; ++j)
#pragma unroll
          for (int gq = 0; gq < 4; ++gq) {
            int n = nw + j * 32 + 8 * gq + 4 * hh;
            uint2 a = *(const uint2*)(yb + n), b = *(const uint2*)(yb + 512 + n);
            y[j][4 * gq + 0] = bflo(a.x) + bflo(b.x); y[j][4 * gq + 1] = bfhi(a.x) + bfhi(b.x);
            y[j][4 * gq + 2] = bflo(a.y) + bflo(b.y); y[j][4 * gq + 3] = bfhi(a.y) + bfhi(b.y);
            sum += y[j][4 * gq] + y[j][4 * gq + 1] + y[j][4 * gq + 2] + y[j][4 * gq + 3];
          }
        sum += __shfl_xor(sum, 32);
        const float mu = sum * (1.f / 64.f);
        float vs = 0.f;
#pragma unroll
        for (int j = 0; j < 2; ++j)
#pragma unroll
          for (int r = 0; r < 16; ++r) { float dlt = y[j][r] - mu; vs += dlt * dlt; }
        vs += __shfl_xor(vs, 32);
        const float rstd = rsqrtf(vs * (1.f / 64.f) + LNX_EPS);
        const float bsum = p.bsc[(size_t)m * 8 + hd] + p.bsc[((size_t)TP + m) * 8 + hd];
        const u16* vb = p.regB + (size_t)m * 1952 + 1024;
#pragma unroll
        for (int j = 0; j < 2; ++j)
#pragma unroll
          for (int gq = 0; gq < 4; ++gq) {
            int n = nw + j * 32 + 8 * gq + 4 * hh;
            uint2 c = *(const uint2*)(vb + n);
            float cv[4] = {bflo(c.x), bfhi(c.x), bflo(c.y), bfhi(c.y)};
            float o[4];
#pragma unroll
            for (int r = 0; r < 4; ++r) {
              float vsh = cv[r];
              float yn = (y[j][4 * gq + r] - mu) * rstd * p.lnx_w[g.layer * 512 + n + r] + p.lnx_b[g.layer * 512 + n + r];
              o[r] = (yn + bsum * vsh) * acc[i][j][4 * gq + r];
            }
            store4(yb + n, o[0], o[1], o[2], o[3]);
          }
      }
    }
  }
}

template <int MODE, int EPI, int BN = 128>
DI void gemm_phase_item(CP p, const GArgs& g, int item, int NT, char* smem) {
  const int grp = item / (8 * NT);
  const int gsz = min(8, NMT - grp * 8);
  const int idx = item - grp * 8 * NT;
  gemm_tile<MODE, EPI, BN>(p, g, grp * 8 + idx % gsz, idx / gsz, smem);
}

template <int MODE, int EPI, int BN>
DI void gemm_phase(CP p, const GArgs& g, int NT, char* smem) {
  const int x = blockIdx.x & 7, j = blockIdx.x >> 3, nj = gridDim.x >> 3;
  const int total = 16 * NT;
  const bool can_chain = BN == 256 && (((g.K >> 6) & 1) == 0);
  bool first = true;
  for (int e = j; e < total; e += nj) {
    const int grp = e / (8 * NT);
    const int rem = e - grp * 8 * NT;
    const int e2 = e + nj;
    const bool has_next = can_chain && e2 < total;
    const int grp2 = e2 / (8 * NT), rem2 = e2 - grp2 * 8 * NT;
    const int chain = can_chain ? ((first ? 0 : 1) | (has_next ? 2 : 0)) : 0;
    gemm_tile<MODE, EPI, BN>(p, g, x + 8 * (grp * 8 + (rem & 7)), rem >> 3, smem, chain, x + 8 * (grp2 * 8 + (rem2 & 7)), rem2 >> 3);
    first = false;
  }
  const int ntail = NT * (BN / 64);
  for (int e = (int)gridDim.x - 1 - (int)blockIdx.x; e < ntail; e += gridDim.x) gemm_tile<MODE, EPI, 64>(p, g, NMT - 1, e, smem);
}

DI void attn_item(CP p, int s, int hd, int qb, char* smem, bool dostore = true) {
  u16* Ks = (u16*)smem;
  u16* Vs = Ks + 2 * 64 * 104;
  const int tid = tidx(), lane = tid & 63, wv = tid >> 6, l32 = lane & 31, hh = lane >> 5;
  const int L = seq_len(s), r0 = seq_start(s);
  const u16* Qb = (const u16*)p.out + (size_t)TP * 1024;
  const u16* KR = Qb + (size_t)TP * 768;
  const int qpos = qb * 256 + wv * 32 + l32;
  const bool wvalid = (qb * 256 + wv * 32) < L;
  const int qrow = r0 + min(qpos, L - 1);
  bf16x8 qf[6];
#pragma unroll
  for (int ks = 0; ks < 6; ++ks) qf[ks] = *(const bf16x8*)(Qb + (size_t)qrow * 768 + hd * 96 + ks * 16 + hh * 8);
  f32x16 o[2];
#pragma unroll
  for (int u = 0; u < 2; ++u)
#pragma unroll
    for (int r = 0; r < 16; ++r) o[u][r] = 0.f;
  float mrun = -1e30f, lrun = 0.f;
  const int nt = (L + 63) >> 6;
  const u16* vtb = p.vt + (size_t)r0 * 512 + (size_t)hd * 64 * L;
  uint4 rg[3];
  auto ldc = [&](int kt, int c) -> uint4 {
    uint4 z = make_uint4(0, 0, 0, 0);
    if (c < 768) {
      int key = c / 12, cc = c - key * 12, kpos = kt * 64 + key;
      if (kpos >= L) return z;
      const u16* src = cc < 8 ? p.kn + (size_t)(r0 + kpos) * 512 + hd * 64 + cc * 8 : KR + (size_t)(r0 + kpos) * 32 + (cc - 8) * 8;
      return *(const uint4*)src;
    } else {
      int c2 = c - 768, dv = c2 >> 3, kc = c2 & 7, kp0 = kt * 64 + kc * 8;
      if (kp0 >= L) return z;
      return *(const uint4*)(vtb + (size_t)dv * L + kp0);
    }
  };
  auto stc = [&](int buf, int c, uint4 v) {
    if (c < 768) { int key = c / 12, cc = c - key * 12; *(uint4*)(Ks + (buf * 64 + key) * 104 + cc * 8) = v; }
    else { int c2 = c - 768, dv = c2 >> 3, kc = c2 & 7; *(uint4*)(Vs + (buf * 64 + dv) * 72 + kc * 8) = v; }
  };
  rg[0] = ldc(0, tid); rg[1] = ldc(0, tid + 512); if (tid < 256) rg[2] = ldc(0, tid + 1024);
  stc(0, tid, rg[0]); stc(0, tid + 512, rg[1]); if (tid < 256) stc(0, tid + 1024, rg[2]);
  __syncthreads();
  for (int kt = 0; kt < nt; ++kt) {
    const int buf = kt & 1;
    if (kt + 1 < nt) { rg[0] = ldc(kt + 1, tid); rg[1] = ldc(kt + 1, tid + 512); if (tid < 256) rg[2] = ldc(kt + 1, tid + 1024); }
    if (wvalid) {
      f32x16 st[2];
#pragma unroll
      for (int t = 0; t < 2; ++t) {
#pragma unroll
        for (int r = 0; r < 16; ++r) st[t][r] = 0.f;
        const u16* kb = Ks + (buf * 64 + t * 32 + l32) * 104 + hh * 8;
#pragma unroll
        for (int ks = 0; ks < 6; ++ks) st[t] = MFMA(*(const bf16x8*)(kb + ks * 16), qf[ks], st[t]);
      }
      if (kt == nt - 1) {
#pragma unroll
        for (int t = 0; t < 2; ++t)
#pragma unroll
          for (int r = 0; r < 16; ++r) if (kt * 64 + t * 32 + crow(r, hh) >= L) st[t][r] = -1e30f;
      }
      float mx = -1e30f;
#pragma unroll
      for (int t = 0; t < 2; ++t)
#pragma unroll
        for (int r = 0; r < 16; ++r) mx = fmaxf(mx, st[t][r]);
      mx = fmaxf(mx, __shfl_xor(mx, 32));
      const float mnew = fmaxf(mrun, mx);
      const float alpha = __builtin_amdgcn_exp2f(mrun - mnew);
      float ls = 0.f;
#pragma unroll
      for (int t = 0; t < 2; ++t)
#pragma unroll
        for (int r = 0; r < 16; ++r) { float pv = __builtin_amdgcn_exp2f(st[t][r] - mnew); st[t][r] = pv; ls += pv; }
      lrun = lrun * alpha + ls; mrun = mnew;
#pragma unroll
      for (int u = 0; u < 2; ++u)
#pragma unroll
        for (int r = 0; r < 16; ++r) o[u][r] *= alpha;
#pragma unroll
      for (int t = 0; t < 2; ++t)
#pragma unroll
        for (int s2 = 0; s2 < 2; ++s2) {
          uint4 pk;
          pk.x = pack2(st[t][8 * s2 + 0], st[t][8 * s2 + 1]); pk.y = pack2(st[t][8 * s2 + 2], st[t][8 * s2 + 3]);
          pk.z = pack2(st[t][8 * s2 + 4], st[t][8 * s2 + 5]); pk.w = pack2(st[t][8 * s2 + 6], st[t][8 * s2 + 7]);
          bf16x8 pf = __builtin_bit_cast(bf16x8, pk);
#pragma unroll
          for (int u = 0; u < 2; ++u) {
            bf16x8 vf = *(const bf16x8*)(Vs + (buf * 64 + u * 32 + l32) * 72 + t * 32 + s2 * 16 + hh * 8);
            o[u] = MFMA(vf, pf, o[u]);
          }
        }
    }
    if (kt + 1 < nt) { stc(buf ^ 1, tid, rg[0]); stc(buf ^ 1, tid + 512, rg[1]); if (tid < 256) stc(buf ^ 1, tid + 1024, rg[2]); }
    __syncthreads();
  }
  if (wvalid) {
    float lt = lrun + __shfl_xor(lrun, 32);
    const float inv = 1.f / lt;
    if (qpos < L && dostore) {
      u16* dst = (u16*)p.out + (size_t)TP * 1024 + (size_t)(r0 + qpos) * 768 + hd * 96;
#pragma unroll
      for (int u = 0; u < 2; ++u)
#pragma unroll
        for (int gq = 0; gq < 4; ++gq)
          store4(dst + u * 32 + 8 * gq + 4 * hh, o[u][4 * gq] * inv, o[u][4 * gq + 1] * inv, o[u][4 * gq + 2] * inv, o[u][4 * gq + 3] * inv);
    }
  }
}

DI void scan_block(CP p, int layer, int s, int d, int hd, char* smem) {
  float* OP = (float*)smem;
  float* WA = OP + 32 * 392;
  float* YB = WA + 2 * 32 * 64;
  u16* XL = (u16*)(YB + 32 * 64);
  float* MU = (float*)(XL + 2 * 32 * 72);
  float* CS = MU + 5 * 2 * 64;
  const int tid = tidx(), lane = tid & 63, wv = tid >> 6, l32 = lane & 31, hh = lane >> 5;
  const int L = seq_len(s), r0 = seq_start(s);
  const int sj = tid >> 4, q = tid & 15;
  const int rloc = lane >> 3, cg8 = lane & 7, row = wv * 8 + rloc;
  const int aoff[5] = {hd * 64, 512 + hd * 64, 1024 + hd * 64, 1536 + d * 64, 1664 + d * 64};
  __syncthreads();
  for (int i = tid; i < 640; i += NTHR) {
    int a = i >> 7, w = (i >> 6) & 1, c = i & 63;
    int off = a == 0 ? aoff[0] : a == 1 ? aoff[1] : a == 2 ? aoff[2] : a == 3 ? aoff[3] : aoff[4];
    MU[i] = p.shift_mu[(size_t)(layer * 2 + w) * 1952 + off + c];
  }
  if (tid < 64) {
    CS[tid] = p.key_k_k[layer * 512 + hd * 64 + tid];
    CS[64 + tid] = p.key_k_a[layer * 512 + hd * 64 + tid];
    CS[128 + tid] = p.bonus_r_k[layer * 512 + hd * 64 + tid];
  }
  const int mat = (wv >> 1) & 1, ntile = wv & 1;
  bf16x8 wfr[4];
  {
    const u16* wb = p.wM + (mat ? OFF_A : OFF_DEC) + (size_t)(d * 512 + hd * 64 + ntile * 32 + l32) * 64 + hh * 8;
#pragma unroll
    for (int ks = 0; ks < 4; ++ks) wfr[ks] = *(const bf16x8*)(wb + ks * 16);
  }
  const float bias = mat ? p.iclr_a0[(size_t)(layer * 2 + d) * 512 + hd * 64 + ntile * 32 + l32]
                         : p.decay_w0[(size_t)(layer * 2 + d) * 512 + hd * 64 + ntile * 32 + l32];
  __syncthreads();
  float S[8];
#pragma unroll
  for (int i = 0; i < 8; ++i) S[i] = 0.f;
  const int nch = (L + 31) >> 5;
  uint2 raw[15];
  float r4[4], k4[4], kk4[4], v4[4];

  auto prefetch = [&](int c) {
    const int sidx = c * 32 + sj;
    const bool valid = sidx < L;
    const int tok = d == 0 ? sidx : L - 1 - sidx;
    const u16* base = p.regB + (size_t)(r0 + tok) * 1952 + 4 * q;
#pragma unroll
    for (int a = 0; a < 5; ++a) {
      const int off = a == 0 ? aoff[0] : a == 1 ? aoff[1] : a == 2 ? aoff[2] : a == 3 ? aoff[3] : aoff[4];
      raw[a * 3 + 0] = (valid && tok > 0) ? *(const uint2*)(base - 1952 + off) : make_uint2(0, 0);
      raw[a * 3 + 1] = valid ? *(const uint2*)(base + off) : make_uint2(0, 0);
      raw[a * 3 + 2] = (valid && tok + 1 < L) ? *(const uint2*)(base + 1952 + off) : make_uint2(0, 0);
    }
  };
  auto shift4 = [&](int a, float* x) {
    const float4 m0 = *(const float4*)(MU + (a * 2 + 0) * 64 + 4 * q);
    const float4 m1 = *(const float4*)(MU + (a * 2 + 1) * 64 + 4 * q);
    const uint2 pm = raw[a * 3], c = raw[a * 3 + 1], pp = raw[a * 3 + 2];
    float c0 = bflo(c.x), c1 = bfhi(c.x), c2 = bflo(c.y), c3 = bfhi(c.y);
    x[0] = c0 + m0.x * (bflo(pm.x) - c0) + m1.x * (bflo(pp.x) - c0);
    x[1] = c1 + m0.y * (bfhi(pm.x) - c1) + m1.y * (bfhi(pp.x) - c1);
    x[2] = c2 + m0.z * (bflo(pm.y) - c2) + m1.z * (bflo(pp.y) - c2);
    x[3] = c3 + m0.w * (bfhi(pm.y) - c3) + m1.w * (bfhi(pp.y) - c3);
  };
  auto stage = [&](int c) {
    shift4(0, r4); shift4(1, k4); shift4(2, v4);
    float xw[4], xa[4];
    shift4(3, xw); shift4(4, xa);
#pragma unroll
    for (int e = 0; e < 4; ++e) xw[e] = 1.f - 2.f / (__expf(2.f * xw[e]) + 1.f);
    store4(XL + sj * 72 + 4 * q, xw[0], xw[1], xw[2], xw[3]);
    store4(XL + 32 * 72 + sj * 72 + 4 * q, xa[0], xa[1], xa[2], xa[3]);
    {
      const float4 kkw = *(const float4*)(CS + 4 * q);
      float x0 = k4[0] * kkw.x, x1 = k4[1] * kkw.y, x2 = k4[2] * kkw.z, x3 = k4[3] * kkw.w;
      float ss = sum16(x0 * x0 + x1 * x1 + x2 * x2 + x3 * x3);
      float inv = 1.f / fmaxf(sqrtf(ss), 1e-12f);
      kk4[0] = x0 * inv; kk4[1] = x1 * inv; kk4[2] = x2 * inv; kk4[3] = x3 * inv;
    }
    __syncthreads();
    if (wv < 4) {
      f32x16 acc;
#pragma unroll
      for (int r = 0; r < 16; ++r) acc[r] = 0.f;
      const u16* xb = XL + mat * 32 * 72 + l32 * 72 + hh * 8;
#pragma unroll
      for (int ks = 0; ks < 4; ++ks) acc = MFMA(*(const bf16x8*)(xb + ks * 16), wfr[ks], acc);
#pragma unroll
      for (int r = 0; r < 16; ++r) {
        float x = acc[r] + bias;
        float sg = sigmoidf_(x);
        float val = mat ? sg : __expf(-0.6065306597126334f * sg);
        WA[(mat * 32 + crow(r, hh)) * 64 + ntile * 32 + l32] = val;
      }
    }
    __syncthreads();
    {
      const float4 w4 = *(const float4*)(WA + sj * 64 + 4 * q);
      const float4 a4 = *(const float4*)(WA + (32 + sj) * 64 + 4 * q);
      const float4 ka = *(const float4*)(CS + 64 + 4 * q);
      const float4 brk = *(const float4*)(CS + 128 + 4 * q);
      const float wv4[4] = {w4.x, w4.y, w4.z, w4.w}, av4[4] = {a4.x, a4.y, a4.z, a4.w};
      const float kav[4] = {ka.x, ka.y, ka.z, ka.w}, bkv[4] = {brk.x, brk.y, brk.z, brk.w};
      float aa[4], wr[4], bb[4], kd[4];
      float br = 0.f, kr = 0.f, bs = 0.f;
#pragma unroll
      for (int e = 0; e < 4; ++e) {
        aa[e] = -kk4[e]; wr[e] = wv4[e] * r4[e]; bb[e] = kk4[e] * av4[e];
        kd[e] = k4[e] * (1.f + (av4[e] - 1.f) * kav[e]);
        br += bb[e] * r4[e]; kr += kd[e] * r4[e]; bs += r4[e] * kd[e] * bkv[e];
      }
      br = sum16(br); kr = sum16(kr); bs = sum16(bs);
      float* o = OP + sj * 392 + 4 * q;
      *(float4*)(o) = make_float4(aa[0], aa[1], aa[2], aa[3]);
      *(float4*)(o + 64) = make_float4(wr[0], wr[1], wr[2], wr[3]);
      *(float4*)(o + 128) = w4;
      *(float4*)(o + 192) = make_float4(bb[0], bb[1], bb[2], bb[3]);
      *(float4*)(o + 256) = make_float4(kd[0], kd[1], kd[2], kd[3]);
      *(float4*)(o + 320) = make_float4(v4[0], v4[1], v4[2], v4[3]);
      if (q == 0) {
        OP[sj * 392 + 384] = br; OP[sj * 392 + 385] = kr;
        const int sidx = c * 32 + sj;
        if (sidx < L) { const int tok = d == 0 ? sidx : L - 1 - sidx; p.bsc[((size_t)d * TP + r0 + tok) * 8 + hd] = bs; }
      }
    }
    __syncthreads();
  };

  prefetch(0);
  stage(0);
  for (int c = 0; c < nch; ++c) {
    if (c + 1 < nch) prefetch(c + 1);
    const int nst = min(32, L - c * 32);
    for (int jj = 0; jj < nst; ++jj) {
      const float* o = OP + jj * 392;
      const float4 a0 = *(const float4*)(o + cg8 * 8), a1 = *(const float4*)(o + cg8 * 8 + 4);
      const float4 y0 = *(const float4*)(o + 64 + cg8 * 8), y1 = *(const float4*)(o + 64 + cg8 * 8 + 4);
      const float4 w0 = *(const float4*)(o + 128 + cg8 * 8), w1 = *(const float4*)(o + 128 + cg8 * 8 + 4);
      const float4 b0 = *(const float4*)(o + 192 + cg8 * 8), b1 = *(const float4*)(o + 192 + cg8 * 8 + 4);
      const float4 k0 = *(const float4*)(o + 256 + cg8 * 8), k1 = *(const float4*)(o + 256 + cg8 * 8 + 4);
      const float vv = o[320 + row];
      const float2 sc = *(const float2*)(o + 384);
      float da = S[0] * a0.x + S[1] * a0.y + S[2] * a0.z + S[3] * a0.w + S[4] * a1.x + S[5] * a1.y + S[6] * a1.z + S[7] * a1.w;
      float dy = S[0] * y0.x + S[1] * y0.y + S[2] * y0.z + S[3] * y0.w + S[4] * y1.x + S[5] * y1.y + S[6] * y1.z + S[7] * y1.w;
      da = dpp_sum8(da); dy = dpp_sum8(dy);
      const float yv = dy + da * sc.x + vv * sc.y;
      S[0] = S[0] * w0.x + da * b0.x + vv * k0.x; S[1] = S[1] * w0.y + da * b0.y + vv * k0.y;
      S[2] = S[2] * w0.z + da * b0.z + vv * k0.z; S[3] = S[3] * w0.w + da * b0.w + vv * k0.w;
      S[4] = S[4] * w1.x + da * b1.x + vv * k1.x; S[5] = S[5] * w1.y + da * b1.y + vv * k1.y;
      S[6] = S[6] * w1.z + da * b1.z + vv * k1.z; S[7] = S[7] * w1.w + da * b1.w + vv * k1.w;
      if (cg8 == 0) YB[jj * 64 + row] = yv;
    }
    __syncthreads();
    {
      const int sidx = c * 32 + sj;
      if (sidx < L) {
        const int tok = d == 0 ? sidx : L - 1 - sidx;
        const float4 yv = *(const float4*)(YB + sj * 64 + 4 * q);
        store4((u16*)p.out + (size_t)(r0 + tok) * 1024 + d * 512 + hd * 64 + 4 * q, yv.x, yv.y, yv.z, yv.w);
      }
    }
    if (c + 1 < nch) stage(c + 1);
  }
  __syncthreads();
}

typedef float f2 __attribute__((ext_vector_type(2)));
DI f2 mk2(float a, float b) { f2 r; r.x = a; r.y = b; return r; }
#define LDS_FENCE() asm volatile("s_waitcnt lgkmcnt(0)" ::: "memory")

template <int CPL>
DI void scan_block2(CP p, int layer, int s, int d, int hd, int rowhalf, char* smem) {
  float* OP = (float*)smem;
  float* YB = OP + 2 * 32 * 392;
  u16* XL = (u16*)(YB + 2 * 32 * 64);
  float* MU = (float*)(XL + 2 * 32 * 72);
  float* CS = MU + 640;
  u16* WL = (u16*)(CS + 192);
  const int tid = tidx(), lane = tid & 63, wv = tid >> 6, l32 = lane & 31, hh = lane >> 5;
  const int L = seq_len(s), r0 = seq_start(s);
  const int aoff0 = hd * 64, aoff1 = 512 + hd * 64, aoff2 = 1024 + hd * 64, aoff3 = 1536 + d * 64, aoff4 = 1664 + d * 64;
  __syncthreads();
  for (int i = tid; i < 640; i += NTHR) {
    int a = i >> 7, w = (i >> 6) & 1, c = i & 63;
    int off = a == 0 ? aoff0 : a == 1 ? aoff1 : a == 2 ? aoff2 : a == 3 ? aoff3 : aoff4;
    MU[i] = p.shift_mu[(size_t)(layer * 2 + w) * 1952 + off + c];
  }
#pragma unroll
  for (int i = 0; i < 2; ++i) {
    const int idx = tid + i * NTHR, mat = idx >> 9, col = (idx >> 3) & 63, kc = idx & 7;
    *(uint4*)(WL + (mat * 64 + col) * 72 + kc * 8) = *(const uint4*)(p.wM + (mat ? OFF_A : OFF_DEC) + (size_t)(d * 512 + hd * 64 + col) * 64 + kc * 8);
  }
  if (tid < 64) {
    CS[tid] = p.key_k_k[layer * 512 + hd * 64 + tid];
    CS[64 + tid] = p.key_k_a[layer * 512 + hd * 64 + tid];
    CS[128 + tid] = p.bonus_r_k[layer * 512 + hd * 64 + tid];
  }
  __syncthreads();
  const int nch = (L + 31) >> 5;

  if (wv >= 4) {
    const int sw = wv - 4;
    const int q = lane & 15;
    float bias[2][2];
#pragma unroll
    for (int mat = 0; mat < 2; ++mat)
#pragma unroll
      for (int nt2 = 0; nt2 < 2; ++nt2)
        bias[mat][nt2] = mat ? p.iclr_a0[(size_t)(layer * 2 + d) * 512 + hd * 64 + nt2 * 32 + l32]
                             : p.decay_w0[(size_t)(layer * 2 + d) * 512 + hd * 64 + nt2 * 32 + l32];
    uint2 raw[2][5];
    auto load_raw = [&](int c) {
#pragma unroll
      for (int u = 0; u < 2; ++u) {
        const int sj = 8 * sw + 4 * u + (lane >> 4);
        const int sidc = min(c * 32 + sj, L - 1);
        const int tok = d == 0 ? sidc : L - 1 - sidc;
        const u16* base = p.regB + (size_t)(r0 + tok) * 1952 + 4 * q;
        raw[u][0] = *(const uint2*)(base + aoff0); raw[u][1] = *(const uint2*)(base + aoff1); raw[u][2] = *(const uint2*)(base + aoff2);
        raw[u][3] = *(const uint2*)(base + aoff3); raw[u][4] = *(const uint2*)(base + aoff4);
      }
    };
    auto stage = [&](int c) {
      float r4[2][4], k4[2][4], kk4[2][4], v4[2][4];
#pragma unroll
      for (int u = 0; u < 2; ++u) {
        const int sj = 8 * sw + 4 * u + (lane >> 4);
        r4[u][0] = bflo(raw[u][0].x); r4[u][1] = bfhi(raw[u][0].x); r4[u][2] = bflo(raw[u][0].y); r4[u][3] = bfhi(raw[u][0].y);
        k4[u][0] = bflo(raw[u][1].x); k4[u][1] = bfhi(raw[u][1].x); k4[u][2] = bflo(raw[u][1].y); k4[u][3] = bfhi(raw[u][1].y);
        v4[u][0] = bflo(raw[u][2].x); v4[u][1] = bfhi(raw[u][2].x); v4[u][2] = bflo(raw[u][2].y); v4[u][3] = bfhi(raw[u][2].y);
        *(uint2*)(XL + sj * 72 + 4 * q) = raw[u][3];
        *(uint2*)(XL + 32 * 72 + sj * 72 + 4 * q) = raw[u][4];
        const float4 kkw = *(const float4*)(CS + 4 * q);
        float x0 = k4[u][0] * kkw.x, x1 = k4[u][1] * kkw.y, x2 = k4[u][2] * kkw.z, x3 = k4[u][3] * kkw.w;
        float ss = sum16(x0 * x0 + x1 * x1 + x2 * x2 + x3 * x3);
        float inv = __builtin_amdgcn_rsqf(fmaxf(ss, 1e-24f));
        kk4[u][0] = x0 * inv; kk4[u][1] = x1 * inv; kk4[u][2] = x2 * inv; kk4[u][3] = x3 * inv;
      }
      LDS_FENCE();
      float* OPn = OP + (c & 1) * 32 * 392;
#pragma unroll
      for (int mat = 0; mat < 2; ++mat)
#pragma unroll
        for (int nt2 = 0; nt2 < 2; ++nt2) {
          f32x16 acc;
#pragma unroll
          for (int r = 0; r < 16; ++r) acc[r] = 0.f;
          const u16* xb = XL + mat * 32 * 72 + (8 * sw + (l32 & 7)) * 72 + hh * 8;
#pragma unroll
          for (int ks = 0; ks < 4; ++ks) acc = MFMA(*(const bf16x8*)(xb + ks * 16), *(const bf16x8*)(WL + (mat * 64 + nt2 * 32 + l32) * 72 + ks * 16 + hh * 8), acc);
#pragma unroll
          for (int r = 0; r < 4; ++r) {
            float x = acc[r] + bias[mat][nt2];
            float sg = sigmoidf_(x);
            float val = mat ? sg : __expf(-0.6065306597126334f * sg);
            OPn[(8 * sw + 4 * hh + r) * 392 + (mat ? 0 : 128) + nt2 * 32 + l32] = val;
          }
        }
      LDS_FENCE();
#pragma unroll
      for (int u = 0; u < 2; ++u) {
        const int sj = 8 * sw + 4 * u + (lane >> 4);
        const float4 w4 = *(const float4*)(OPn + sj * 392 + 128 + 4 * q);
        const float4 a4 = *(const float4*)(OPn + sj * 392 + 4 * q);
        const float4 ka = *(const float4*)(CS + 64 + 4 * q);
        const float4 brk = *(const float4*)(CS + 128 + 4 * q);
        const float wv4[4] = {w4.x, w4.y, w4.z, w4.w}, av4[4] = {a4.x, a4.y, a4.z, a4.w};
        const float kav[4] = {ka.x, ka.y, ka.z, ka.w}, bkv[4] = {brk.x, brk.y, brk.z, brk.w};
        float bb[4], kd[4];
        float bs = 0.f;
#pragma unroll
        for (int e = 0; e < 4; ++e) {
          bb[e] = -kk4[u][e] * av4[e];
          kd[e] = k4[u][e] * (1.f + (av4[e] - 1.f) * kav[e]);
          bs += r4[u][e] * kd[e] * bkv[e];
        }
        bs = sum16(bs);
        float* o = OPn + sj * 392 + 4 * q;
        *(float4*)(o) = make_float4(kk4[u][0], kk4[u][1], kk4[u][2], kk4[u][3]);
        *(float4*)(o + 64) = make_float4(r4[u][0], r4[u][1], r4[u][2], r4[u][3]);
        *(float4*)(o + 128) = w4;
        *(float4*)(o + 192) = make_float4(bb[0], bb[1], bb[2], bb[3]);
        *(float4*)(o + 256) = make_float4(kd[0], kd[1], kd[2], kd[3]);
        *(float4*)(o + 320) = make_float4(v4[u][0], v4[u][1], v4[u][2], v4[u][3]);
        if (q == 0) {
          const int sidx = c * 32 + sj;
          if (sidx < L && rowhalf == 0) { const int tok = d == 0 ? sidx : L - 1 - sidx; p.bsc[((size_t)d * TP + r0 + tok) * 8 + hd] = bs; }
        }
      }
    };
    auto writeout = [&](int c) {
      const float* yb = YB + (c & 1) * 2048;
#pragma unroll
      for (int u = 0; u < 2; ++u) {
        const int sj = 8 * sw + 4 * u + (lane >> 4);
        const int sidx = c * 32 + sj;
        const bool mine = CPL == 16 ? true : ((q >> 3) == rowhalf);
        if (sidx < L && mine) {
          const int tok = d == 0 ? sidx : L - 1 - sidx;
          const float4 yv = *(const float4*)(yb + sj * 64 + 4 * q);
          store4((u16*)p.out + (size_t)(r0 + tok) * 1024 + d * 512 + hd * 64 + 4 * q, yv.x, yv.y, yv.z, yv.w);
        }
      }
    };
    load_raw(0);
    stage(0);
    if (nch > 1) load_raw(1);
    __syncthreads();
    for (int c = 0; c < nch; ++c) {
      if (c + 1 < nch) { stage(c + 1); if (c + 2 < nch) load_raw(c + 2); }
      if (c >= 1) writeout(c - 1);
      __syncthreads();
    }
    writeout(nch - 1);
  } else {
    constexpr int LPRW = 64 / CPL;
    constexpr int NV = CPL / 2;
    const int cg = lane % LPRW;
    const int row = (CPL == 8 ? rowhalf * 32 + wv * 8 : wv * 16) + lane / LPRW;
    f2 S[NV];
#pragma unroll
    for (int i = 0; i < NV; ++i) S[i] = mk2(0.f, 0.f);
    __builtin_amdgcn_s_setprio(3);
    __syncthreads();
    for (int c = 0; c < nch; ++c) {
      const int nst = min(32, L - c * 32);
      const float* ob = OP + (c & 1) * 32 * 392;
      float* yb = YB + (c & 1) * 2048;
      float* ydst = cg == 0 ? yb + row : (float*)(smem + 147712) + lane;
      const int ystride = cg == 0 ? 64 : 0;
      float4 ca[CPL / 4], cy[CPL / 4], cw[CPL / 4], cb[CPL / 4], ck[CPL / 4];
      float cvv;
      {
        const float* o = ob + cg * CPL;
#pragma unroll
        for (int i = 0; i < CPL / 4; ++i) {
          ca[i] = *(const float4*)(o + 4 * i); cy[i] = *(const float4*)(o + 64 + 4 * i); cw[i] = *(const float4*)(o + 128 + 4 * i);
          cb[i] = *(const float4*)(o + 192 + 4 * i); ck[i] = *(const float4*)(o + 256 + 4 * i);
        }
        cvv = ob[320 + row];
      }
#pragma unroll 4
      for (int jj = 0; jj < nst; ++jj) {
        float4 na[CPL / 4], ny[CPL / 4], nw[CPL / 4], nb[CPL / 4], nk[CPL / 4];
        float nvv;
        {
          const int jn = jj + 1;
          const float* o = ob + jn * 392 + cg * CPL;
#pragma unroll
          for (int i = 0; i < CPL / 4; ++i) {
            na[i] = *(const float4*)(o + 4 * i); ny[i] = *(const float4*)(o + 64 + 4 * i); nw[i] = *(const float4*)(o + 128 + 4 * i);
            nb[i] = *(const float4*)(o + 192 + 4 * i); nk[i] = *(const float4*)(o + 256 + 4 * i);
          }
          nvv = ob[jn * 392 + 320 + row];
        }
        f2 A[NV], Y[NV], W[NV], B[NV], K[NV];
#pragma unroll
        for (int i = 0; i < CPL / 4; ++i) {
          A[2 * i] = mk2(ca[i].x, ca[i].y); A[2 * i + 1] = mk2(ca[i].z, ca[i].w);
          Y[2 * i] = mk2(cy[i].x, cy[i].y); Y[2 * i + 1] = mk2(cy[i].z, cy[i].w);
          W[2 * i] = mk2(cw[i].x, cw[i].y); W[2 * i + 1] = mk2(cw[i].z, cw[i].w);
          B[2 * i] = mk2(cb[i].x, cb[i].y); B[2 * i + 1] = mk2(cb[i].z, cb[i].w);
          K[2 * i] = mk2(ck[i].x, ck[i].y); K[2 * i + 1] = mk2(ck[i].z, ck[i].w);
        }
        const float vv = cvv;
        f2 pa0 = S[0] * A[0], pa1 = S[1] * A[1];
#pragma unroll
        for (int i = 2; i < NV; i += 2) { pa0 = S[i] * A[i] + pa0; pa1 = S[i + 1] * A[i + 1] + pa1; }
        pa0 = pa0 + pa1;
        float da = pa0.x + pa0.y;
        const f2 vvv = mk2(vv, vv);
        f2 SW[NV];
#pragma unroll
        for (int i = 0; i < NV; ++i) SW[i] = S[i] * W[i] + vvv * K[i];
        da += __int_as_float(__builtin_amdgcn_update_dpp(0, __float_as_int(da), 0xB1, 0xf, 0xf, false));
        da += __int_as_float(__builtin_amdgcn_update_dpp(0, __float_as_int(da), 0x4E, 0xf, 0xf, false));
        if (CPL == 8) da += __int_as_float(__builtin_amdgcn_update_dpp(0, __float_as_int(da), 0x141, 0xf, 0xf, false));
        const f2 dav = mk2(da, da);
#pragma unroll
        for (int i = 0; i < NV; ++i) S[i] = dav * B[i] + SW[i];
        f2 py0 = S[0] * Y[0], py1 = S[1] * Y[1];
#pragma unroll
        for (int i = 2; i < NV; i += 2) { py0 = S[i] * Y[i] + py0; py1 = S[i + 1] * Y[i + 1] + py1; }
        py0 = py0 + py1;
        float yv = py0.x + py0.y;
        yv += __int_as_float(__builtin_amdgcn_update_dpp(0, __float_as_int(yv), 0xB1, 0xf, 0xf, false));
        yv += __int_as_float(__builtin_amdgcn_update_dpp(0, __float_as_int(yv), 0x4E, 0xf, 0xf, false));
        if (CPL == 8) yv += __int_as_float(__builtin_amdgcn_update_dpp(0, __float_as_int(yv), 0x141, 0xf, 0xf, false));
        ydst[jj * ystride] = yv;
#pragma unroll
        for (int i = 0; i < CPL / 4; ++i) { ca[i] = na[i]; cy[i] = ny[i]; cw[i] = nw[i]; cb[i] = nb[i]; ck[i] = nk[i]; }
        cvv = nvv;
      }
      __syncthreads();
    }
    __builtin_amdgcn_s_setprio(0);
  }
  __syncthreads();
}

DI void shift_item(CP p, int layer, int ch, char* smem) {
  const int tid = tidx();
  int s, c;
  if (ch < 258) { s = ch / 129; c = ch - s * 129; } else { int x = ch - 258; s = 2 + x / 33; c = x - (s - 2) * 33; }
  const int L = seq_len(s), r0 = seq_start(s) + c * 64;
  const int nrows = min(64, L - c * 64);
  const int cgp = tid & 255, rg = tid >> 8;
  const int col = cgp * 8;
  const int rlo = rg * 32, rhi = min(rlo + 32, nrows);
  const bool act = cgp < 244 && rlo < nrows;
  typedef unsigned u32x4 __attribute__((ext_vector_type(4)));
  u32x4 prev = {0u, 0u, 0u, 0u}, cur = prev, lastn = prev;
  float mu0[8], mu1[8];
  u16* base = p.regB + (size_t)r0 * 1952 + col;
  if (act) {
#pragma unroll
    for (int e = 0; e < 8; ++e) { mu0[e] = p.shift_mu[(size_t)(layer * 2) * 1952 + col + e]; mu1[e] = p.shift_mu[(size_t)(layer * 2 + 1) * 1952 + col + e]; }
    if (rlo > 0) prev = *(const u32x4*)(base + (size_t)(rlo - 1) * 1952);
    else if (c > 0) prev = *(const u32x4*)(halo_ptr(p) + ((size_t)(ch - 1) * 2 + 1) * 1952 + col);
    cur = *(const u32x4*)(base + (size_t)rlo * 1952);
    if (rhi < nrows) lastn = *(const u32x4*)(base + (size_t)rhi * 1952);
    else if (c * 64 + nrows < L) lastn = *(const u32x4*)(halo_ptr(p) + ((size_t)(ch + 1) * 2) * 1952 + col);
  }
  __syncthreads();
  if (act) {
    const int kind = col < 1536 ? 0 : col < 1664 ? 1 : col < 1792 ? 0 : 2;
    for (int rb = rlo; rb < rhi; rb += 8) {
      u32x4 rw[9];
      rw[0] = cur;
#pragma unroll
      for (int i = 1; i < 9; ++i) { const int r = rb + i; rw[i] = (r < rhi) ? *(const u32x4*)(base + (size_t)r * 1952) : lastn; }
#pragma unroll
      for (int i = 0; i < 8; ++i) {
        const u32x4 cc = rw[i], nn = rw[i + 1];
        const unsigned pc[4] = {cc.x, cc.y, cc.z, cc.w}, pm[4] = {prev.x, prev.y, prev.z, prev.w}, pn[4] = {nn.x, nn.y, nn.z, nn.w};
        unsigned o[4];
#pragma unroll
        for (int e = 0; e < 4; ++e) {
          float c0 = bflo(pc[e]), c1 = bfhi(pc[e]);
          float x0 = c0 + mu0[2 * e] * (bflo(pm[e]) - c0) + mu1[2 * e] * (bflo(pn[e]) - c0);
          float x1 = c1 + mu0[2 * e + 1] * (bfhi(pm[e]) - c1) + mu1[2 * e + 1] * (bfhi(pn[e]) - c1);
          if (kind == 1) { x0 = 1.f - 2.f * __builtin_amdgcn_rcpf(__expf(2.f * x0) + 1.f); x1 = 1.f - 2.f * __builtin_amdgcn_rcpf(__expf(2.f * x1) + 1.f); }
          else if (kind == 2) { x0 = sigmoidf_(x0); x1 = sigmoidf_(x1); }
          o[e] = pack2(x0, x1);
        }
        { u32x4 ov = {o[0], o[1], o[2], o[3]}; *(u32x4*)(base + (size_t)(rb + i) * 1952) = ov; }
        prev = cc;
      }
      cur = rw[8];
    }
  }
  __syncthreads();
}

DI void init_rows(CP p, int item) {
  const int lane = tidx() & 63, wv = tidx() >> 6;
  const int r = item * 8 + wv;
  if (r >= TP) return;
  u16* dst = p.hb + (size_t)r * 1024 + lane * 16;
  float ss = 0.f;
  if (r < T) {
    int s, pos, L; row2seq(r, s, pos, L);
    const float* src = pos < 16 ? p.meta + pos * 1024
                     : (s < 2 ? p.x_prompt + ((size_t)s * 8192 + pos - 16) * 1024 : p.x_sample + ((size_t)(s - 2) * 2048 + pos - 16) * 1024);
    src += lane * 16;
    unsigned pk[8];
#pragma unroll
    for (int i = 0; i < 4; ++i) {
      float4 v = *(const float4*)(src + 4 * i);
      pk[2 * i] = pack2(v.x, v.y); pk[2 * i + 1] = pack2(v.z, v.w);
      float a = bflo(pk[2 * i]), b = bfhi(pk[2 * i]), c = bflo(pk[2 * i + 1]), dd = bfhi(pk[2 * i + 1]);
      ss += a * a + b * b + c * c + dd * dd;
    }
    *(uint4*)dst = make_uint4(pk[0], pk[1], pk[2], pk[3]);
    *(uint4*)(dst + 8) = make_uint4(pk[4], pk[5], pk[6], pk[7]);
  } else {
    *(uint4*)dst = make_uint4(0, 0, 0, 0);
    *(uint4*)(dst + 8) = make_uint4(0, 0, 0, 0);
  }
#pragma unroll
  for (int o = 32; o > 0; o >>= 1) ss += __shfl_xor(ss, o);
  if (lane < 16) p.ssq[(size_t)lane * TP + r] = lane == 0 ? ss : 0.f;
}
DI void init_rope(CP p, int item) {
  const int idx = item * NTHR + tidx();
  if (idx >= LPR * 16) return;
  const int pos = idx >> 4, i = idx & 15;
  double rev = (double)pos * ROPE_INV[i] * 0.15915494309189535;
  rev -= rint(rev);
  const float fr = (float)rev;
  p.ropec[idx] = __builtin_amdgcn_cosf(fr);
  p.ropes[idx] = __builtin_amdgcn_sinf(fr);
}
DI void final_rows(CP p, int item) {
  const int lane = tidx() & 63, wv = tidx() >> 6;
  const int orow = item * 8 + wv;
  int r;
  if (orow < 16384) { int s = orow >> 13; r = s * LPR + 16 + (orow & 8191); }
  else { int x = orow - 16384; int s = x >> 11; r = 2 * LPR + s * LSM + 16 + (x & 2047); }
  const float rs = rstd16(p.ssq, r);
  const u16* src = p.hb + (size_t)r * 1024 + lane * 16;
  uint4 a = *(const uint4*)src, b = *(const uint4*)(src + 8);
  unsigned w[8] = {a.x, a.y, a.z, a.w, b.x, b.y, b.z, b.w};
  float* dst = p.out + (size_t)orow * 1024 + lane * 16;
  const float* gn = p.final_norm + lane * 16;
#pragma unroll
  for (int i = 0; i < 4; ++i) {
    float4 o;
    o.x = bflo(w[2 * i]) * rs * gn[4 * i]; o.y = bfhi(w[2 * i]) * rs * gn[4 * i + 1];
    o.z = bflo(w[2 * i + 1]) * rs * gn[4 * i + 2]; o.w = bfhi(w[2 * i + 1]) * rs * gn[4 * i + 3];
    *(float4*)(dst + 4 * i) = o;
  }
}

#define XB_TMO      128
#define XB_XCNT(j)  (256  + 64 * (j))
#define XB_XSUB(j)  (1280 + 64 * (j))
#define XB_XGEN(j)  (2304 + 64 * (j))
#define XB_TOP      3328
#define XB_TOPGEN   3392
#define XCD_BAR_WORDS 3456
#define XB_SPIN_CAP (1u << 18)
#define LAS __attribute__((address_space(3)))

__device__ __forceinline__ unsigned xb_ld(unsigned* p)              { return __hip_atomic_load(p, __ATOMIC_RELAXED, __HIP_MEMORY_SCOPE_AGENT); }
__device__ __forceinline__ unsigned xb_add(unsigned* p, unsigned v) { return __hip_atomic_fetch_add(p, v, __ATOMIC_RELAXED, __HIP_MEMORY_SCOPE_AGENT); }
__device__ __forceinline__ unsigned xb_xcc_id() { return (unsigned)__builtin_amdgcn_s_getreg((3 << 11) | 20) & 0xFu; }
#define XB_SPIN(cond, bar) do { unsigned _sp = 0; while (cond) { __builtin_amdgcn_s_sleep(1); \
    if ((++_sp & 255u) == 0u) { if (xb_ld(&(bar)[XB_TMO])) break; if (_sp > XB_SPIN_CAP) { atomicAdd(&(bar)[XB_TMO], 1u); break; } } } } while (0)

struct XcdBarrier {
    unsigned* bar; unsigned x;
    volatile LAS unsigned* st;
};

__device__ __forceinline__ XcdBarrier xcd_barrier_post(unsigned* bar, volatile LAS unsigned* st) {
    XcdBarrier b; b.bar = bar; b.x = xb_xcc_id(); b.st = st;
    if (threadIdx.x == 0) (void)xb_add(&bar[XB_XCNT(b.x)], 1u);
    return b;
}
__device__ __forceinline__ void xcd_barrier_complete(unsigned* bar, unsigned x, unsigned& nloc, unsigned& nx) {
    const unsigned G = gridDim.x * gridDim.y * gridDim.z;
    unsigned sum, cnt, mine, sp = 0u;
    for (;;) {
        sum = 0u; cnt = 0u; mine = 0u;
#pragma unroll
        for (unsigned j = 0; j < 16; ++j) { const unsigned c = xb_ld(&bar[XB_XCNT(j)]); sum += c; cnt += (c > 0u) ? 1u : 0u; mine = (j == x) ? c : mine; }
        if (sum == G) break;
        __builtin_amdgcn_s_sleep(1);
        if ((++sp & 255u) == 0u) { if (xb_ld(&bar[XB_TMO])) break; if (sp > XB_SPIN_CAP) { atomicAdd(&bar[XB_TMO], 1u); break; } }
    }
    nloc = mine > 0u ? mine : 1u; nx = cnt > 0u ? cnt : 1u;
}

__device__ __forceinline__ void xcd_barrier(const XcdBarrier& b) {
    asm volatile("s_waitcnt vmcnt(0)" ::: "memory");
    __syncthreads();
    if (threadIdx.x == 0) {
        unsigned* bar = b.bar;
        __builtin_amdgcn_s_waitcnt(0);
        unsigned nloc = b.st[0], nx = b.st[1];
        if (nloc == 0u) { xcd_barrier_complete(bar, b.x, nloc, nx); b.st[0] = nloc; b.st[1] = nx; }
        const unsigned old = xb_add(&bar[XB_XSUB(b.x)], 1u);
        const unsigned gen = old / nloc;
        if (old + 1u == (gen + 1u) * nloc) {
            __builtin_amdgcn_fence(__ATOMIC_RELEASE, "agent");
            asm volatile("s_waitcnt vmcnt(0)" ::: "memory");
            const unsigned og = xb_add(&bar[XB_TOP], 1u);
            const unsigned tg = og / nx;
            if (og + 1u == (tg + 1u) * nx) xb_add(&bar[XB_TOPGEN], 1u);
            else XB_SPIN(xb_ld(&bar[XB_TOPGEN]) == tg, bar);
            __builtin_amdgcn_fence(__ATOMIC_ACQUIRE, "agent");
            xb_add(&bar[XB_XGEN(b.x)], 1u);
            asm volatile("s_waitcnt vmcnt(0)" ::: "memory");
        } else {
            XB_SPIN(xb_ld(&bar[XB_XGEN(b.x)]) == gen, bar);
            __builtin_amdgcn_fence(__ATOMIC_ACQUIRE, "agent");
            asm volatile("s_waitcnt vmcnt(0)" ::: "memory");
        }
    }
    __syncthreads();
}

constexpr int NPHASE = 21;
#ifndef ONLY
#define EN(x) true
#else
#define EN(x) ((x) == ONLY)
#endif
DI void run_phase(CP p, int ph, char* smem) {
  const int bid = blockIdx.x, nb = gridDim.x;
  const int fidx = (bid & 7) ? (bid >> 3) * 7 + (bid & 7) - 1 : -1, nfill = (nb >> 3) * 7;
  if (EN(100) && ph == 0) {
    const int n0 = NCONV_FFN, n1 = n0, n2 = n1 + TP / 8, n3 = n2 + (LPR * 16 + NTHR - 1) / NTHR;
    for (int it = bid; it < n3; it += nb) {
      if (it < n0) conv_ffn(p, 0, 0, it, smem);
      else if (it < n2) init_rows(p, it - n1);
      else init_rope(p, it - n2);
    }
    if (bid == 0 && tidx() < 4) p.ctr[tidx()] = 0u;
    return;
  }
  if (ph == 10) return;
  if (EN(102) && ph == 20) { for (int it = bid; it < 4096; it += nb) final_rows(p, it); return; }
  const int layer = ph > 10 ? 1 : 0;
  const int k = ph - (layer ? 11 : 1);
  GArgs g{};
  g.layer = layer; g.scale = 1.f;
  u16* outb = (u16*)p.out;
  switch (k) {
    case 0: case 7: if (EN(0)) {
      g.a0 = p.hb; g.ld0 = 1024; g.split = 1 << 30; g.ks0 = 64; g.a1 = p.hb; g.ld1 = 1024; g.W = (layer == 1 && k == 0) ? p.kn : p.wF; g.K = 1024;
      gemm_phase<0, EPI_UP, 256>(p, g, 22, smem);
      if (k == 7 && layer == 0 && fidx >= 0) for (int it = fidx; it < NCONV_FFN; it += nfill) conv_ffn(p, 1, 0, it, smem);
    } break;
    case 1: case 8: if (EN(1)) {
      g.a0 = p.regB; g.ld0 = 1408; g.split = 22; g.ks0 = 64; g.a1 = outb; g.ld1 = 1408; g.W = ((layer == 1 && k == 1) ? p.kn : p.wF) + OFF_WD; g.K = 2816; g.scale = 0.5f;
      gemm_phase<0, EPI_RES, 256>(p, g, 4, smem);
      if (layer == 0 && fidx >= 0) for (int it = fidx; it < NCONV_MIX; it += nfill) conv_mix(p, k == 1 ? 0 : 1, it, smem);
    } break;
    case 2: if (EN(2)) {
      g.a0 = p.hb; g.ld0 = 1024; g.split = 1 << 30; g.ks0 = 64; g.a1 = p.hb; g.ld1 = 1024; g.W = p.wM + OFF_IN; g.K = 1024;
      gemm_phase<0, EPI_INPROJ, 256>(p, g, 10, smem);
    } break;
    case 3: if (EN(3)) {
      const int nq = NMT * 6, nkv = NMT * 8, nsh = 522, ntot = nq + nkv + nsh;
      for (int it = bid; it < ntot; it += nb) {
        if (it < nq) {
          g.a0 = outb; g.ld0 = 512; g.split = 1 << 30; g.ks0 = 64; g.a1 = outb; g.ld1 = 512; g.W = p.wM + OFF_UQ; g.K = 256;
          gemm_phase_item<0, EPI_Q>(p, g, it, 6, smem);
        } else if (it < nq + nkv) {
          g.a0 = outb + 256; g.ld0 = 512; g.split = 1 << 30; g.ks0 = 64; g.a1 = outb; g.ld1 = 512; g.W = p.wM + OFF_UKV; g.K = 128;
          gemm_phase_item<0, EPI_KV>(p, g, it - nq, 8, smem);
        } else shift_item(p, layer, it - nq - nkv, smem);
      }
    } break;
    case 4: if (EN(4)) {
      for (int sc = bid; sc < 192; sc += nb) {
        if (sc < 64) { int x = sc >> 1; scan_block2<8>(p, layer, x >> 4, (x >> 3) & 1, x & 7, sc & 1, smem); }
        else { int x = sc - 64; scan_block2<16>(p, layer, 2 + (x >> 4), (x >> 3) & 1, x & 7, 0, smem); }
      }
      unsigned* bc = (unsigned*)(smem + SMEM_BYTES - 16);
      while (true) {
        __syncthreads();
        if (tidx() == 0) *bc = atomicAdd(p.ctr + layer, 1u);
        __syncthreads();
        const int it = (int)*bc;
        if (it >= 1104 + NCONV_FFN) break;
        if (it >= 1104) { conv_ffn(p, layer, 1, it - 1104, smem); continue; }
        int s, hd, qb;
        if (it < 528) { s = it / 264; int rem = it - s * 264; hd = rem / 33; qb = rem - hd * 33; }
        else { int x = it - 528; s = 2 + x / 72; int rem = x % 72; hd = rem / 9; qb = rem - hd * 9; }
#ifdef PROBE_ATT2
        attn_item(p, s, hd, qb, smem, p.ctr[8] == 12345u);
        __syncthreads();
#endif
        attn_item(p, s, hd, qb, smem);
      }
    } break;
    case 5: if (EN(5)) {
      g.W = p.wM + OFF_G; g.K = 192; g.a0 = p.regB + 1792; g.a1 = g.a0; g.ld0 = g.ld1 = 1952; g.split = 1 << 30; g.ks0 = 64;
      gemm_phase<0, EPI_POST, 256>(p, g, 2, smem);
    } break;
    case 6: if (EN(6)) {
      g.a0 = outb + (size_t)TP * 1024; g.ld0 = 768; g.split = 8; g.ks0 = 96; g.a1 = outb; g.ld1 = 1024; g.W = p.wM + OFF_OUT; g.K = 1024;
      gemm_phase<0, EPI_RES, 256>(p, g, 4, smem);
    } break;
  }
}

template <bool COOP>
__global__ void __launch_bounds__(NTHR) mega(Params pp, int lo, int hi) {
  extern __shared__ __attribute__((aligned(16))) char smem[];
  const __attribute__((address_space(4))) Params* kp = (const __attribute__((address_space(4))) Params*)__builtin_amdgcn_kernarg_segment_ptr();
  volatile LAS unsigned* st = (volatile LAS unsigned*)(smem + SMEM_BYTES - 32);
  if (threadIdx.x == 0) { st[0] = 0u; st[1] = 0u; }
  __syncthreads();
  XcdBarrier xb = xcd_barrier_post(kp->bar, st);
  for (int ph = lo; ph < hi; ++ph) {
    if (ph == 10) continue;
    asm volatile("" : "+s"(kp));
    run_phase(*kp, ph, smem);
    if (COOP && ph + 1 < hi) {
      if (hi < 0) cg::this_grid().sync();
      xcd_barrier(xb);
    }
  }
}

extern "C" void kernel_launch(void* const* d_in, const int* in_sizes, int n_in, void* d_out, int out_size, void* d_ws, size_t ws_size,
                              hipStream_t stream) {
  Params p{};
  const float** pf = (const float**)&p;
  for (int i = 0; i < 30; ++i) pf[i] = (const float*)d_in[i];
  p.out = (float*)d_out;
  char* w = (char*)d_ws;
  size_t off = 0;
  auto take = [&](size_t bytes) { char* r = w + off; off += (bytes + 255) & ~(size_t)255; return r; };
  p.hb = (u16*)take((size_t)TP * 1024 * 2);
  p.regB = (u16*)take((size_t)TP * 1952 * 2);
  p.kn = (u16*)take((size_t)TP * 512 * 2);
  p.vt = (u16*)take((size_t)TP * 512 * 2);
  p.wF = (u16*)take((size_t)WF_ELEMS * 2);
  p.wM = (u16*)take((size_t)WM_ELEMS * 2);
  p.ssq = (float*)take((size_t)16 * TP * 4);
  p.ssqq = (float*)take((size_t)6 * TP * 4);
  p.bsc = (float*)take((size_t)2 * TP * 8 * 4);
  p.ropec = (float*)take((size_t)LPR * 16 * 4);
  p.ropes = (float*)take((size_t)LPR * 16 * 4);
  p.ctr = (unsigned*)take(256);
  p.bar = (unsigned*)take((size_t)XCD_BAR_WORDS * 4);
  if (off > ws_size) fprintf(stderr, "workspace too small: need %zu have %zu\n", off, ws_size);
#ifndef MULTI_LAUNCH
  static int grid_blocks = 0;
  if (!grid_blocks) {
    hipFuncSetAttribute((const void*)mega<true>, hipFuncAttributeMaxDynamicSharedMemorySize, SMEM_BYTES);
    int dev = 0, cus = 0, per_cu = 0;
    hipGetDevice(&dev);
    hipDeviceGetAttribute(&cus, hipDeviceAttributeMultiprocessorCount, dev);
    hipOccupancyMaxActiveBlocksPerMultiprocessor(&per_cu, mega<true>, NTHR, SMEM_BYTES);
    if (per_cu > 1) per_cu = 1;
    grid_blocks = cus * per_cu;
  }
  hipMemsetAsync(p.bar, 0, (size_t)XCD_BAR_WORDS * 4, stream);
  int lo = 0, hi = NPHASE;
  void* args[] = {&p, &lo, &hi};
  hipError_t e = hipLaunchCooperativeKernel((void*)mega<true>, dim3(grid_blocks), dim3(NTHR), args, SMEM_BYTES, stream);
  if (e != hipSuccess) fprintf(stderr, "cooperative launch failed: %s (grid %d)\n", hipGetErrorString(e), grid_blocks);
#else
  hipFuncSetAttribute((const void*)mega<false>, hipFuncAttributeMaxDynamicSharedMemorySize, SMEM_BYTES);
  for (int ph = 0; ph < NPHASE; ++ph) mega<false><<<256, NTHR, SMEM_BYTES, stream>>>(p, ph, ph + 1);
#endif
}
```
